# Optimizing an MI355X kernel written in HIP

```python
import jax, jax.numpy as jnp
from jax import lax
import numpy as np

D_MODEL = 1024
BATCH = 8
SEQ = 4096
DEPTH = 4

CHUNK = 64
Q_BLOCK = 128
N_A_LAYERS = DEPTH // 2
MLA_HEADS = 8
QK_NOPE = 128
QK_ROPE = 64
V_HEAD = 128
Q_LORA = 384
KV_LORA = 256
ROPE_BASE = 10000.0
SB_HEADS = 8
SB_HEAD = 128
D_FF = 2816
N_EXPERTS = 8
TOP_K = 2
D_FF_EXPERT = 2816
EPS = 1e-6

kernel_name = "yoco_mla_stickbreaking_moe_trunk"


def rms_norm(x, g):
    xf = x.astype(jnp.float32)
    y = xf * lax.rsqrt(jnp.mean(xf * xf, axis=-1, keepdims=True) + EPS)
    return (y * g.astype(jnp.float32)).astype(x.dtype)


def rope_cos_sin(positions):
    inv_freq = 1.0 / (ROPE_BASE ** (jnp.arange(0, QK_ROPE, 2, dtype=jnp.float32) / QK_ROPE))
    ang = positions.astype(jnp.float32)[..., None] * inv_freq
    return jnp.cos(ang), jnp.sin(ang)


def apply_rope(x, cos, sin):
    xf = x.astype(jnp.float32)
    x1, x2 = jnp.split(xf, 2, axis=-1)
    return jnp.concatenate([x1 * cos - x2 * sin, x1 * sin + x2 * cos], axis=-1).astype(x.dtype)


def swiglu(h, w_gate_up, w_down):
    g, u = jnp.split(h @ w_gate_up, 2, axis=-1)
    return (jax.nn.silu(g) * u) @ w_down


def mla(h, cos, sin, w_down, q_norm, w_uq, kv_norm, w_ukv, w_o):
    B, S, _ = h.shape
    c_q, c_kv, k_rope = jnp.split(h @ w_down, [Q_LORA, Q_LORA + KV_LORA], axis=-1)
    q = (rms_norm(c_q, q_norm) @ w_uq).reshape(B, S, MLA_HEADS, QK_NOPE + QK_ROPE)
    q_nope = q[..., :QK_NOPE]
    q_rope = apply_rope(q[..., QK_NOPE:], cos[:, :, None, :], sin[:, :, None, :])
    k_rope = apply_rope(k_rope, cos, sin)
    kv = (rms_norm(c_kv, kv_norm) @ w_ukv).reshape(B, S, MLA_HEADS, QK_NOPE + V_HEAD)
    k_nope, v = kv[..., :QK_NOPE], kv[..., QK_NOPE:]
    scale = (QK_NOPE + QK_ROPE) ** -0.5
    outs = []
    for start in range(0, S, Q_BLOCK):
        end = start + Q_BLOCK
        s = (jnp.einsum('bqhd,bkhd->bhqk', q_nope[:, start:end], k_nope[:, :end])
             + jnp.einsum('bqhr,bkr->bhqk', q_rope[:, start:end], k_rope[:, :end]))
        s = s.astype(jnp.float32) * scale
        q_chunk = (start + jnp.arange(Q_BLOCK)) // CHUNK
        k_chunk = jnp.arange(end) // CHUNK
        mask = k_chunk[None, :] <= q_chunk[:, None]
        p = jax.nn.softmax(jnp.where(mask, s, -jnp.inf), axis=-1).astype(v.dtype)
        outs.append(jnp.einsum('bhqk,bkhd->bqhd', p, v[:, :end]))
    o = jnp.concatenate(outs, axis=1).reshape(B, S, MLA_HEADS * V_HEAD)
    return o @ w_o


def stick_breaking(h, w_q, w_o, k, v):
    B, S, _ = h.shape
    q = (h @ w_q).reshape(B, S, SB_HEADS, SB_HEAD)
    scale = SB_HEAD ** -0.5
    outs = []
    for start in range(0, S, Q_BLOCK):
        end = start + Q_BLOCK
        z = jnp.einsum('bqhd,bkhd->bhqk', q[:, start:end], k[:, :end]).astype(jnp.float32) * scale
        t = start + jnp.arange(Q_BLOCK)
        s = jnp.arange(end)
        mask = s[None, :] < t[:, None]
        log_1m_beta = jnp.where(mask, jax.nn.log_sigmoid(-z), 0.0)
        between = lax.cumsum(log_1m_beta, axis=3, reverse=True) - log_1m_beta
        log_a = jnp.where(mask, jax.nn.log_sigmoid(z) + between, -jnp.inf)
        a = jnp.exp(log_a).astype(v.dtype)
        outs.append(jnp.einsum('bhqk,bkhd->bqhd', a, v[:, :end]))
    o = jnp.concatenate(outs, axis=1).reshape(B, S, SB_HEADS * SB_HEAD)
    return o @ w_o


def moe(h, router, w_gate_up, w_down):
    B, S, D = h.shape
    xt = h.reshape(B * S, D)
    probs = jax.nn.softmax((xt @ router).astype(jnp.float32), axis=-1)
    top_p, top_i = lax.top_k(probs, TOP_K)
    top_p = top_p / jnp.sum(top_p, axis=-1, keepdims=True)
    gates = jnp.sum(jax.nn.one_hot(top_i, N_EXPERTS, dtype=jnp.float32) * top_p[..., None], axis=1)
    gates = gates.astype(xt.dtype)
    y = jnp.zeros_like(xt)
    for e in range(N_EXPERTS):
        y = y + gates[:, e:e + 1] * swiglu(xt, w_gate_up[e], w_down[e])
    return y.reshape(B, S, D)


def setup_inputs(seed: int = 0) -> dict:
    key = jax.random.key(seed)
    keys = iter(jax.random.split(key, 64))
    f32 = jnp.float32

    def w(shape, fan_in):
        return jax.random.normal(next(keys), shape, f32) * (fan_in ** -0.5)

    def g(n):
        return 1.0 + 0.01 * jax.random.normal(next(keys), (n,), f32)

    d = {}
    d["x"] = jax.random.normal(next(keys), (BATCH, SEQ, D_MODEL), f32)
    offsets = jax.random.randint(next(keys), (BATCH, 1), 0, 4096, dtype=jnp.int32)
    d["positions"] = offsets + jnp.arange(SEQ, dtype=jnp.int32)[None, :]

    def add_mla(i):
        d[f"attn_norm_{i}"] = g(D_MODEL)
        d[f"mla_w_down_{i}"] = w((D_MODEL, Q_LORA + KV_LORA + QK_ROPE), D_MODEL)
        d[f"mla_q_norm_{i}"] = g(Q_LORA)
        d[f"mla_w_uq_{i}"] = w((Q_LORA, MLA_HEADS * (QK_NOPE + QK_ROPE)), Q_LORA)
        d[f"mla_kv_norm_{i}"] = g(KV_LORA)
        d[f"mla_w_ukv_{i}"] = w((KV_LORA, MLA_HEADS * (QK_NOPE + V_HEAD)), KV_LORA)
        d[f"mla_w_o_{i}"] = w((MLA_HEADS * V_HEAD, D_MODEL), MLA_HEADS * V_HEAD)

    def add_sb(i):
        d[f"attn_norm_{i}"] = g(D_MODEL)
        d[f"sb_w_q_{i}"] = w((D_MODEL, SB_HEADS * SB_HEAD), D_MODEL)
        d[f"sb_w_o_{i}"] = w((SB_HEADS * SB_HEAD, D_MODEL), SB_HEADS * SB_HEAD)

    def add_dense(i):
        d[f"ffn_norm_{i}"] = g(D_MODEL)
        d[f"ffn_w_gate_up_{i}"] = w((D_MODEL, 2 * D_FF), D_MODEL)
        d[f"ffn_w_down_{i}"] = w((D_FF, D_MODEL), D_FF)

    def add_moe(i):
        d[f"ffn_norm_{i}"] = g(D_MODEL)
        d[f"moe_router_{i}"] = w((D_MODEL, N_EXPERTS), D_MODEL)
        d[f"moe_w_gate_up_{i}"] = w((N_EXPERTS, D_MODEL, 2 * D_FF_EXPERT), D_MODEL)
        d[f"moe_w_down_{i}"] = w((N_EXPERTS, D_FF_EXPERT, D_MODEL), D_FF_EXPERT)

    add_mla(0); add_dense(0)
    add_mla(1); add_moe(1)
    d["kv_shared_norm"] = g(D_MODEL)
    d["kv_shared_w"] = w((D_MODEL, 2 * SB_HEADS * SB_HEAD), D_MODEL)
    add_sb(2); add_dense(2)
    add_sb(3); add_moe(3)
    d["final_norm"] = g(D_MODEL)
    return d


def reference(x, positions,
              attn_norm_0, mla_w_down_0, mla_q_norm_0, mla_w_uq_0, mla_kv_norm_0, mla_w_ukv_0, mla_w_o_0,
              ffn_norm_0, ffn_w_gate_up_0, ffn_w_down_0,
              attn_norm_1, mla_w_down_1, mla_q_norm_1, mla_w_uq_1, mla_kv_norm_1, mla_w_ukv_1, mla_w_o_1,
              ffn_norm_1, moe_router_1, moe_w_gate_up_1, moe_w_down_1,
              kv_shared_norm, kv_shared_w,
              attn_norm_2, sb_w_q_2, sb_w_o_2,
              ffn_norm_2, ffn_w_gate_up_2, ffn_w_down_2,
              attn_norm_3, sb_w_q_3, sb_w_o_3,
              ffn_norm_3, moe_router_3, moe_w_gate_up_3, moe_w_down_3,
              final_norm):
    B, S, _ = x.shape
    attn_norms = [attn_norm_0, attn_norm_1, attn_norm_2, attn_norm_3]
    ffn_norms = [ffn_norm_0, ffn_norm_1, ffn_norm_2, ffn_norm_3]
    mla_params = [
        (mla_w_down_0, mla_q_norm_0, mla_w_uq_0, mla_kv_norm_0, mla_w_ukv_0, mla_w_o_0),
        (mla_w_down_1, mla_q_norm_1, mla_w_uq_1, mla_kv_norm_1, mla_w_ukv_1, mla_w_o_1),
    ]
    sb_params = [(sb_w_q_2, sb_w_o_2), (sb_w_q_3, sb_w_o_3)]
    dense_params = [(ffn_w_gate_up_0, ffn_w_down_0), (ffn_w_gate_up_2, ffn_w_down_2)]
    moe_params = [(moe_router_1, moe_w_gate_up_1, moe_w_down_1),
                  (moe_router_3, moe_w_gate_up_3, moe_w_down_3)]

    cos, sin = rope_cos_sin(positions)
    h = x
    k_sh = v_sh = None
    for layer in range(DEPTH):
        if layer < N_A_LAYERS:
            h = h + mla(rms_norm(h, attn_norms[layer]), cos, sin, *mla_params[layer])
        else:
            if layer == N_A_LAYERS:
                kv = (rms_norm(h, kv_shared_norm) @ kv_shared_w).reshape(B, S, 2, SB_HEADS, SB_HEAD)
                k_sh, v_sh = kv[:, :, 0], kv[:, :, 1]
            h = h + stick_breaking(rms_norm(h, attn_norms[layer]), *sb_params[layer - N_A_LAYERS], k_sh, v_sh)
        f_in = rms_norm(h, ffn_norms[layer])
        if layer % 2 == 0:
            h = h + swiglu(f_in, *dense_params[layer // 2])
        else:
            h = h + moe(f_in, *moe_params[layer // 2])
    return rms_norm(h, final_norm)
```

```cpp
#include <hip/hip_runtime.h>
#include <cstdio>
#include <cstdint>

#ifndef REPEAT
#define REPEAT -1
#endif
#ifndef DENSE_DN_FP8
#define DENSE_DN_FP8 1
#endif
#ifndef MLA_FP8
#define MLA_FP8 1
#endif
typedef unsigned short bf16;
typedef float f32x4 __attribute__((ext_vector_type(4)));
typedef float f32x16 __attribute__((ext_vector_type(16)));
typedef unsigned u32x4 __attribute__((ext_vector_type(4)));
typedef unsigned u32x2 __attribute__((ext_vector_type(2)));

constexpr int NB = 8, S = 4096, D = 1024, M = NB * S;
constexpr int NH = 8, QKN = 128, QKR = 64, QKD = QKN + QKR, VH = 128, QL = 384, KVL = 256;
constexpr int NDOWN = QL + KVL + QKR;
constexpr int FF = 2816, NE = 8;
constexpr float EPS = 1e-6f;
constexpr float LOG2E = 1.4426950408889634f, LN2 = 0.6931471805599453f;
constexpr float C2_MLA = 0.07216878364870322f * LOG2E;
constexpr float C2_SB = 0.08838834764831845f * LOG2E;
constexpr int TMAX = 2 * M + NE * 256;

constexpr size_t MiB = 1u << 20;
constexpr size_t WS_CTL = 0, CTL_BYTES = 1 * MiB;
constexpr size_t WS_SS = 1 * MiB;
constexpr size_t WS_CS = 9 * MiB;
constexpr size_t WS_RINFO = 17 * MiB;
constexpr size_t WS_SLOT = 18 * MiB;
constexpr size_t WS_TOKSLOT = WS_SLOT + 768 * 1024;
constexpr size_t WS_HB = 19 * MiB;
constexpr size_t WS_R0 = 83 * MiB;
constexpr size_t R_CQ = 0, R_CKV = 24 * MiB, R_KR = 40 * MiB, R_Q = 44 * MiB, R_KN = 140 * MiB, R_V = 204 * MiB, R_O = 268 * MiB;
constexpr size_t R_Q8 = 44 * MiB, R_K8T = 92 * MiB, R_VT8T = 144 * MiB;
constexpr int K8_PITCH = 208, K8_TILE = 64 * K8_PITCH, VT8_PITCH = 80, VT8_TILE = 128 * VT8_PITCH;
static_assert(R_Q8 + (size_t)M * 1536 <= R_K8T && R_K8T + (size_t)4096 * K8_TILE <= R_VT8T && R_VT8T + (size_t)4096 * VT8_TILE <= R_O, "fp8 MLA buffers");
constexpr size_t R_ACT = 0;
constexpr size_t R_KS = 176 * MiB, R_VS = 240 * MiB, R_QS = 304 * MiB, R_OS = 368 * MiB;
constexpr size_t R_XG = 0, R_ACTG = 132 * MiB;
constexpr size_t WS_WSMALL = 578 * MiB, WS_WMOE = 635 * MiB;
constexpr size_t WS_END = 767 * MiB;
constexpr int CW_CNT = 64;
constexpr int CW_BAR = 4096;
constexpr int CW_BASE = 256;

__device__ __forceinline__ unsigned f2bf(float f) { unsigned u = __builtin_bit_cast(unsigned, f); return (u + 0x7fffu + ((u >> 16) & 1u)) >> 16; }
__device__ __forceinline__ float bf2f(unsigned b) { return __builtin_bit_cast(float, (b & 0xffffu) << 16); }
__device__ __forceinline__ unsigned pk2(float lo, float hi) { return f2bf(lo) | (f2bf(hi) << 16); }
__device__ __forceinline__ float wave_sum(float v) {
#pragma unroll
    for (int o = 1; o < 64; o <<= 1) v += __shfl_xor(v, o);
    return v;
}
__device__ __forceinline__ float wave_max(float v) {
#pragma unroll
    for (int o = 1; o < 64; o <<= 1) v = fmaxf(v, __shfl_xor(v, o));
    return v;
}
__device__ __forceinline__ int crow(int r, int hi) { return (r & 3) + 8 * (r >> 2) + 4 * hi; }

__device__ __forceinline__ float sum16(const float* p) { const f32x4 a = *(const f32x4*)p, b = *(const f32x4*)(p + 4), c = *(const f32x4*)(p + 8), d = *(const f32x4*)(p + 12);
    return (((a.x + a.y) + (a.z + a.w)) + ((b.x + b.y) + (b.z + b.w))) + (((c.x + c.y) + (c.z + c.w)) + ((d.x + d.y) + (d.z + d.w))); }
struct RInfo { int e1, e2, p1, p2; float g1, g2; int s1, s2; };

namespace pg8 {
#define PG8_LAS __attribute__((address_space(3)))
typedef unsigned short bf16_t;
typedef short bf16x8 __attribute__((ext_vector_type(8)));
typedef float f32x4 __attribute__((ext_vector_type(4)));
typedef unsigned u32x4 __attribute__((ext_vector_type(4)));
constexpr int BM = 256, BK = 64, HALF = 128, HTB = HALF * BK * 2  , STAGE_BYTES = 8 * HTB, NXCD = 8, WGM = 8;

__host__ __device__ __forceinline__ int lds_byte(int r, int c) { const int st = (r >> 4) * 2 + (c >> 5), rr = r & 15, cc = c & 31, ob = rr * 64 + cc * 2; return st * 1024 + (ob ^ (((ob >> 9) & 1) << 5)); }
__host__ __device__ __forceinline__ void stage_rc(int b, int& R, int& C) { const int st = b / 1024, sb = b % 1024, swz = sb ^ (((sb >> 9) & 1) << 5); R = (st >> 1) * 16 + swz / 64; C = (st & 1) * 32 + (swz % 64) / 2; }
__host__ __device__ __forceinline__ int perm32(int rho) { const int n = rho >> 4, i = rho & 15; return 8 * (i >> 2) + 4 * n + (i & 3); }

struct Unit { int pm, pn; };
struct Gemm { const bf16_t* A; const bf16_t* Bt; int M, N, K; };

struct StaticOrder {
    int nM, nN, nwg, G, c;
    __host__ __device__ void init(int M, int N, int G_, int c_) { nM = M / BM; nN = N / BM; nwg = nM * nN; G = G_; c = c_; }
    __host__ __device__ bool next(int i, Unit& u) const {
        const long L = (long)i * G + c; if (L >= nwg) return false;
        int wgid = (int)L; { const int q = nwg / NXCD, r = nwg % NXCD, xcd = wgid % NXCD, off = wgid / NXCD; wgid = (xcd < r ? xcd * (q + 1) : r * (q + 1) + (xcd - r) * q) + off; }
        const int nig = WGM * nN, gid = wgid / nig, fm = gid * WGM, gsz = (nM - fm) < WGM ? (nM - fm) : WGM;
        u.pm = fm + ((wgid % nig) % gsz); u.pn = (wgid % nig) / gsz; return true;
    }
    __device__ __forceinline__ void a_ready(const Unit&) const {}
    __device__ __forceinline__ void done(const Unit&) const {}
    __device__ __forceinline__ size_t boff(const Unit&) const { return 0; }
};

__device__ __forceinline__ unsigned cvt_pk_bf16(float lo, float hi) { unsigned r; asm volatile("v_cvt_pk_bf16_f32 %0, %1, %2" : "=v"(r) : "v"(lo), "v"(hi)); return r; }
typedef unsigned u32x2 __attribute__((ext_vector_type(2)));
__device__ __forceinline__ u32x4 pack8(const f32x4 a, const f32x4 b) { u32x4 w; w.x = cvt_pk_bf16(a[0], a[1]); w.y = cvt_pk_bf16(a[2], a[3]); w.z = cvt_pk_bf16(b[0], b[1]); w.w = cvt_pk_bf16(b[2], b[3]); return w; }
__device__ __forceinline__ float sumsq8(const f32x4 a, const f32x4 b) { return ((a[0] * a[0] + a[1] * a[1]) + (a[2] * a[2] + a[3] * a[3])) + ((b[0] * b[0] + b[1] * b[1]) + (b[2] * b[2] + b[3] * b[3])); }
__device__ __forceinline__ float red_fq(float q) {
    q += __uint_as_float((unsigned)__builtin_amdgcn_ds_swizzle((int)__float_as_uint(q), 0x401F));
    { auto rr = __builtin_amdgcn_permlane32_swap(__float_as_uint(q), __float_as_uint(q), false, false); q = __uint_as_float(rr[0]) + __uint_as_float(rr[1]); }
    return q; }
__device__ __forceinline__ float row_ss(const float* ss, int stride, int nq, int r, int fq) { if (stride == 1) return ss[r]; float q = 0.f; if (fq < nq) { const f32x4 v = *(const f32x4*)(ss + (size_t)r * 16 + fq * 4); q = (v[0] + v[1]) + (v[2] + v[3]); } return red_fq(q); }
constexpr float EPSN = 1e-6f;
__device__ __forceinline__ void row_sums(float (&q)[8], const float* ss, int stride, int nq, int row0, int fq) {
    if (stride == 1) {
#pragma unroll
        for (int g = 0; g < 8; ++g) q[g] = ss[row0 + (g >> 2) * HALF + (g & 3) * 16];
        asm volatile("" :: "v"(q[0]), "v"(q[1]), "v"(q[2]), "v"(q[3]), "v"(q[4]), "v"(q[5]), "v"(q[6]), "v"(q[7]));
        return;
    }
    f32x4 raw[8]; const int fqc = (fq < nq) ? fq : 0;
#pragma unroll
    for (int g = 0; g < 8; ++g) raw[g] = *(const f32x4*)(ss + (size_t)(row0 + (g >> 2) * HALF + (g & 3) * 16) * 16 + fqc * 4);
    asm volatile("" :: "v"(raw[0]), "v"(raw[1]), "v"(raw[2]), "v"(raw[3]), "v"(raw[4]), "v"(raw[5]), "v"(raw[6]), "v"(raw[7]));
    float t[8];
#pragma unroll
    for (int g = 0; g < 8; ++g) { const float sm = (raw[g][0] + raw[g][1]) + (raw[g][2] + raw[g][3]); q[g] = (fq < nq) ? sm : 0.f; }
#pragma unroll
    for (int g = 0; g < 8; ++g) t[g] = __uint_as_float((unsigned)__builtin_amdgcn_ds_swizzle((int)__float_as_uint(q[g]), 0x401F));
#pragma unroll
    for (int g = 0; g < 8; ++g) q[g] += t[g];
#pragma unroll
    for (int g = 0; g < 8; ++g) { auto rr = __builtin_amdgcn_permlane32_swap(__float_as_uint(q[g]), __float_as_uint(q[g]), false, false); q[g] = __uint_as_float(rr[0]) + __uint_as_float(rr[1]); }
}
#define EPI_ROW_SCALES(rs_, ss_, stride_, nq_, expr) float rs_[8]; { float q_[8]; row_sums(q_, ss_, stride_, nq_, u.pm * BM + wr * 64 + fr, fq); _Pragma("unroll") for (int g_ = 0; g_ < 8; ++g_) { const float q = q_[g_]; rs_[g_] = (expr); } }
__device__ __forceinline__ float rsq_(float x) { return __builtin_amdgcn_rsqf(x); }
constexpr int TOUCH_SINK = STAGE_BYTES + 4096;
__device__ __forceinline__ void touch_line(PG8_LAS unsigned char* lds, const void* p) { __builtin_amdgcn_global_load_lds((const unsigned*)p, (PG8_LAS unsigned*)(lds + TOUCH_SINK), 4, 0, 0); }
__device__ __forceinline__ void touch_rows16(PG8_LAS unsigned char* lds, const float* ss, int row0, int tid) { if (tid < 128) touch_line(lds, (const char*)(ss + (size_t)row0 * 16) + tid * 128); }
__device__ __forceinline__ void touch_rows1(PG8_LAS unsigned char* lds, const float* ss, int row0, int tid) { if (tid < 8) touch_line(lds, (const char*)(ss + row0) + tid * 128); }
__device__ __forceinline__ unsigned pk4_fp8(float a, float b, float c, float d) {
    a = __builtin_amdgcn_fmed3f(a, -448.f, 448.f); b = __builtin_amdgcn_fmed3f(b, -448.f, 448.f); c = __builtin_amdgcn_fmed3f(c, -448.f, 448.f); d = __builtin_amdgcn_fmed3f(d, -448.f, 448.f);
    int w = __builtin_amdgcn_cvt_pk_fp8_f32(a, b, 0, false); w = __builtin_amdgcn_cvt_pk_fp8_f32(c, d, w, true); return (unsigned)w; }

struct EpiDown { static constexpr bool PERM = true, AFTER_DRAIN = false, PROBE2 = false;
    const float* ss; const float2* cs; bf16_t* cq; bf16_t* ckv; bf16_t* kr; float* ssq; float* sskv; unsigned char* k8t;
    __device__ __forceinline__ void touch(PG8_LAS unsigned char* lds, const Unit& u, int tid) const { touch_rows16(lds, ss, u.pm * BM, tid); }
    __device__ __forceinline__ void operator()(const f32x4 (&acc)[2][2][4][2], const Unit& u0, int wr, int wc, int fr, int fq) const {
        Unit u = u0; asm volatile("" : "+s"(u.pm), "+s"(u.pn));
        EPI_ROW_SCALES(rs, ss, 16, 4, rsq_(q * (1.0f / 1024.0f) + EPSN))
#pragma unroll
        for (int ai = 0; ai < 2; ++ai)
#pragma unroll
            for (int m = 0; m < 4; ++m) { const int r = u.pm * BM + ai * HALF + wr * 64 + m * 16 + fr; const float rstd = rs[ai * 4 + m];
#pragma unroll
                for (int bj = 0; bj < 2; ++bj) { const int c = u.pn * BM + bj * HALF + wc * 32, cl = c + fq * 8;
                    const f32x4 v0 = acc[ai][bj][m][0] * rstd, v1 = acc[ai][bj][m][1] * rstd;
                    if (c < 384) { *(u32x4*)(cq + (size_t)r * 384 + cl) = pack8(v0, v1); const float q = red_fq(sumsq8(v0, v1)); if (fq == 0) ssq[(size_t)r * 16 + (c >> 5)] = q; }
                    else if (c < 640) { *(u32x4*)(ckv + (size_t)r * 256 + (cl - 384)) = pack8(v0, v1); const float q = red_fq(sumsq8(v0, v1)); if (fq == 0) sskv[(size_t)r * 16 + ((c - 384) >> 5)] = q; }
                    else if (c < 704) { const int i0 = (cl - 640) >> 1; const f32x4 t01 = *(const f32x4*)(cs + (size_t)r * 32 + i0), t23 = *(const f32x4*)(cs + (size_t)r * 32 + i0 + 2);
                        const f32x4 o0 = {v0[0] * t01[0] - v0[1] * t01[1], v0[0] * t01[1] + v0[1] * t01[0], v0[2] * t01[2] - v0[3] * t01[3], v0[2] * t01[3] + v0[3] * t01[2]};
                        const f32x4 o1 = {v1[0] * t23[0] - v1[1] * t23[1], v1[0] * t23[1] + v1[1] * t23[0], v1[2] * t23[2] - v1[3] * t23[3], v1[2] * t23[3] + v1[3] * t23[2]};
                        if (k8t) { u32x2 w; w.x = pk4_fp8(o0[0], o0[1], o0[2], o0[3]); w.y = pk4_fp8(o1[0], o1[1], o1[2], o1[3]); const int b = r >> 12, key = r & 4095, j = key >> 6, kk = key & 63;
#pragma unroll
                            for (int h2 = 0; h2 < 8; ++h2) *(u32x2*)(k8t + (size_t)((b * 8 + h2) * 64 + j) * 13312 + kk * 208 + 128 + (cl - 640)) = w; }
                        else *(u32x4*)(kr + (size_t)r * 64 + (cl - 640)) = pack8(o0, o1); }
                } }
    }
};
struct EpiUq { static constexpr bool PERM = true, AFTER_DRAIN = false, PROBE2 = false;
    const float* ssq; const float2* cs; bf16_t* Q; float c2; int pad;
    __device__ __forceinline__ void touch(PG8_LAS unsigned char* lds, const Unit& u, int tid) const { touch_rows16(lds, ssq, u.pm * BM, tid); }
    __device__ __forceinline__ void operator()(const f32x4 (&acc)[2][2][4][2], const Unit& u0, int wr, int wc, int fr, int fq) const {
        Unit u = u0; asm volatile("" : "+s"(u.pm), "+s"(u.pn));
        EPI_ROW_SCALES(rs, ssq, 16, 3, rsq_(q * (1.0f / 384.0f) + EPSN) * c2)
#pragma unroll
        for (int ai = 0; ai < 2; ++ai)
#pragma unroll
            for (int m = 0; m < 4; ++m) { const int r = u.pm * BM + ai * HALF + wr * 64 + m * 16 + fr; const float rstd = rs[ai * 4 + m];
#pragma unroll
                for (int bj = 0; bj < 2; ++bj) { const int c = u.pn * BM + bj * HALF + wc * 32, cl = c + fq * 8, d = c % 192;
                    const f32x4 v0 = acc[ai][bj][m][0] * rstd, v1 = acc[ai][bj][m][1] * rstd;
                    if (d < 128) { *(u32x4*)(Q + (size_t)r * 1536 + cl) = pack8(v0, v1); }
                    else { const int i0 = ((d - 128) >> 1) + fq * 4; const f32x4 t01 = *(const f32x4*)(cs + (size_t)r * 32 + i0), t23 = *(const f32x4*)(cs + (size_t)r * 32 + i0 + 2);
                        const f32x4 o0 = {v0[0] * t01[0] - v0[1] * t01[1], v0[0] * t01[1] + v0[1] * t01[0], v0[2] * t01[2] - v0[3] * t01[3], v0[2] * t01[3] + v0[3] * t01[2]};
                        const f32x4 o1 = {v1[0] * t23[0] - v1[1] * t23[1], v1[0] * t23[1] + v1[1] * t23[0], v1[2] * t23[2] - v1[3] * t23[3], v1[2] * t23[3] + v1[3] * t23[2]};
                        *(u32x4*)(Q + (size_t)r * 1536 + cl) = pack8(o0, o1); }
                } }
    }
};
struct EpiUq8 { static constexpr bool PERM = true, AFTER_DRAIN = false, PROBE2 = false;
    const float* ssq; const float2* cs; unsigned char* Q8; float c2; int pad;
    __device__ __forceinline__ void touch(PG8_LAS unsigned char* lds, const Unit& u, int tid) const { touch_rows16(lds, ssq, u.pm * BM, tid); }
    __device__ __forceinline__ void operator()(const f32x4 (&acc)[2][2][4][2], const Unit& u0, int wr, int wc, int fr, int fq) const {
        Unit u = u0; asm volatile("" : "+s"(u.pm), "+s"(u.pn));
        EPI_ROW_SCALES(rs, ssq, 16, 3, rsq_(q * (1.0f / 384.0f) + EPSN) * c2)
#pragma unroll
        for (int ai = 0; ai < 2; ++ai)
#pragma unroll
            for (int m = 0; m < 4; ++m) { const int r = u.pm * BM + ai * HALF + wr * 64 + m * 16 + fr; const float rstd = rs[ai * 4 + m];
#pragma unroll
                for (int bj = 0; bj < 2; ++bj) { const int c = u.pn * BM + bj * HALF + wc * 32, cl = c + fq * 8, d = c % 192;
                    f32x4 v0 = acc[ai][bj][m][0] * rstd, v1 = acc[ai][bj][m][1] * rstd;
                    if (d >= 128) { const int i0 = ((d - 128) >> 1) + fq * 4; const f32x4 t01 = *(const f32x4*)(cs + (size_t)r * 32 + i0), t23 = *(const f32x4*)(cs + (size_t)r * 32 + i0 + 2);
                        const f32x4 o0 = {v0[0] * t01[0] - v0[1] * t01[1], v0[0] * t01[1] + v0[1] * t01[0], v0[2] * t01[2] - v0[3] * t01[3], v0[2] * t01[3] + v0[3] * t01[2]};
                        const f32x4 o1 = {v1[0] * t23[0] - v1[1] * t23[1], v1[0] * t23[1] + v1[1] * t23[0], v1[2] * t23[2] - v1[3] * t23[3], v1[2] * t23[3] + v1[3] * t23[2]};
                        v0 = o0; v1 = o1; }
                    u32x2 w; w.x = pk4_fp8(v0[0], v0[1], v0[2], v0[3]); w.y = pk4_fp8(v1[0], v1[1], v1[2], v1[3]);
                    *(u32x2*)(Q8 + (size_t)r * 1536 + cl) = w; } }
    }
};
struct EpiKn8 { static constexpr bool PERM = true, AFTER_DRAIN = false, PROBE2 = false;
    const float* sskv; unsigned char* K8T;
    __device__ __forceinline__ void touch(PG8_LAS unsigned char* lds, const Unit& u, int tid) const { touch_rows16(lds, sskv, u.pm * BM, tid); }
    __device__ __forceinline__ void operator()(const f32x4 (&acc)[2][2][4][2], const Unit& u0, int wr, int wc, int fr, int fq) const {
        Unit u = u0; asm volatile("" : "+s"(u.pm), "+s"(u.pn));
        EPI_ROW_SCALES(rs, sskv, 16, 2, rsq_(q * (1.0f / 256.0f) + EPSN))
#pragma unroll
        for (int ai = 0; ai < 2; ++ai)
#pragma unroll
            for (int m = 0; m < 4; ++m) { const int r = u.pm * BM + ai * HALF + wr * 64 + m * 16 + fr; const float rstd = rs[ai * 4 + m];
                const int b = r >> 12, key = r & 4095, j = key >> 6, kk = key & 63;
#pragma unroll
                for (int bj = 0; bj < 2; ++bj) { const int head = 2 * u.pn + bj; const f32x4 v0 = acc[ai][bj][m][0] * rstd, v1 = acc[ai][bj][m][1] * rstd;
                    u32x2 w; w.x = pk4_fp8(v0[0], v0[1], v0[2], v0[3]); w.y = pk4_fp8(v1[0], v1[1], v1[2], v1[3]);
                    *(u32x2*)(K8T + (size_t)((b * 8 + head) * 64 + j) * 13312 + kk * 208 + wc * 32 + fq * 8) = w; } }
    }
};
struct EpiVt8 { static constexpr bool PERM = true, AFTER_DRAIN = false, PROBE2 = false;
    const float* sskv; unsigned char* VT8T;
    __device__ __forceinline__ void touch(PG8_LAS unsigned char* lds, const Unit& u, int tid) const { touch_rows16(lds, sskv, u.pn * BM, tid); }
    __device__ __forceinline__ void operator()(const f32x4 (&acc)[2][2][4][2], const Unit& u0, int wr, int wc, int fr, int fq) const {
        Unit u = u0; asm volatile("" : "+s"(u.pm), "+s"(u.pn));
        float sc[2][8];
#pragma unroll
        for (int bj = 0; bj < 2; ++bj) { const int c = u.pn * BM + bj * HALF + wc * 32 + fq * 8;
            f32x4 s0[8], s1[8];
#pragma unroll
            for (int i = 0; i < 8; ++i) { s0[i] = *(const f32x4*)(sskv + (size_t)(c + i) * 16); s1[i] = *(const f32x4*)(sskv + (size_t)(c + i) * 16 + 4); }
            asm volatile("" :: "v"(s0[0]), "v"(s0[1]), "v"(s0[2]), "v"(s0[3]), "v"(s0[4]), "v"(s0[5]), "v"(s0[6]), "v"(s0[7]), "v"(s1[0]), "v"(s1[1]), "v"(s1[2]), "v"(s1[3]), "v"(s1[4]), "v"(s1[5]), "v"(s1[6]), "v"(s1[7]));
#pragma unroll
            for (int i = 0; i < 8; ++i) sc[bj][i] = rsq_((((s0[i][0] + s0[i][1]) + (s0[i][2] + s0[i][3])) + ((s1[i][0] + s1[i][1]) + (s1[i][2] + s1[i][3]))) * (1.0f / 256.0f) + EPSN); }
#pragma unroll
        for (int ai = 0; ai < 2; ++ai)
#pragma unroll
            for (int m = 0; m < 4; ++m) { const int rr = u.pm * BM + ai * HALF + wr * 64 + m * 16 + fr, head = rr >> 7, d = rr & 127;
#pragma unroll
                for (int bj = 0; bj < 2; ++bj) { const int c = u.pn * BM + bj * HALF + wc * 32 + fq * 8, b = c >> 12, key = c & 4095, j = key >> 6, kk = key & 63;
                    const f32x4 v0 = acc[ai][bj][m][0], v1 = acc[ai][bj][m][1];
                    u32x2 w; w.x = pk4_fp8(v0[0] * sc[bj][0], v0[1] * sc[bj][1], v0[2] * sc[bj][2], v0[3] * sc[bj][3]); w.y = pk4_fp8(v1[0] * sc[bj][4], v1[1] * sc[bj][5], v1[2] * sc[bj][6], v1[3] * sc[bj][7]);
                    *(u32x2*)(VT8T + (size_t)((b * 8 + head) * 64 + j) * 10240 + d * 80 + kk) = w; } }
    }
};
struct EpiUkv { static constexpr bool PERM = true, AFTER_DRAIN = false, PROBE2 = false;
    const float* sskv; bf16_t* KN; bf16_t* V;
    __device__ __forceinline__ void touch(PG8_LAS unsigned char* lds, const Unit& u, int tid) const { touch_rows16(lds, sskv, u.pm * BM, tid); }
    __device__ __forceinline__ void operator()(const f32x4 (&acc)[2][2][4][2], const Unit& u0, int wr, int wc, int fr, int fq) const {
        Unit u = u0; asm volatile("" : "+s"(u.pm), "+s"(u.pn));
        EPI_ROW_SCALES(rs, sskv, 16, 2, rsq_(q * (1.0f / 256.0f) + EPSN))
#pragma unroll
        for (int ai = 0; ai < 2; ++ai)
#pragma unroll
            for (int m = 0; m < 4; ++m) { const int r = u.pm * BM + ai * HALF + wr * 64 + m * 16 + fr; const float rstd = rs[ai * 4 + m];
                const size_t o = (size_t)r * 1024 + u.pn * 128 + wc * 32 + fq * 8;
                *(u32x4*)(KN + o) = pack8(acc[ai][0][m][0] * rstd, acc[ai][0][m][1] * rstd);
                *(u32x4*)(V + o) = pack8(acc[ai][1][m][0] * rstd, acc[ai][1][m][1] * rstd); }
    }
};
__device__ __forceinline__ f32x4 bf4_lo(const u32x4 w) { return (f32x4){__uint_as_float(w.x << 16), __uint_as_float(w.x & 0xffff0000u), __uint_as_float(w.y << 16), __uint_as_float(w.y & 0xffff0000u)}; }
__device__ __forceinline__ f32x4 bf4_hi(const u32x4 w) { return (f32x4){__uint_as_float(w.z << 16), __uint_as_float(w.z & 0xffff0000u), __uint_as_float(w.w << 16), __uint_as_float(w.w & 0xffff0000u)}; }
struct EpiRes { static constexpr bool PERM = true, AFTER_DRAIN = false, PROBE2 = false;
    const bf16_t* hin; bf16_t* hb; float* ssn; float ascale; int pad;
    __device__ __forceinline__ void touch(PG8_LAS unsigned char* lds, const Unit& u, int tid) const { _Pragma("unroll") for (int i = 0; i < 2; ++i) { const int li = tid + 512 * i; touch_line(lds, (const char*)(hin + (size_t)(u.pm * BM + (li >> 2)) * 1024 + u.pn * BM) + (li & 3) * 128); } }
    __device__ __forceinline__ void operator()(const f32x4 (&acc)[2][2][4][2], const Unit& u0, int wr, int wc, int fr, int fq) const {
        Unit u = u0; asm volatile("" : "+s"(u.pm), "+s"(u.pn));
        const size_t o00 = (size_t)(u.pm * BM + wr * 64 + fr) * 1024 + u.pn * BM + wc * 32 + fq * 8;
        u32x4 h0[8], h1[8];
#pragma unroll
        for (int g = 0; g < 8; ++g) { const size_t og = o00 + (size_t)((g >> 2) * HALF + (g & 3) * 16) * 1024; h0[g] = *(const u32x4*)(hin + og); h1[g] = *(const u32x4*)(hin + og + HALF); }
        asm volatile("" :: "v"(h0[0]), "v"(h0[1]), "v"(h0[2]), "v"(h0[3]), "v"(h0[4]), "v"(h0[5]), "v"(h0[6]), "v"(h0[7]), "v"(h1[0]), "v"(h1[1]), "v"(h1[2]), "v"(h1[3]), "v"(h1[4]), "v"(h1[5]), "v"(h1[6]), "v"(h1[7]));
#pragma unroll
        for (int g = 0; g < 8; ++g) { const int ai = g >> 2, m = g & 3; const int r = u.pm * BM + ai * HALF + wr * 64 + m * 16 + fr;
            float q = 0.f;
#pragma unroll
            for (int bj = 0; bj < 2; ++bj) { const size_t o = o00 + (size_t)(ai * HALF + m * 16) * 1024 + bj * HALF; const u32x4 hv = bj ? h1[g] : h0[g];
                const f32x4 o0 = bf4_lo(hv) + acc[ai][bj][m][0] * ascale, o1 = bf4_hi(hv) + acc[ai][bj][m][1] * ascale;
                *(u32x4*)(hb + o) = pack8(o0, o1); q += sumsq8(o0, o1); }
            q = red_fq(q); if (fq == 0) ssn[(size_t)r * 16 + u.pn * 4 + wc] = q; }
    }
};
struct EpiSwiglu { static constexpr bool PERM = true, AFTER_DRAIN = false, PROBE2 = true;
    const float* ss; bf16_t* act; int ss_stride; int pad;
    __device__ __forceinline__ void touch(PG8_LAS unsigned char* lds, const Unit& u, int tid) const { if (ss_stride == 1) touch_rows1(lds, ss, u.pm * BM, tid); else touch_rows16(lds, ss, u.pm * BM, tid); }
    __device__ __forceinline__ void operator()(const f32x4 (&acc)[2][2][4][2], const Unit& u0, int wr, int wc, int fr, int fq) const {
        Unit u = u0; asm volatile("" : "+s"(u.pm), "+s"(u.pn));
        bf16_t* abase = act + ((size_t)(u.pm * 44 + 2 * u.pn + (wc >> 1)) * 256 + wr * 64 + fr) * 64 + (wc & 1) * 32 + fq * 8;
        EPI_ROW_SCALES(rs, ss, ss_stride, 4, rsq_(q * (1.0f / 1024.0f) + EPSN))
#pragma unroll
        for (int ai = 0; ai < 2; ++ai)
#pragma unroll
            for (int m = 0; m < 4; ++m) { const float rstd = rs[ai * 4 + m];
                f32x4 a[2];
                const float c1 = -1.4426950408889634f * rstd, ic2 = __builtin_amdgcn_rcpf(rstd * rstd);
#pragma unroll
                for (int n = 0; n < 2; ++n) { const f32x4 ag = acc[ai][0][m][n], t = ag * acc[ai][1][m][n];
#pragma unroll
                    for (int j = 0; j < 4; ++j) a[n][j] = t[j] * __builtin_amdgcn_rcpf(__builtin_fmaf(__builtin_amdgcn_exp2f(ag[j] * c1), ic2, ic2)); }
                *(u32x4*)(abase + (ai * HALF + m * 16) * 64) = pack8(a[0], a[1]); }
    }
};
__device__ __forceinline__ unsigned pk4_fp8_nc(float a, float b, float c, float d) { int w = __builtin_amdgcn_cvt_pk_fp8_f32(a, b, 0, false); w = __builtin_amdgcn_cvt_pk_fp8_f32(c, d, w, true); return (unsigned)w; }
struct EpiSwiglu8 { static constexpr bool PERM = true, AFTER_DRAIN = false, PROBE2 = false;
    const float* ss; unsigned char* act; int ss_stride; float ascale;
    __device__ __forceinline__ void touch(PG8_LAS unsigned char* lds, const Unit& u, int tid) const { if (ss_stride == 1) touch_rows1(lds, ss, u.pm * BM, tid); else touch_rows16(lds, ss, u.pm * BM, tid); }
    __device__ __forceinline__ void operator()(const f32x4 (&acc)[2][2][4][2], const Unit& u0, int wr, int wc, int fr, int fq) const {
        Unit u = u0; asm volatile("" : "+s"(u.pm), "+s"(u.pn));
        unsigned char* abase = act + (size_t)(u.pm * 22 + u.pn) * 32768 + (wr * 64 + fr) * 128 + wc * 32 + fq * 8;
        EPI_ROW_SCALES(rs, ss, ss_stride, 4, rsq_(q * (1.0f / 1024.0f) + EPSN) * ascale)
#pragma unroll
        for (int ai = 0; ai < 2; ++ai)
#pragma unroll
            for (int m = 0; m < 4; ++m) { const float rstd = rs[ai * 4 + m];
                f32x4 a[2];
                const float c1 = -1.4426950408889634f * rstd, ic2 = __builtin_amdgcn_rcpf(rstd * rstd * 8.0f);
#pragma unroll
                for (int n = 0; n < 2; ++n) { const f32x4 ag = acc[ai][0][m][n], t = ag * acc[ai][1][m][n];
#pragma unroll
                    for (int j = 0; j < 4; ++j) a[n][j] = t[j] * __builtin_amdgcn_rcpf(__builtin_fmaf(__builtin_amdgcn_exp2f(ag[j] * c1), ic2, ic2)); }
                u32x2 w; w.x = pk4_fp8(a[0][0], a[0][1], a[0][2], a[0][3]); w.y = pk4_fp8(a[1][0], a[1][1], a[1][2], a[1][3]);
                *(u32x2*)(abase + (ai * HALF + m * 16) * 128) = w; }
    }
};
struct EpiProj { static constexpr bool PERM = true, AFTER_DRAIN = false, PROBE2 = false;
    const float* ss; bf16_t* o0; size_t tstride; float qs; int qt; int nq; float invd; int pad;
    __device__ __forceinline__ void touch(PG8_LAS unsigned char* lds, const Unit& u, int tid) const { touch_rows16(lds, ss, u.pm * BM, tid); }
    __device__ __forceinline__ void operator()(const f32x4 (&acc)[2][2][4][2], const Unit& u0, int wr, int wc, int fr, int fq) const {
        Unit u = u0; asm volatile("" : "+s"(u.pm), "+s"(u.pn));
        const int t = u.pn >> 2; bf16_t* dst = o0 + (size_t)t * tstride; const float sc = (t == qt) ? qs : 1.0f;
        EPI_ROW_SCALES(rs, ss, 16, nq, rsq_(q * invd + EPSN) * sc)
#pragma unroll
        for (int ai = 0; ai < 2; ++ai)
#pragma unroll
            for (int m = 0; m < 4; ++m) { const int r = u.pm * BM + ai * HALF + wr * 64 + m * 16 + fr; const float rstd = rs[ai * 4 + m];
#pragma unroll
                for (int bj = 0; bj < 2; ++bj) *(u32x4*)(dst + (size_t)r * 1024 + (u.pn & 3) * BM + bj * HALF + wc * 32 + fq * 8) = pack8(acc[ai][bj][m][0] * rstd, acc[ai][bj][m][1] * rstd); }
    }
};
struct EpiMdn { static constexpr bool PERM = true, AFTER_DRAIN = false, PROBE2 = false;
    const float* sgate; bf16_t* y; float scale; int pad;
    __device__ __forceinline__ void touch(PG8_LAS unsigned char* lds, const Unit& u, int tid) const { touch_rows1(lds, sgate, u.pm * BM, tid); }
    __device__ __forceinline__ void operator()(const f32x4 (&acc)[2][2][4][2], const Unit& u0, int wr, int wc, int fr, int fq) const {
        Unit u = u0; asm volatile("" : "+s"(u.pm), "+s"(u.pn));
        EPI_ROW_SCALES(rs, sgate, 1, 0, q * scale)
#pragma unroll
        for (int ai = 0; ai < 2; ++ai)
#pragma unroll
            for (int m = 0; m < 4; ++m) { const int r = u.pm * BM + ai * HALF + wr * 64 + m * 16 + fr; const float g = rs[ai * 4 + m];
#pragma unroll
                for (int bj = 0; bj < 2; ++bj) *(u32x4*)(y + (size_t)r * 1024 + u.pn * BM + bj * HALF + wc * 32 + fq * 8) = pack8(acc[ai][bj][m][0] * g, acc[ai][bj][m][1] * g); }
    }
};
struct GroupedOrder : StaticOrder {
    int b1, b2, b3, b4, b5, b6, b7; size_t estride;
    __device__ __forceinline__ void initg(const int* base, int N, int G_, int c_, size_t estride_) { init(__builtin_amdgcn_readfirstlane(base[8]), N, G_, c_); b1 = __builtin_amdgcn_readfirstlane(base[1]); b2 = __builtin_amdgcn_readfirstlane(base[2]); b3 = __builtin_amdgcn_readfirstlane(base[3]); b4 = __builtin_amdgcn_readfirstlane(base[4]); b5 = __builtin_amdgcn_readfirstlane(base[5]); b6 = __builtin_amdgcn_readfirstlane(base[6]); b7 = __builtin_amdgcn_readfirstlane(base[7]); estride = estride_; }
    __device__ __forceinline__ void initd(int M, int N, int G_, int c_) { init(M, N, G_, c_); b1 = b2 = b3 = b4 = b5 = b6 = b7 = 0x7fffffff; estride = 0; }
    __device__ __forceinline__ size_t boff(const Unit& u) const { const int r = u.pm * BM; const int e = (r >= b1) + (r >= b2) + (r >= b3) + (r >= b4) + (r >= b5) + (r >= b6) + (r >= b7); return (size_t)e * estride; }
};
struct MoeSplit { int nM_main, ntail;
    __device__ __forceinline__ void init(int nM, int nN, int G) { const int nwg = nM * nN, t = nwg % G; const bool on = (G % nN == 0) && t != 0 && t * 4 <= G && nwg > G; ntail = on ? t : 0; nM_main = (nwg - ntail) / nN; } };
struct TailOrder : GroupedOrder { int tpm, tpn;
    __device__ __forceinline__ bool next(int i, Unit& u) const { if (i != 0) return false; u.pm = tpm; u.pn = tpn; return true; } };
typedef int v8i_t __attribute__((ext_vector_type(8)));
typedef int v4i_t __attribute__((ext_vector_type(4)));
__device__ __forceinline__ v8i_t cat8(const bf16x8 lo, const bf16x8 hi) { const v4i_t a = __builtin_bit_cast(v4i_t, lo), b = __builtin_bit_cast(v4i_t, hi); return __builtin_shufflevector(a, b, 0, 1, 2, 3, 4, 5, 6, 7); }
template <class Epi, class Sched, bool ALIGN_EPI = false, bool SP2 = false, bool F8 = false, bool TILED = false>
__device__ __forceinline__ void gemm_phase(PG8_LAS unsigned char* lds, const Gemm g, const Sched& S, const Epi& E) {
    int tid_ = threadIdx.x; asm volatile("" : "+v"(tid_));
    const int tid = tid_, wid = __builtin_amdgcn_readfirstlane(tid >> 6), lane = tid & 63, wr = wid >> 2, wc = wid & 3, fr = lane & 15, fq = lane >> 4;
    int K_ = g.K; asm volatile("" : "+s"(K_));
    const int K = K_, nt = K / BK;
    unsigned voffA[2], voffB[2];
#pragma unroll
    for (int i = 0; i < 2; ++i) { int R, C; stage_rc(tid * 16 + i * 8192, R, C); const int Rb = Epi::PERM ? ((R & ~31) + perm32(R & 31)) : R;
        voffA[i] = TILED ? (unsigned)(R * 128 + C * 2) : (unsigned)(R * K + C) * 2u; voffB[i] = TILED ? (unsigned)(Rb * 128 + C * 2) : (unsigned)(Rb * K + C) * 2u; }
    const size_t kstep = TILED ? (size_t)32768 : (size_t)(BK * 2);
    const size_t hstep = TILED ? (size_t)16384 : (size_t)HALF * K * 2;
    const size_t tstep = (size_t)BM * K * 2;
    const unsigned ldsw = (unsigned)wid * 1024u;
    const int aoff = lds_byte(wr * 64 + fr, fq * 8), boff = lds_byte(wc * 32 + fr, fq * 8);
#define PG8_SA(b, h) (((b) * 2 + (h)) * HTB)
#define PG8_SB(b, h) ((4 + (b) * 2 + (h)) * HTB)
#define PG8_STAGE(bufoff, gbase, voff) do { _Pragma("unroll") for (int _i = 0; _i < 2; ++_i) \
        __builtin_amdgcn_global_load_lds((const unsigned*)((const char*)(gbase) + (voff)[_i]), (PG8_LAS unsigned*)(lds + (bufoff) + ldsw + _i * 8192), 16, 0, 0); } while (0)
#define PG8_LD16(off) (*(const PG8_LAS v4i_t*)(lds + (off)))
#define PG8_LDA(dst, b, h) do { if constexpr (F8) { _Pragma("unroll") for (int m = 0; m < 4; ++m) dst##8[m] = __builtin_shufflevector(PG8_LD16(PG8_SA(b, h) + aoff + m * 2048), PG8_LD16(PG8_SA(b, h) + aoff + m * 2048 + 1024), 0, 1, 2, 3, 4, 5, 6, 7); } \
        else { _Pragma("unroll") for (int m = 0; m < 4; ++m) _Pragma("unroll") for (int k = 0; k < 2; ++k) dst[m][k] = *(const PG8_LAS bf16x8*)(lds + PG8_SA(b, h) + aoff + m * 2048 + k * 1024); } } while (0)
#define PG8_LDB(dst, b, h) do { if constexpr (F8) { _Pragma("unroll") for (int n = 0; n < 2; ++n) dst##8[n] = __builtin_shufflevector(PG8_LD16(PG8_SB(b, h) + boff + n * 2048), PG8_LD16(PG8_SB(b, h) + boff + n * 2048 + 1024), 0, 1, 2, 3, 4, 5, 6, 7); } \
        else { _Pragma("unroll") for (int n = 0; n < 2; ++n) _Pragma("unroll") for (int k = 0; k < 2; ++k) dst[n][k] = *(const PG8_LAS bf16x8*)(lds + PG8_SB(b, h) + boff + n * 2048 + k * 1024); } } while (0)
#define PG8_MMA(ai, bj, At, Bt) do { __builtin_amdgcn_s_setprio(1); \
        if constexpr (F8) { asm volatile("s_nop 1"); _Pragma("unroll") for (int m = 0; m < 4; ++m) _Pragma("unroll") for (int n = 0; n < 2; ++n) \
            asm volatile("v_mfma_scale_f32_16x16x128_f8f6f4 %0, %1, %2, %0, %3, %3 op_sel_hi:[0,0,0]" : "+v"(acc[ai][bj][m][n]) : "v"(Bt##8[n]), "v"(At##8[m]), "v"(one_scale)); } \
        else { _Pragma("unroll") for (int m = 0; m < 4; ++m) _Pragma("unroll") for (int n = 0; n < 2; ++n) _Pragma("unroll") for (int k = 0; k < 2; ++k) \
            acc[ai][bj][m][n] = __builtin_amdgcn_mfma_f32_16x16x32_bf16(Bt[n][k], At[m][k], acc[ai][bj][m][n], 0, 0, 0); } \
        __builtin_amdgcn_s_setprio(0); } while (0)
#define PG8_WAIT_V(n) asm volatile("s_waitcnt vmcnt(" #n ")" ::: "memory")
#define PG8_WAIT_L(n) asm volatile("s_waitcnt lgkmcnt(" #n ")" ::: "memory")
#define PG8_BAR __builtin_amdgcn_s_barrier()
#define PG8_SCHED __builtin_amdgcn_sched_barrier(0)
    Unit cur, nxt; int ui = 0;
    if (!S.next(0, cur)) return;
    float zero_; asm volatile("v_mov_b32 %0, 0" : "=v"(zero_));
    f32x4 acc[2][2][4][2];
#pragma unroll
    for (int a = 0; a < 2; ++a)
#pragma unroll
        for (int b = 0; b < 2; ++b)
#pragma unroll
            for (int m = 0; m < 4; ++m)
#pragma unroll
                for (int n = 0; n < 2; ++n) acc[a][b][m][n] = (f32x4){0.f, 0.f, 0.f, 0.f};
    const int one_scale = 0x7F7F7F7F; (void)one_scale;
    const char* cA = (const char*)g.A + (size_t)cur.pm * tstep; const char* cB = (const char*)g.Bt + S.boff(cur) + (size_t)cur.pn * tstep;
    S.a_ready(cur);
    if constexpr (SP2) {
        PG8_STAGE(PG8_SB(0, 0), cB, voffB); PG8_STAGE(PG8_SB(0, 1), cB + hstep, voffB); PG8_STAGE(PG8_SA(0, 0), cA, voffA); PG8_STAGE(PG8_SA(0, 1), cA + hstep, voffA);
        if (wr == 1) PG8_BAR;
        PG8_WAIT_V(2); PG8_BAR;
        PG8_STAGE(PG8_SB(1, 0), cB + kstep, voffB); PG8_STAGE(PG8_SA(1, 0), cA + kstep, voffA); PG8_STAGE(PG8_SB(1, 1), cB + hstep + kstep, voffB);
        PG8_WAIT_V(6); PG8_BAR;
    } else {
        PG8_STAGE(PG8_SB(0, 0), cB, voffB); PG8_STAGE(PG8_SA(0, 0), cA, voffA); PG8_STAGE(PG8_SB(0, 1), cB + hstep, voffB); PG8_STAGE(PG8_SA(0, 1), cA + hstep, voffA);
        if (wr == 1) PG8_BAR;
        PG8_WAIT_V(4); PG8_BAR;
        PG8_STAGE(PG8_SB(1, 0), cB + kstep, voffB); PG8_STAGE(PG8_SA(1, 0), cA + kstep, voffA); PG8_STAGE(PG8_SB(1, 1), cB + hstep + kstep, voffB);
        PG8_WAIT_V(6); PG8_BAR;
    }
    for (;;) {
        const bool has_next = S.next(ui + 1, nxt);
        const char* nA = has_next ? (const char*)g.A + (size_t)nxt.pm * tstep : cA; const char* nB = has_next ? (const char*)g.Bt + S.boff(nxt) + (size_t)nxt.pn * tstep : cB;
#pragma nounroll
        for (int t = 0; t < nt; t += 2) {
            bf16x8 At[4][2], B0[2][2], B1[2][2]; v8i_t At8[4], B08[2], B18[2];
            const bool last = (t == nt - 2);
            const char* a1 = cA + (size_t)(t + 1) * kstep;
            const char* a2 = last ? nA : cA + (size_t)(t + 2) * kstep; const char* b2 = last ? nB : cB + (size_t)(t + 2) * kstep;
            const char* a3 = a2 + kstep; const char* b3 = b2 + kstep;
            if (last && has_next) S.a_ready(nxt);
            if (last) { const int tl_ = wid * 64 + (int)__builtin_amdgcn_mbcnt_hi(~0u, __builtin_amdgcn_mbcnt_lo(~0u, 0u)); E.touch(lds, cur, tl_); PG8_SCHED; }
            if constexpr (SP2) {
            PG8_LDB(B0, 0, 0); PG8_LDB(B1, 0, 1); PG8_SCHED; PG8_LDA(At, 0, 0); PG8_STAGE(PG8_SA(1, 1), a1 + hstep, voffA);
            PG8_WAIT_V(8); PG8_WAIT_L(0); PG8_BAR; PG8_MMA(0, 0, At, B0); PG8_MMA(0, 1, At, B1); PG8_BAR; PG8_SCHED;
            PG8_LDA(At, 0, 1); PG8_STAGE(PG8_SB(0, 0), b2, voffB); PG8_STAGE(PG8_SB(0, 1), b2 + hstep, voffB); PG8_STAGE(PG8_SA(0, 0), a2, voffA);
            PG8_WAIT_V(8); PG8_WAIT_L(0); PG8_BAR; PG8_MMA(1, 0, At, B0); PG8_MMA(1, 1, At, B1); PG8_BAR; PG8_SCHED;
            PG8_LDB(B0, 1, 0); PG8_LDB(B1, 1, 1); PG8_SCHED; PG8_LDA(At, 1, 0); PG8_STAGE(PG8_SA(0, 1), a2 + hstep, voffA);
            PG8_WAIT_V(8); PG8_WAIT_L(0); PG8_BAR; PG8_MMA(0, 0, At, B0); PG8_MMA(0, 1, At, B1); PG8_BAR; PG8_SCHED;
            PG8_LDA(At, 1, 1); PG8_STAGE(PG8_SB(1, 0), b3, voffB); PG8_STAGE(PG8_SB(1, 1), b3 + hstep, voffB); PG8_STAGE(PG8_SA(1, 0), a3, voffA);
            PG8_WAIT_V(8); PG8_WAIT_L(0); PG8_BAR; PG8_MMA(1, 0, At, B0); PG8_MMA(1, 1, At, B1); PG8_BAR; PG8_SCHED;
            } else {
            PG8_LDB(B0, 0, 0); PG8_SCHED; PG8_LDA(At, 0, 0); PG8_STAGE(PG8_SA(1, 1), a1 + hstep, voffA);
            PG8_WAIT_L(8); PG8_BAR; PG8_WAIT_L(0); PG8_MMA(0, 0, At, B0); PG8_BAR; PG8_SCHED;
            PG8_LDB(B1, 0, 1); PG8_STAGE(PG8_SB(0, 0), b2, voffB);
            PG8_BAR; PG8_WAIT_L(0); PG8_MMA(0, 1, At, B1); PG8_BAR;
            PG8_LDA(At, 0, 1); PG8_STAGE(PG8_SA(0, 0), a2, voffA);
            PG8_BAR; PG8_WAIT_L(0); PG8_MMA(1, 0, At, B0); PG8_BAR; PG8_SCHED;
            PG8_STAGE(PG8_SB(0, 1), b2 + hstep, voffB);
            PG8_WAIT_V(6); PG8_BAR; PG8_MMA(1, 1, At, B1); PG8_BAR;
            PG8_LDB(B0, 1, 0); PG8_SCHED; PG8_LDA(At, 1, 0); PG8_STAGE(PG8_SA(0, 1), a2 + hstep, voffA);
            PG8_WAIT_L(8); PG8_BAR; PG8_WAIT_L(0); PG8_MMA(0, 0, At, B0); PG8_BAR; PG8_SCHED;
            PG8_LDB(B1, 1, 1); PG8_STAGE(PG8_SB(1, 0), b3, voffB);
            PG8_BAR; PG8_WAIT_L(0); PG8_MMA(0, 1, At, B1); PG8_BAR;
            PG8_LDA(At, 1, 1); PG8_STAGE(PG8_SA(1, 0), a3, voffA);
            PG8_BAR; PG8_WAIT_L(0); PG8_MMA(1, 0, At, B0); PG8_BAR; PG8_SCHED;
            PG8_STAGE(PG8_SB(1, 1), b3 + hstep, voffB);
            PG8_WAIT_V(6); PG8_BAR; PG8_MMA(1, 1, At, B1); PG8_BAR;
            }
        }
        if constexpr (F8) {
            asm volatile("s_nop 7\n\ts_nop 7" ::: "memory");
#pragma unroll
            for (int a_ = 0; a_ < 2; ++a_)
#pragma unroll
                for (int b_ = 0; b_ < 2; ++b_) asm volatile("" : "+v"(acc[a_][b_][0][0]), "+v"(acc[a_][b_][0][1]), "+v"(acc[a_][b_][1][0]), "+v"(acc[a_][b_][1][1]), "+v"(acc[a_][b_][2][0]), "+v"(acc[a_][b_][2][1]), "+v"(acc[a_][b_][3][0]), "+v"(acc[a_][b_][3][1]));
        }
        if constexpr (ALIGN_EPI) { if (wr == 0) PG8_BAR; }
        if constexpr (!Epi::AFTER_DRAIN) { E(acc, cur, wr, wc, fr, fq); if (REPEAT == 13 && Epi::PROBE2) { asm volatile("" ::: "memory"); E(acc, cur, wr, wc, fr, fq); } S.done(cur); }
        if (!has_next) break;
#pragma unroll
        for (int a = 0; a < 2; ++a)
#pragma unroll
            for (int b = 0; b < 2; ++b)
#pragma unroll
                for (int m = 0; m < 4; ++m)
#pragma unroll
                    for (int n = 0; n < 2; ++n) acc[a][b][m][n] = (f32x4){0.f, 0.f, 0.f, 0.f};
        cur = nxt; cA = nA; cB = nB; ++ui;
        if constexpr (ALIGN_EPI) { if (wr == 1) PG8_BAR; }
    }
    PG8_WAIT_V(0);
    if constexpr (!ALIGN_EPI) { if (wr == 0) PG8_BAR; }
    PG8_BAR;
    if constexpr (Epi::AFTER_DRAIN) { E.fused(acc, cur, wr, wc, fr, fq, lds, wid, lane); S.done(cur); }
#undef PG8_SA
#undef PG8_SB
#undef PG8_STAGE
#undef PG8_LDA
#undef PG8_LD16
#undef PG8_LDB
#undef PG8_MMA
#undef PG8_WAIT_V
#undef PG8_WAIT_L
#undef PG8_BAR
#undef PG8_SCHED
}
}


namespace att {
typedef short bf16x8 __attribute__((ext_vector_type(8)));
typedef short s16x4 __attribute__((ext_vector_type(4)));
typedef float f32x16 __attribute__((ext_vector_type(16)));
typedef unsigned u32x4 __attribute__((ext_vector_type(4)));
#define ATT_LAS __attribute__((address_space(3)))
#define SBAR() __builtin_amdgcn_sched_barrier(0)
constexpr int L_V = 0, L_K = 32768, L_KM = 49152, L_WS = 102400;
constexpr int KP_MLA = 400, KT_MLA = 64 * KP_MLA;
constexpr int KP_SB = 272, KT_SB = 64 * KP_SB;
static_assert(L_KM + 2 * KT_MLA <= L_WS && L_K + 2 * KT_SB <= L_WS && L_WS + 8 * 256 <= 131072, "attention LDS map");
constexpr float THR2 = 11.5f;

__device__ __forceinline__ int crow(int r, int hi) { return (r & 3) + 8 * (r >> 2) + 4 * hi; }
__device__ __forceinline__ unsigned cvtpk(float lo, float hi) { unsigned r; asm volatile("v_cvt_pk_bf16_f32 %0, %1, %2" : "=v"(r) : "v"(lo), "v"(hi)); return r; }
__device__ __forceinline__ int v_st(int k, int c) { const int kk = (k & ~0xC) | ((k & 4) << 1) | ((k & 8) >> 1); return ((kk >> 3) * 4 + (c >> 5)) * 512 + ((kk & 7) * 32 + (c & 31)) * 2; }
__device__ __forceinline__ int v_rd_base(int lane) { return ((lane & 3) << 3) | (((lane >> 2) & 3) << 6) | (((lane >> 4) & 1) << 5) | (((lane >> 5) & 1) << 8); }
constexpr int v_rd_off(int d0, int ks, int half) { return d0 * 512 + ks * 4096 + half * 2048; }
template <int OFF> __device__ __forceinline__ s16x4 tr_read(int vb) { s16x4 r; asm volatile("ds_read_b64_tr_b16 %0, %1 offset:%2" : "=&v"(r) : "v"(vb), "i"(OFF) : "memory"); return r; }
template <int D0> __device__ __forceinline__ void pv_one(f32x16& od, int vb, bf16x8 pa0, bf16x8 pa1, bf16x8 pa2, bf16x8 pa3) {
    const s16x4 l0 = tr_read<v_rd_off(D0, 0, 0)>(vb), h0 = tr_read<v_rd_off(D0, 0, 1)>(vb), l1 = tr_read<v_rd_off(D0, 1, 0)>(vb), h1 = tr_read<v_rd_off(D0, 1, 1)>(vb);
    const s16x4 l2 = tr_read<v_rd_off(D0, 2, 0)>(vb), h2 = tr_read<v_rd_off(D0, 2, 1)>(vb), l3 = tr_read<v_rd_off(D0, 3, 0)>(vb), h3 = tr_read<v_rd_off(D0, 3, 1)>(vb);
    asm volatile("s_waitcnt lgkmcnt(0)" ::: "memory"); SBAR();
#define ATT_PK(L, H) (bf16x8){L[0], L[1], L[2], L[3], H[0], H[1], H[2], H[3]}
    od = __builtin_amdgcn_mfma_f32_32x32x16_bf16(pa0, ATT_PK(l0, h0), od, 0, 0, 0);
    od = __builtin_amdgcn_mfma_f32_32x32x16_bf16(pa1, ATT_PK(l1, h1), od, 0, 0, 0);
    od = __builtin_amdgcn_mfma_f32_32x32x16_bf16(pa2, ATT_PK(l2, h2), od, 0, 0, 0);
    od = __builtin_amdgcn_mfma_f32_32x32x16_bf16(pa3, ATT_PK(l3, h3), od, 0, 0, 0);
#undef ATT_PK
}
__device__ __forceinline__ void pv_d0(f32x16* o, int vb, bf16x8 pa0, bf16x8 pa1, bf16x8 pa2, bf16x8 pa3) {
    pv_one<0>(o[0], vb, pa0, pa1, pa2, pa3); pv_one<1>(o[1], vb, pa0, pa1, pa2, pa3); pv_one<2>(o[2], vb, pa0, pa1, pa2, pa3); pv_one<3>(o[3], vb, pa0, pa1, pa2, pa3);
}
template <int ND0, int PITCH> __device__ __forceinline__ void qkt(f32x16& p0, f32x16& p1, const ATT_LAS char* Kt, const bf16x8* qr, int r32, int hi) {
    p0 = f32x16{}; p1 = f32x16{};
    const ATT_LAS char* kb = Kt + r32 * PITCH + hi * 16;
#pragma unroll
    for (int d0 = 0; d0 < ND0; ++d0) {
        const bf16x8 b0 = *(const ATT_LAS bf16x8*)(kb + d0 * 32), b1 = *(const ATT_LAS bf16x8*)(kb + 32 * PITCH + d0 * 32);
        p0 = __builtin_amdgcn_mfma_f32_32x32x16_bf16(b0, qr[d0], p0, 0, 0, 0);
        p1 = __builtin_amdgcn_mfma_f32_32x32x16_bf16(b1, qr[d0], p1, 0, 0, 0); }
}
__device__ __forceinline__ void pack_p(const f32x16& p0, const f32x16& p1, bf16x8& pa0, bf16x8& pa1, bf16x8& pa2, bf16x8& pa3) {
#define ATT_PK4(P, BASE, OUT) do { unsigned a0 = cvtpk(P[BASE + 0], P[BASE + 1]), a1 = cvtpk(P[BASE + 2], P[BASE + 3]);   \
    unsigned b0 = cvtpk(P[BASE + 4], P[BASE + 5]), b1 = cvtpk(P[BASE + 6], P[BASE + 7]);                              \
    auto r0 = __builtin_amdgcn_permlane32_swap(a0, b0, false, false); auto r1 = __builtin_amdgcn_permlane32_swap(a1, b1, false, false); \
    u32x4 w = {r0[0], r1[0], r0[1], r1[1]}; OUT = *reinterpret_cast<bf16x8*>(&w); } while (0)
    ATT_PK4(p0, 0, pa0); ATT_PK4(p0, 8, pa1); ATT_PK4(p1, 0, pa2); ATT_PK4(p1, 8, pa3);
#undef ATT_PK4
}
__device__ __forceinline__ void softmax_tile(f32x16& p0, f32x16& p1, float& m_reg, float& l_reg, float& alpha) {
    float pmax = p0[0];
#pragma unroll
    for (int r = 1; r < 16; ++r) pmax = fmaxf(pmax, p0[r]);
#pragma unroll
    for (int r = 0; r < 16; ++r) pmax = fmaxf(pmax, p1[r]);
    { auto rr = __builtin_amdgcn_permlane32_swap(__float_as_uint(pmax), __float_as_uint(pmax), false, false); pmax = fmaxf(__uint_as_float(rr[0]), __uint_as_float(rr[1])); }
    float mn;
    if (__builtin_expect(__all(pmax - m_reg <= THR2), 1)) { mn = m_reg; alpha = 1.f; }
    else { mn = fmaxf(m_reg, pmax); alpha = __builtin_amdgcn_exp2f(m_reg - mn); m_reg = mn; }
    float ps = 0.f;
#pragma unroll
    for (int r = 0; r < 16; ++r) { p0[r] = __builtin_amdgcn_exp2f(p0[r] - mn); ps += p0[r]; }
#pragma unroll
    for (int r = 0; r < 16; ++r) { p1[r] = __builtin_amdgcn_exp2f(p1[r] - mn); ps += p1[r]; }
    { auto rr = __builtin_amdgcn_permlane32_swap(__float_as_uint(ps), __float_as_uint(ps), false, false); ps = __uint_as_float(rr[0]) + __uint_as_float(rr[1]); }
    l_reg = l_reg * alpha + ps;
}

__device__ __forceinline__ void mla_smpv(f32x16& p0, f32x16& p1, float& m_reg, float& l_reg, f32x16 (&o)[4], ATT_LAS float* al_l, int r32, int hi, int vb) {
    float alpha; softmax_tile(p0, p1, m_reg, l_reg, alpha);
    if (__any(alpha < 1.f)) { if (hi == 0) al_l[r32] = alpha; asm volatile("s_waitcnt lgkmcnt(0)" ::: "memory");
#pragma unroll
        for (int d = 0; d < 4; ++d)
#pragma unroll
            for (int r = 0; r < 16; ++r) o[d][r] *= al_l[crow(r, hi)]; }
    bf16x8 pa0, pa1, pa2, pa3; pack_p(p0, p1, pa0, pa1, pa2, pa3); SBAR();
    pv_d0(o, vb, pa0, pa1, pa2, pa3);
}
__device__ __forceinline__ void store_o_tile(ATT_LAS char* stg, const f32x16 (&o)[4], const float* rl, bf16* Orow0, int lane, int r32, int hi) {
#pragma unroll
    for (int r = 0; r < 16; ++r) { const float sc = rl ? rl[r] : 1.0f; ATT_LAS char* rp = stg + crow(r, hi) * 272 + r32 * 2;
#pragma unroll
        for (int d0 = 0; d0 < 4; ++d0) *(ATT_LAS unsigned short*)(rp + d0 * 64) = (unsigned short)(cvtpk(o[d0][r] * sc, 0.f) & 0xffffu); }
    asm volatile("s_waitcnt lgkmcnt(0)" ::: "memory");
#pragma unroll
    for (int i = 0; i < 8; ++i) { const int q = lane + 64 * i, row = q >> 4, c16 = q & 15;
        const u32x4 v = *(const ATT_LAS u32x4*)(stg + row * 272 + c16 * 16);
        *(u32x4*)(Orow0 + (size_t)row * 1024 + c16 * 8) = v; }
    asm volatile("s_waitcnt lgkmcnt(0)" ::: "memory");
}
__device__ __forceinline__ void mla_unit(ATT_LAS char* lds, const bf16* __restrict__ Q, const bf16* __restrict__ KN, const bf16* __restrict__ KR, const bf16* __restrict__ V, bf16* __restrict__ O, int b, int hd, int qb) {
    int tid_ = threadIdx.x; asm volatile("" : "+v"(tid_));
    const int tid = tid_, wid = __builtin_amdgcn_readfirstlane(tid >> 6), lane = tid & 63, r32 = lane & 31, hi = lane >> 5;
    ATT_LAS char* Vl = lds + L_V; ATT_LAS char* Kl = lds + L_KM; ATT_LAS float* li_l = (ATT_LAS float*)(lds + L_WS) + wid * 64; ATT_LAS float* al_l = li_l + 32;
    const size_t tok0 = (size_t)b * S; const int q0 = qb * 256;
    bf16x8 qr[12];
    { const bf16* Qw = Q + (tok0 + q0 + wid * 32 + r32) * 1536 + hd * 192 + hi * 8;
#pragma unroll
      for (int d0 = 0; d0 < 12; ++d0) qr[d0] = *(const bf16x8*)(Qw + d0 * 16); }
    float m_reg = -1e30f, l_reg = 0.f; f32x16 o[4] = {};
    const int NT = 4 * qb + 4, jw = 4 * qb + (wid >> 1);
    const int sr = tid >> 4, sc = (tid & 15) * 8, vst0 = v_st(sr, sc), vst1 = v_st(32 + sr, sc);
    const bf16* vsrc = V + (tok0 + sr) * 1024 + hd * 128 + sc;
    const bf16* ksrc[3]; int kstr[3], kdst[3];
#pragma unroll
    for (int i = 0; i < 3; ++i) { const int q = tid + 512 * i, krow = q / 24, kc = q - krow * 24;
        ksrc[i] = (kc < 16) ? KN + (tok0 + krow) * 1024 + hd * 128 + kc * 8 : KR + (tok0 + krow) * 64 + (kc - 16) * 8;
        kstr[i] = (kc < 16) ? 64 * 1024 : 64 * 64; kdst[i] = krow * KP_MLA + kc * 16; }
    const int vb0 = (int)(uintptr_t)Vl + v_rd_base(lane);
    bf16x8 vs0, vs1, ks0, ks1, ks2;
#define MLA_SLOAD(j) do { vs0 = *(const bf16x8*)(vsrc + (size_t)(j) * 65536); vs1 = *(const bf16x8*)(vsrc + (size_t)(j) * 65536 + 32 * 1024); \
        ks0 = *(const bf16x8*)(ksrc[0] + (size_t)(j) * kstr[0]); ks1 = *(const bf16x8*)(ksrc[1] + (size_t)(j) * kstr[1]); ks2 = *(const bf16x8*)(ksrc[2] + (size_t)(j) * kstr[2]); } while (0)
#define MLA_SWRITE(kb, vbf) do { *(ATT_LAS bf16x8*)(Vl + (vbf) * 16384 + vst0) = vs0; *(ATT_LAS bf16x8*)(Vl + (vbf) * 16384 + vst1) = vs1; \
        *(ATT_LAS bf16x8*)(Kl + (kb) * KT_MLA + kdst[0]) = ks0; *(ATT_LAS bf16x8*)(Kl + (kb) * KT_MLA + kdst[1]) = ks1; *(ATT_LAS bf16x8*)(Kl + (kb) * KT_MLA + kdst[2]) = ks2; } while (0)
    const bool late = wid >= 4;
    f32x16 p0 = {}, p1 = {};
#define MLA_SMPV(vbuf) mla_smpv(p0, p1, m_reg, l_reg, o, al_l, r32, hi, vb0 + (vbuf) * 16384)
    MLA_SLOAD(0); asm volatile("s_waitcnt vmcnt(0)" ::: "memory"); MLA_SWRITE(0, 0); __syncthreads();
    int vcur = 0;
    for (int j = 0; j < NT; ++j) {
        const int cur = j & 1, vprev = (vcur == 0) ? 2 : vcur - 1, vnext = (vcur == 2) ? 0 : vcur + 1;
        if (j + 1 < NT) MLA_SLOAD(j + 1);
        if (!late && j <= jw) qkt<12, KP_MLA>(p0, p1, Kl + cur * KT_MLA, qr, r32, hi);
        SBAR();
        if (late ? (j >= 1 && j - 1 <= jw) : (j <= jw)) MLA_SMPV(late ? vprev : vcur);
        SBAR();
        if (late && j <= jw) { int r32b = r32; asm volatile("" : "+v"(r32b)); qkt<12, KP_MLA>(p0, p1, Kl + cur * KT_MLA, qr, r32b, hi); }
        if (j + 1 < NT) { asm volatile("s_waitcnt vmcnt(0)" ::: "memory"); MLA_SWRITE(cur ^ 1, vnext); }
        __syncthreads();
        vcur = vnext;
    }
    if (late && NT - 1 <= jw) { const int vlast = (vcur == 0) ? 2 : vcur - 1; MLA_SMPV(vlast); }
    __syncthreads();
#undef MLA_SMPV
#undef MLA_SLOAD
#undef MLA_SWRITE
    if (hi == 0) li_l[r32] = l_reg; asm volatile("s_waitcnt lgkmcnt(0)" ::: "memory");
    bf16* Ow = O + (tok0 + q0 + wid * 32) * 1024 + hd * 128 + r32;
#pragma unroll
    for (int r = 0; r < 16; ++r) { const float rl = __builtin_amdgcn_rcpf(li_l[crow(r, hi)]); const int orow = crow(r, hi);
#pragma unroll
        for (int d0 = 0; d0 < 4; ++d0) Ow[(size_t)orow * 1024 + d0 * 32] = (bf16)(cvtpk(o[d0][r] * rl, 0.f) & 0xffffu); }
}

typedef int v8i __attribute__((ext_vector_type(8)));
typedef int v4i __attribute__((ext_vector_type(4)));
constexpr int L8_K = 0, L8_V = 3 * 13312;
static_assert(L8_V + 3 * 10240 <= L_WS, "fp8 MLA LDS map");
#define MFMA8_32(accv, A, B) asm volatile("s_nop 4\n\tv_mfma_scale_f32_32x32x64_f8f6f4 %0, %1, %2, %0, %3, %3 op_sel_hi:[0,0,0]" : "+v"(accv) : "v"(A), "v"(B), "v"(one_scale))
#define MFMA8_32_Z(accv, A, B) asm volatile("s_nop 4\n\tv_mfma_scale_f32_32x32x64_f8f6f4 %0, %1, %2, 0, %3, %3 op_sel_hi:[0,0,0]" : "=&v"(accv) : "v"(A), "v"(B), "v"(one_scale))
#define MFMA8_32_LAST(accv, A, B) asm volatile("s_nop 1\n\tv_mfma_scale_f32_32x32x64_f8f6f4 %0, %1, %2, %0, %3, %3 op_sel_hi:[0,0,0]\n\ts_nop 15\n\ts_nop 15" : "+v"(accv) : "v"(A), "v"(B), "v"(one_scale))
__device__ __forceinline__ v8i ld32(const ATT_LAS char* p) { const v4i a = *(const ATT_LAS v4i*)p, b = *(const ATT_LAS v4i*)(p + 16); return __builtin_shufflevector(a, b, 0, 1, 2, 3, 4, 5, 6, 7); }
__device__ __forceinline__ unsigned pk4f8(float a, float b, float c, float d) { int w = __builtin_amdgcn_cvt_pk_fp8_f32(a, b, 0, false); w = __builtin_amdgcn_cvt_pk_fp8_f32(c, d, w, true); return (unsigned)w; }
__device__ __forceinline__ void softmax_tile8(f32x16& p0, f32x16& p1, float& m_reg, float& l_reg, float& alpha) {
    float pmax = p0[0];
#pragma unroll
    for (int r = 1; r < 16; ++r) pmax = fmaxf(pmax, p0[r]);
#pragma unroll
    for (int r = 0; r < 16; ++r) pmax = fmaxf(pmax, p1[r]);
    { auto rr = __builtin_amdgcn_permlane32_swap(__float_as_uint(pmax), __float_as_uint(pmax), false, false); pmax = fmaxf(__uint_as_float(rr[0]), __uint_as_float(rr[1])); }
    float mn;
    if (__builtin_expect(__all(pmax - m_reg <= 128.f), 1)) { mn = m_reg; alpha = 1.f; }
    else { mn = fmaxf(m_reg, pmax); alpha = __builtin_amdgcn_exp2f((m_reg - mn) * 0.0625f); m_reg = mn; }
    float ps = 0.f; const float mb = mn * 0.0625f;
#pragma unroll
    for (int r = 0; r < 16; ++r) { p0[r] = __builtin_amdgcn_exp2f(p0[r] * 0.0625f - mb); ps += p0[r]; }
#pragma unroll
    for (int r = 0; r < 16; ++r) { p1[r] = __builtin_amdgcn_exp2f(p1[r] * 0.0625f - mb); ps += p1[r]; }
    { auto rr = __builtin_amdgcn_permlane32_swap(__float_as_uint(ps), __float_as_uint(ps), false, false); ps = __uint_as_float(rr[0]) + __uint_as_float(rr[1]); }
    l_reg = l_reg * alpha + ps;
}
__device__ __forceinline__ void mla8_unit(ATT_LAS char* lds, const unsigned char* __restrict__ Q8, const unsigned char* __restrict__ K8T, const unsigned char* __restrict__ VT8T, bf16* __restrict__ O, int b, int hd, int qb) {
    int tid_ = threadIdx.x; asm volatile("" : "+v"(tid_));
    const int tid = tid_, wid = __builtin_amdgcn_readfirstlane(tid >> 6), lane = tid & 63, r32 = lane & 31, hi = lane >> 5;
    ATT_LAS char* Kl = lds + L8_K; ATT_LAS char* Vl = lds + L8_V; ATT_LAS float* li_l = (ATT_LAS float*)(lds + L_WS) + wid * 64; ATT_LAS float* al_l = li_l + 32;
    const size_t tok0 = (size_t)b * S; const int q0 = qb * 256;
    const int one_scale = 0x7F7F7F7F;
    v8i qr[3];
    { const unsigned char* Qw = Q8 + (tok0 + q0 + wid * 32 + r32) * 1536 + hd * 192 + hi * 32;
#pragma unroll
      for (int d = 0; d < 3; ++d) { const v4i a = *(const v4i*)(Qw + 64 * d), c = *(const v4i*)(Qw + 64 * d + 16); qr[d] = __builtin_shufflevector(a, c, 0, 1, 2, 3, 4, 5, 6, 7); } }
    float m_reg = -1e30f, l_reg = 0.f; f32x16 o[4] = {};
    const int NT = 4 * qb + 4, jw = 4 * qb + (wid >> 1);
    if (wid >= 4) __builtin_amdgcn_s_setprio(1);
    const unsigned char* kt = K8T + (size_t)((b * 8 + hd) * 64) * 13312 + lane * 16;
    const unsigned char* vt = VT8T + (size_t)((b * 8 + hd) * 64) * 10240 + lane * 16;
#define M8_DMA(j, slot) do { _Pragma("unroll") for (int i_ = 0; i_ < 3; ++i_) { int p_ = wid + 8 * i_; p_ = p_ > 22 ? 22 : p_; \
        if (p_ < 13) __builtin_amdgcn_global_load_lds((const unsigned*)(kt + (size_t)(j) * 13312 + p_ * 1024), (ATT_LAS unsigned*)(Kl + (slot) * 13312 + p_ * 1024), 16, 0, 0); \
        else __builtin_amdgcn_global_load_lds((const unsigned*)(vt + (size_t)(j) * 10240 + (p_ - 13) * 1024), (ATT_LAS unsigned*)(Vl + (slot) * 10240 + (p_ - 13) * 1024), 16, 0, 0); } } while (0)
    M8_DMA(0, 0); M8_DMA(1, 1);
    int slot = 0;
    for (int j = 0; j < NT; ++j) {
        if (j + 1 < NT) asm volatile("s_waitcnt vmcnt(3)" ::: "memory"); else asm volatile("s_waitcnt vmcnt(0)" ::: "memory");
        __builtin_amdgcn_s_barrier(); asm volatile("" ::: "memory");
        const int s2 = (slot == 0) ? 2 : slot - 1;
        if (j + 2 < NT) M8_DMA(j + 2, s2);
        if (j <= jw) {
            f32x16 p0, p1;
            const ATT_LAS char* kb = Kl + slot * 13312 + r32 * 208 + hi * 32;
            const ATT_LAS char* vbp = Vl + slot * 10240 + r32 * 80 + hi * 32;
            v8i ka[3], kc[3], vf[4];
#pragma unroll
            for (int d = 0; d < 3; ++d) { ka[d] = ld32(kb + 64 * d); kc[d] = ld32(kb + 32 * 208 + 64 * d); }
            MFMA8_32_Z(p0, ka[0], qr[0]); MFMA8_32_Z(p1, kc[0], qr[0]);
#pragma unroll
            for (int d = 1; d < 3; ++d) { MFMA8_32(p0, ka[d], qr[d]); MFMA8_32(p1, kc[d], qr[d]); }
#pragma unroll
            for (int d0 = 0; d0 < 4; ++d0) vf[d0] = ld32(vbp + d0 * 32 * 80);
            asm volatile("s_nop 15\n\ts_nop 15" : "+v"(p0), "+v"(p1));
            float alpha; softmax_tile8(p0, p1, m_reg, l_reg, alpha);
            if (__any(alpha < 1.f)) { if (hi == 0) al_l[r32] = alpha; asm volatile("s_waitcnt lgkmcnt(0)" ::: "memory");
#pragma unroll
                for (int d = 0; d < 4; ++d)
#pragma unroll
                    for (int r = 0; r < 16; ++r) o[d][r] *= al_l[crow(r, hi)]; }
            v8i pf;
#pragma unroll
            for (int g = 0; g < 4; ++g) { const unsigned ag = pk4f8(p0[4 * g], p0[4 * g + 1], p0[4 * g + 2], p0[4 * g + 3]), bg = pk4f8(p1[4 * g], p1[4 * g + 1], p1[4 * g + 2], p1[4 * g + 3]);
                auto rr = __builtin_amdgcn_permlane32_swap(ag, bg, false, false); pf[2 * g] = (int)rr[0]; pf[2 * g + 1] = (int)rr[1]; }
#pragma unroll
            for (int d0 = 0; d0 < 4; ++d0) MFMA8_32(o[d0], pf, vf[d0]);
            asm volatile("s_nop 15\n\ts_nop 15" : "+v"(o[0]), "+v"(o[1]), "+v"(o[2]), "+v"(o[3]));
        }
        slot = (slot == 2) ? 0 : slot + 1;
    }
#undef M8_DMA
    __builtin_amdgcn_s_setprio(0);
    __builtin_amdgcn_s_barrier(); asm volatile("" ::: "memory");
    if (hi == 0) li_l[r32] = l_reg; asm volatile("s_waitcnt lgkmcnt(0)" ::: "memory");
    float rl[16];
#pragma unroll
    for (int r = 0; r < 16; ++r) rl[r] = __builtin_amdgcn_rcpf(li_l[crow(r, hi)]);
    store_o_tile(lds + wid * 8704, o, rl, O + (tok0 + q0 + wid * 32) * 1024 + hd * 128, lane, r32, hi);
    __builtin_amdgcn_s_barrier(); asm volatile("" ::: "memory");
}

__device__ __forceinline__ void sb_unit(ATT_LAS char* lds, volatile ATT_LAS unsigned* done, unsigned seq, const bf16* __restrict__ Q, const bf16* __restrict__ K, const bf16* __restrict__ V, bf16* __restrict__ O, int b, int hd, int qb) {
    int tid_ = threadIdx.x; asm volatile("" : "+v"(tid_));
    const int tid = tid_, wid = __builtin_amdgcn_readfirstlane(tid >> 6), lane = tid & 63, r32 = lane & 31, hi = lane >> 5;
    ATT_LAS char* Vl = lds + L_V; ATT_LAS char* Kl = lds + L_K;
    const size_t tok0 = (size_t)b * S; const int q0 = qb * 256;
    bf16x8 qr[8];
    { const bf16* Qw = Q + (tok0 + q0 + wid * 32 + r32) * 1024 + hd * 128 + hi * 8;
#pragma unroll
      for (int d0 = 0; d0 < 8; ++d0) qr[d0] = *(const bf16x8*)(Qw + d0 * 16); }
    float carry = 1.f; f32x16 o[4] = {}; bool wdone = false;
    if (wid >= 4) __builtin_amdgcn_s_setprio(1);
    const int NT = 4 * qb + 4, jw = 4 * qb + (wid >> 1), lim = 32 * (wid & 1) + r32;
    const int sr = tid >> 4, sc = (tid & 15) * 8, vst0 = v_st(sr, sc), vst1 = v_st(32 + sr, sc), kst0 = sr * KP_SB + sc * 2, kst1 = (32 + sr) * KP_SB + sc * 2;
    const bf16* vsrc = V + (tok0 + sr) * 1024 + hd * 128 + sc; const bf16* ksrc = K + (tok0 + sr) * 1024 + hd * 128 + sc;
    const int vb0 = (int)(uintptr_t)Vl + v_rd_base(lane);
    bf16x8 vs0, vs1, ks0, ks1;
#define SB_SLOAD(j) do { vs0 = *(const bf16x8*)(vsrc + (size_t)(j) * 65536); vs1 = *(const bf16x8*)(vsrc + (size_t)(j) * 65536 + 32 * 1024); \
        ks0 = *(const bf16x8*)(ksrc + (size_t)(j) * 65536); ks1 = *(const bf16x8*)(ksrc + (size_t)(j) * 65536 + 32 * 1024); } while (0)
#define SB_SWRITE(bf) do { *(ATT_LAS bf16x8*)(Vl + (bf) * 16384 + vst0) = vs0; *(ATT_LAS bf16x8*)(Vl + (bf) * 16384 + vst1) = vs1; \
        *(ATT_LAS bf16x8*)(Kl + (bf) * KT_SB + kst0) = ks0; *(ATT_LAS bf16x8*)(Kl + (bf) * KT_SB + kst1) = ks1; } while (0)
    SB_SLOAD(NT - 1); asm volatile("s_waitcnt vmcnt(0)" ::: "memory"); SB_SWRITE(0); __syncthreads();
    for (int it = 0; it < NT; ++it) {
        const int cur = it & 1, j = NT - 1 - it;
        if (it + 1 < NT) SB_SLOAD(j - 1);
        if (j <= jw && !wdone) {
            f32x16 p0, p1, r0, r1;
            qkt<8, KP_SB>(p0, p1, Kl + cur * KT_SB, qr, r32, hi);
#pragma unroll
            for (int r = 0; r < 16; ++r) { const float e0 = __builtin_amdgcn_exp2f(fminf(p0[r], 64.f)), e1 = __builtin_amdgcn_exp2f(fminf(p1[r], 64.f));
                r0[r] = __builtin_amdgcn_rcpf(1.0f + e0); r1[r] = __builtin_amdgcn_rcpf(1.0f + e1); p0[r] = e0 * r0[r]; p1[r] = e1 * r1[r]; }
            if (j == jw) {
#pragma unroll
                for (int r = 0; r < 16; ++r) { const int key = crow(r, hi); if (key >= lim) { r0[r] = 1.f; p0[r] = 0.f; } if (key + 32 >= lim) { r1[r] = 1.f; p1[r] = 0.f; } }
            }
            float T[8], U[8], Tp[8];
#pragma unroll
            for (int g = 0; g < 4; ++g) {
                { const float a0 = r0[4 * g], a1 = r0[4 * g + 1], a2 = r0[4 * g + 2], a3 = r0[4 * g + 3]; const float x2 = a3, x1 = x2 * a2, x0 = x1 * a1; T[g] = x0 * a0; r0[4 * g] = x0; r0[4 * g + 1] = x1; r0[4 * g + 2] = x2; r0[4 * g + 3] = 1.f; }
                { const float a0 = r1[4 * g], a1 = r1[4 * g + 1], a2 = r1[4 * g + 2], a3 = r1[4 * g + 3]; const float x2 = a3, x1 = x2 * a2, x0 = x1 * a1; T[4 + g] = x0 * a0; r1[4 * g] = x0; r1[4 * g + 1] = x1; r1[4 * g + 2] = x2; r1[4 * g + 3] = 1.f; }
            }
#pragma unroll
            for (int g = 0; g < 8; ++g) { auto rr = __builtin_amdgcn_permlane32_swap(__float_as_uint(T[g]), __float_as_uint(T[g]), false, false); const float ta = __uint_as_float(rr[0]), tb = __uint_as_float(rr[1]); U[g] = ta * tb; Tp[g] = hi ? 1.f : tb; }
            float W = carry;
#pragma unroll
            for (int g = 7; g >= 0; --g) { const float F = W * Tp[g];
                if (g >= 4) { const int q = g - 4;
#pragma unroll
                    for (int e = 0; e < 4; ++e) p1[4 * q + e] *= r1[4 * q + e] * F; }
                else {
#pragma unroll
                    for (int e = 0; e < 4; ++e) p0[4 * g + e] *= r0[4 * g + e] * F; }
                W *= U[g]; }
            carry = W;
            bf16x8 pa0, pa1, pa2, pa3; pack_p(p0, p1, pa0, pa1, pa2, pa3); SBAR();
            pv_d0(o, vb0 + cur * 16384, pa0, pa1, pa2, pa3);
            wdone = __all(carry == 0.f);
        }
        if (wdone && lane == 0) done[(it & 1) * 8 + wid] = seq;
        if (it + 1 < NT) { asm volatile("s_waitcnt vmcnt(0)" ::: "memory"); SB_SWRITE(cur ^ 1); }
        __syncthreads();
        { const unsigned dv = (lane < 8) ? done[(it & 1) * 8 + lane] : seq; if (__all(dv == seq)) break; }
    }
#undef SB_SLOAD
#undef SB_SWRITE
    __builtin_amdgcn_s_setprio(0);
    store_o_tile(lds + wid * 8704, o, nullptr, O + (tok0 + q0 + wid * 32) * 1024 + hd * 128, lane, r32, hi);
    __syncthreads();
}
__device__ __forceinline__ void unit_of(int u, int& b, int& hd, int& qb) { const int bh = (u & 255) >> 2, s = u & 3, k = u >> 8; b = bh >> 3; hd = bh & 7; qb = (k == 0) ? s : (k == 1) ? 7 - s : (k == 2) ? 8 + s : 15 - s; }
}

#define LAS __attribute__((address_space(3)))
#define GAS __attribute__((address_space(1)))
constexpr int NWAVES = 8;
constexpr int RING_BYTES = 131072, LDSCTL_OFF = RING_BYTES, LDS_BYTES = 147456; static_assert(pg8::TOUCH_SINK >= LDSCTL_OFF + 1024 && pg8::TOUCH_SINK + 256 <= LDS_BYTES, "touch sink");
constexpr int LC_PTR = 0, LC_BAR = 96, LC_SBDONE = 128;

#define XB_TMO      128
#define XB_XCNT(j)  (256  + 64 * (j))
#define XB_XSUB(j)  (1280 + 64 * (j))
#define XB_XGEN(j)  (2304 + 64 * (j))
#define XB_TOP      3328
#define XB_TOPGEN   3392
#define XCD_BAR_WORDS 3456
#define XB_SPIN_CAP (1u << 18)

__device__ __forceinline__ unsigned xb_ld(unsigned* p)              { return __hip_atomic_load(p, __ATOMIC_RELAXED, __HIP_MEMORY_SCOPE_AGENT); }
__device__ __forceinline__ unsigned xb_add(unsigned* p, unsigned v) { return __hip_atomic_fetch_add(p, v, __ATOMIC_RELAXED, __HIP_MEMORY_SCOPE_AGENT); }
__device__ __forceinline__ unsigned xb_xcc_id() { return (unsigned)__builtin_amdgcn_s_getreg((3 << 11) | 20) & 0xFu; }
#define XB_SPIN(cond, bar) do { unsigned _sp = 0; while (cond) { __builtin_amdgcn_s_sleep(1); \
    if ((++_sp & 255u) == 0u) { if (xb_ld(&(bar)[XB_TMO])) break; if (_sp > XB_SPIN_CAP) { atomicAdd(&(bar)[XB_TMO], 1u); break; } } } } while (0)

struct XcdBarrier {
    unsigned* bar; unsigned x;
    volatile LAS unsigned* st;
};

__device__ __forceinline__ XcdBarrier xcd_barrier_post(unsigned* bar, volatile LAS unsigned* st) {
    XcdBarrier b; b.bar = bar; b.x = xb_xcc_id(); b.st = st;
    if (threadIdx.x == 0) (void)xb_add(&bar[XB_XCNT(b.x)], 1u);
    return b;
}
__device__ __forceinline__ void xcd_barrier_complete(unsigned* bar, unsigned x, unsigned& nloc, unsigned& nx) {
    const unsigned G = gridDim.x * gridDim.y * gridDim.z;
    unsigned sum, cnt, mine, sp = 0u;
    for (;;) {
        sum = 0u; cnt = 0u; mine = 0u;
#pragma unroll
        for (unsigned j = 0; j < 16; ++j) { const unsigned c = xb_ld(&bar[XB_XCNT(j)]); sum += c; cnt += (c > 0u) ? 1u : 0u; mine = (j == x) ? c : mine; }
        if (sum == G) break;
        __builtin_amdgcn_s_sleep(1);
        if ((++sp & 255u) == 0u) { if (xb_ld(&bar[XB_TMO])) break; if (sp > XB_SPIN_CAP) { atomicAdd(&bar[XB_TMO], 1u); break; } }
    }
    nloc = mine > 0u ? mine : 1u; nx = cnt > 0u ? cnt : 1u;
}

__device__ __forceinline__ void xcd_barrier(const XcdBarrier& b) {
    asm volatile("s_waitcnt vmcnt(0)" ::: "memory");
    __syncthreads();
    if (threadIdx.x == 0) {
        unsigned* bar = b.bar;
        __builtin_amdgcn_s_waitcnt(0);
        unsigned nloc = b.st[0], nx = b.st[1];
        if (nloc == 0u) { xcd_barrier_complete(bar, b.x, nloc, nx); b.st[0] = nloc; b.st[1] = nx; }
        const unsigned old = xb_add(&bar[XB_XSUB(b.x)], 1u);
        const unsigned gen = old / nloc;
        if (old + 1u == (gen + 1u) * nloc) {
            __builtin_amdgcn_fence(__ATOMIC_RELEASE, "agent");
            asm volatile("s_waitcnt vmcnt(0)" ::: "memory");
            const unsigned og = xb_add(&bar[XB_TOP], 1u);
            const unsigned tg = og / nx;
            if (og + 1u == (tg + 1u) * nx) xb_add(&bar[XB_TOPGEN], 1u);
            else XB_SPIN(xb_ld(&bar[XB_TOPGEN]) == tg, bar);
            __builtin_amdgcn_fence(__ATOMIC_ACQUIRE, "agent");
            xb_add(&bar[XB_XGEN(b.x)], 1u);
            asm volatile("s_waitcnt vmcnt(0)" ::: "memory");
        } else {
            XB_SPIN(xb_ld(&bar[XB_XGEN(b.x)]) == gen, bar);
            __builtin_amdgcn_fence(__ATOMIC_ACQUIRE, "agent");
            asm volatile("s_waitcnt vmcnt(0)" ::: "memory");
        }
    }
    __syncthreads();
}


constexpr int PH_PRO = 0;
__host__ __device__ constexpr int PH(int l, int k) { return 1 + l * 10 + k; }
constexpr int PH_END = PH(3, 8) + 1;

struct MatDesc { int in_idx, gain_idx, K, N, mode, rowoff; long long src_off; long long dst_off; };
constexpr long long WSM = (long long)WS_WSMALL, WMO = (long long)WS_WMOE;
constexpr long long OFF_WD0 = WSM, OFF_WUQ0 = OFF_WD0 + 768LL * 1024 * 2, OFF_WUKV0 = OFF_WUQ0 + 1536LL * 384 * 2, OFF_WO0 = OFF_WUKV0 + 2048LL * 256 * 2;
constexpr long long OFF_WD1 = OFF_WO0 + 1024LL * 1024 * 2, OFF_WUQ1 = OFF_WD1 + 768LL * 1024 * 2, OFF_WUKV1 = OFF_WUQ1 + 1536LL * 384 * 2, OFF_WO1 = OFF_WUKV1 + 2048LL * 256 * 2;
constexpr long long OFF_WGU0 = OFF_WO1 + 1024LL * 1024 * 2, OFF_WDN0 = OFF_WGU0 + 5632LL * 1024 * 2;
constexpr long long OFF_WGU2 = OFF_WDN0 + 1024LL * 2816 * 2, OFF_WDN2 = OFF_WGU2 + 5632LL * 1024 * 2;
constexpr long long OFF_WKVQ = OFF_WDN2 + 1024LL * 2816 * 2, OFF_WQ3 = OFF_WKVQ + 3072LL * 1024 * 2, OFF_WO2 = OFF_WQ3 + 1024LL * 1024 * 2, OFF_WO3 = OFF_WO2 + 1024LL * 1024 * 2;
constexpr long long OFF_WSM_END = OFF_WO3 + 1024LL * 1024 * 2;
static_assert(OFF_WSM_END <= (long long)WS_WMOE, "small weights fit");
constexpr long long MOE_GU_BYTES = 5632LL * 1024, MOE_DN_BYTES = 1024LL * 2816;
constexpr long long OFF_MGU = WMO, OFF_MDN = WMO + 8 * MOE_GU_BYTES;
constexpr int NMAT_SMALL = 18;
__device__ const MatDesc g_mats[NMAT_SMALL] = {
    {3, 2, 1024, 704, 1, 0, 0, OFF_WD0}, {5, 4, 384, 1536, 2, 0, 0, OFF_WUQ0}, {7, 6, 256, 2048, 4, 0, 0, OFF_WUKV0}, {8, -1, 1024, 1024, 0, 0, 0, OFF_WO0},
    {13, 12, 1024, 704, 1, 0, 0, OFF_WD1}, {15, 14, 384, 1536, 2, 0, 0, OFF_WUQ1}, {17, 16, 256, 2048, 4, 0, 0, OFF_WUKV1}, {18, -1, 1024, 1024, 0, 0, 0, OFF_WO1},
    {10, 9, 1024, 5632, 3, 0, 0, OFF_WGU0}, {11, -1, 2816, 1024, 0, 0, 0, OFF_WDN0},
    {29, 28, 1024, 5632, 3, 0, 0, OFF_WGU2}, {30, -1, 2816, 1024, 0, 0, 0, OFF_WDN2},
    {24, 23, 1024, 2048, 0, 0, 0, OFF_WKVQ}, {26, 25, 1024, 1024, 0, 2048, 0, OFF_WKVQ}, {32, 31, 1024, 1024, 0, 0, 0, OFF_WQ3},
    {27, -1, 1024, 1024, 0, 0, 0, OFF_WO2}, {33, -1, 1024, 1024, 0, 0, 0, OFF_WO3},
    {3, 2, 0, 0, 9, 0, 0, OFF_WD0}
};
__device__ __forceinline__ int map_row(int mode, int n) {
    if (mode == 1) { return n < 640 ? n : (n < 672 ? 640 + 2 * (n - 640) : 641 + 2 * (n - 672)); }
    if (mode == 2) { const int hd = n / 192, d = n - hd * 192; return d < 128 ? n : (d < 160 ? hd * 192 + 128 + 2 * (d - 128) : hd * 192 + 129 + 2 * (d - 160)); }
    if (mode == 4) { const int hd = n >> 8, d = n & 255; return d < 128 ? hd * 128 + d : 1024 + hd * 128 + (d - 128); }
    if (mode == 3) { if (n < 2816) return 256 * (n >> 7) + (n & 127); const int n2 = n - 2816; return 256 * (n2 >> 7) + 128 + (n2 & 127); }
    return n;
}
typedef unsigned v4u __attribute__((ext_vector_type(4)));
struct ConvJob { const float* W; const float* gain; bf16* WT; int K, N, mode, rowoff, k0, n0; int f8; float wscale; int tiled; int pad; };
constexpr int CONV_PITCH = 129, SMALL_ITEMS = 2 * (48 + 36 + 32 + 64) + 2 * (352 + 176) + 128 + 64 + 64 + 64 + 64, MOE_ITEMS_E = 352 + 176, MOE_ITEMS = NE * MOE_ITEMS_E;
__device__ __forceinline__ void conv_load(const ConvJob& J, int t, f32x4 (&v)[8], float (&gk)[8]) {
    const int lane = t & 63, wave = t >> 6, n = J.n0 + 4 * ((lane & 7) + 8 * (wave & 3)), r0 = (wave >> 2) * 8 + (lane >> 3);
#pragma unroll
    for (int i = 0; i < 8; ++i) { const int k = J.k0 + r0 + 16 * i;
        v[i] = (n < J.N) ? __builtin_nontemporal_load((const f32x4*)(J.W + (size_t)k * J.N + n)) : (f32x4){0.f, 0.f, 0.f, 0.f};
        gk[i] = (J.gain ? J.gain[k] : 1.0f) * J.wscale; }
}
__device__ __forceinline__ void conv_to_lds(LAS float* scr, int t, const f32x4 (&v)[8], const float (&gk)[8]) {
    const int lane = t & 63, wave = t >> 6, c = 4 * ((lane & 7) + 8 * (wave & 3)), r0 = (wave >> 2) * 8 + (lane >> 3);
#pragma unroll
    for (int i = 0; i < 8; ++i) { LAS float* p = scr + (r0 + 16 * i) * CONV_PITCH + c; const f32x4 x = v[i] * gk[i]; p[0] = x[0]; p[1] = x[1]; p[2] = x[2]; p[3] = x[3]; }
}
__device__ __forceinline__ void conv_store(const ConvJob& J, const LAS float* scr, int t) {
    if (J.f8) {
        const int c = t >> 6, n_l = t & 63;
#pragma unroll
        for (int jj = 0; jj < 2; ++jj) { const int n = n_l + 64 * jj;
            if (J.n0 + n < J.N) { const LAS float* sp = scr + (16 * c) * CONV_PITCH + n;
                v4u o;
                o.x = pg8::pk4_fp8_nc(sp[0 * CONV_PITCH], sp[1 * CONV_PITCH], sp[2 * CONV_PITCH], sp[3 * CONV_PITCH]); o.y = pg8::pk4_fp8_nc(sp[4 * CONV_PITCH], sp[5 * CONV_PITCH], sp[6 * CONV_PITCH], sp[7 * CONV_PITCH]);
                o.z = pg8::pk4_fp8_nc(sp[8 * CONV_PITCH], sp[9 * CONV_PITCH], sp[10 * CONV_PITCH], sp[11 * CONV_PITCH]); o.w = pg8::pk4_fp8_nc(sp[12 * CONV_PITCH], sp[13 * CONV_PITCH], sp[14 * CONV_PITCH], sp[15 * CONV_PITCH]);
                const int row = J.rowoff + map_row(J.mode, J.n0 + n), k = J.k0 + 16 * c;
                if (J.tiled) *(v4u*)((unsigned char*)J.WT + (((size_t)(row >> 8) * (J.K >> 7) + (k >> 7)) * 256 + (row & 255)) * 128 + (k & 127)) = o;
                else *(v4u*)((unsigned char*)J.WT + (size_t)row * J.K + k) = o; } }
        return;
    }
    const int c_lo = t & 7, n_l = t >> 3;
#pragma unroll
    for (int jj = 0; jj < 4; ++jj) { const int n = n_l + 64 * (jj >> 1), c = c_lo + 8 * (jj & 1);
        if (J.n0 + n < J.N) { const LAS float* sp = scr + (8 * c) * CONV_PITCH + n;
            v4u o; o.x = pk2(sp[0 * CONV_PITCH], sp[1 * CONV_PITCH]); o.y = pk2(sp[2 * CONV_PITCH], sp[3 * CONV_PITCH]); o.z = pk2(sp[4 * CONV_PITCH], sp[5 * CONV_PITCH]); o.w = pk2(sp[6 * CONV_PITCH], sp[7 * CONV_PITCH]);
            const int row = J.rowoff + map_row(J.mode, J.n0 + n), k = J.k0 + 8 * c;
            if (J.tiled) *(v4u*)(J.WT + (((size_t)(row >> 8) * (J.K >> 6) + (k >> 6)) * 256 + (row & 255)) * 64 + (k & 63)) = o;
            else *(v4u*)(J.WT + (size_t)row * J.K + k) = o; } }
}

#ifndef SITES
#define SITES 0xffff
#endif
#define SITE(n) (((SITES) >> (n)) & 1)
#ifndef REPEAT
#define REPEAT -1
#endif
#define DUMMY(k) ((REPEAT == (k)) && rep_ == 0)
#define REP(k) for (int rep_ = 0; rep_ < ((REPEAT == (k)) ? 2 : 1); ++rep_)

#define RLX_AGENT __ATOMIC_RELAXED, __HIP_MEMORY_SCOPE_AGENT
__device__ __forceinline__ void prep_row(const float* __restrict__ x, const int* __restrict__ pos, bf16* __restrict__ hb, float* __restrict__ ss, float2* __restrict__ cs, int m, int lane) {
    const f32x4* xr = (const f32x4*)(x + (size_t)m * D) + lane;
    float s = 0.f;
#pragma unroll
    for (int j = 0; j < 4; ++j) { const f32x4 v = __builtin_nontemporal_load(xr + 64 * j); s += (v.x * v.x + v.y * v.y) + (v.z * v.z + v.w * v.w);
        u32x2 o; o.x = pk2(v.x, v.y); o.y = pk2(v.z, v.w); *((u32x2*)(hb + (size_t)m * D) + lane + 64 * j) = o; }
    s = wave_sum(s);
    if (lane < 16) ss[(size_t)m * 16 + lane] = (lane == 0) ? s : 0.f;
    if (lane < 32) {
        const float inv_freq = 1.0f / powf(10000.0f, (float)(2 * lane) / 64.0f);
        const float ang = (float)pos[m] * inv_freq;
        double t = (double)ang * 0.15915494309189535; t -= floor(t);
        const float a = (float)(t * 6.283185307179586);
        cs[(size_t)m * 32 + lane] = make_float2(cosf(a), sinf(a));
    }
}
__device__ __forceinline__ void router_load(LAS float* T, const float* __restrict__ gain, const float* __restrict__ R, int tid) {
    for (int i = tid; i < 1024; i += NWAVES * 64) { const int jq = i >> 6, ln = i & 63, k = 4 * ln + 256 * (jq >> 2) + (jq & 3); const float g = gain[k];
        const f32x4 r0 = *(const f32x4*)(R + (size_t)k * NE), r1 = *(const f32x4*)(R + (size_t)k * NE + 4);
        *(LAS f32x4*)(T + (size_t)i * 8) = r0 * g; *(LAS f32x4*)(T + (size_t)i * 8 + 4) = r1 * g; }
}
__device__ __forceinline__ void route_dot4(const LAS float* T, const u32x2 (&hw)[4][4], int lane, float (&acc)[4][NE]) {
#pragma unroll
    for (int r = 0; r < 4; ++r)
#pragma unroll
        for (int e = 0; e < NE; ++e) acc[r][e] = 0.f;
#pragma unroll
    for (int j = 0; j < 4; ++j)
#pragma unroll
        for (int q = 0; q < 4; ++q) { const LAS float* tp = T + (size_t)((4 * j + q) * 64 + lane) * 8; const f32x4 w0 = *(const LAS f32x4*)tp, w1 = *(const LAS f32x4*)(tp + 4);
#pragma unroll
            for (int r = 0; r < 4; ++r) { const unsigned wd = (q < 2) ? hw[r][j].x : hw[r][j].y; const float h = (q & 1) ? bf2f(wd >> 16) : bf2f(wd);
                acc[r][0] += h * w0[0]; acc[r][1] += h * w0[1]; acc[r][2] += h * w0[2]; acc[r][3] += h * w0[3]; acc[r][4] += h * w1[0]; acc[r][5] += h * w1[1]; acc[r][6] += h * w1[2]; acc[r][7] += h * w1[3]; } }
}
__device__ __forceinline__ void route_row(const float (&acc)[NE], float rstd, int lane, int& i1, int& i2, float& g1, float& g2) {
    const bool b0 = lane & 1, b1 = lane & 2, b2 = lane & 4;
    float w4[4], x2[2], y;
#pragma unroll
    for (int i = 0; i < 4; ++i) { const float snd = b0 ? acc[i] : acc[4 + i], kp = b0 ? acc[4 + i] : acc[i]; w4[i] = kp + __shfl_xor(snd, 1); }
#pragma unroll
    for (int i = 0; i < 2; ++i) { const float snd = b1 ? w4[i] : w4[2 + i], kp = b1 ? w4[2 + i] : w4[i]; x2[i] = kp + __shfl_xor(snd, 2); }
    { const float snd = b2 ? x2[0] : x2[1], kp = b2 ? x2[1] : x2[0]; y = kp + __shfl_xor(snd, 4); }
    y += __shfl_xor(y, 8); y += __shfl_xor(y, 16); y += __shfl_xor(y, 32);
    y *= rstd;
    float lg[NE];
#pragma unroll
    for (int e = 0; e < NE; ++e) lg[e] = __uint_as_float(__builtin_amdgcn_readlane(__float_as_uint(y), (e >> 2) + 2 * ((e >> 1) & 1) + 4 * (e & 1)));
    i1 = 0; float v1 = lg[0];
#pragma unroll
    for (int e = 1; e < NE; ++e) if (lg[e] > v1) { v1 = lg[e]; i1 = e; }
    i2 = -1; float v2 = -3.0e38f;
#pragma unroll
    for (int e = 0; e < NE; ++e) if (e != i1 && lg[e] > v2) { v2 = lg[e]; i2 = e; }
    const float e2 = __expf(v2 - v1); g1 = 1.0f / (1.0f + e2); g2 = e2 / (1.0f + e2);
}
template <bool FINAL>
__device__ __forceinline__ bool combine_rows2(const bf16* hbin, bf16* hbout, float* __restrict__ outf, const bf16* __restrict__ y, const int2* __restrict__ tokslot, float* __restrict__ ss, const float* __restrict__ gfin, int m0, int m1, int lane, int thr, int pass) {
    const int2 ta = tokslot[m0], tb = tokslot[m1];
    { const int mx_ = max(max(ta.x, ta.y), max(tb.x, tb.y)); const bool touch = __builtin_amdgcn_readfirstlane(mx_) >= thr;
      if (touch != (pass != 0)) return false; }
    u32x2 ha[4], hc[4], ya1[4], ya2[4], yb1[4], yb2[4];
#pragma unroll
    for (int j = 0; j < 4; ++j) { ha[j] = *((const u32x2*)(hbin + (size_t)m0 * D) + lane + 64 * j); hc[j] = *((const u32x2*)(hbin + (size_t)m1 * D) + lane + 64 * j); }
#pragma unroll
    for (int j = 0; j < 4; ++j) { ya1[j] = *((const u32x2*)(y + (size_t)ta.x * D) + lane + 64 * j); ya2[j] = *((const u32x2*)(y + (size_t)ta.y * D) + lane + 64 * j);
                                  yb1[j] = *((const u32x2*)(y + (size_t)tb.x * D) + lane + 64 * j); yb2[j] = *((const u32x2*)(y + (size_t)tb.y * D) + lane + 64 * j); }
#pragma unroll
    for (int t = 0; t < 2; ++t) {
        const int m = t ? m1 : m0; f32x4 v[4]; float s = 0.f;
#pragma unroll
        for (int j = 0; j < 4; ++j) { const u32x2 hw = t ? hc[j] : ha[j], a = t ? yb1[j] : ya1[j], c = t ? yb2[j] : ya2[j];
            v[j].x = bf2f(hw.x) + (bf2f(a.x) + bf2f(c.x)); v[j].y = bf2f(hw.x >> 16) + (bf2f(a.x >> 16) + bf2f(c.x >> 16)); v[j].z = bf2f(hw.y) + (bf2f(a.y) + bf2f(c.y)); v[j].w = bf2f(hw.y >> 16) + (bf2f(a.y >> 16) + bf2f(c.y >> 16));
            s += (v[j].x * v[j].x + v[j].y * v[j].y) + (v[j].z * v[j].z + v[j].w * v[j].w); }
        s = wave_sum(s);
        if (!FINAL) {
#pragma unroll
            for (int j = 0; j < 4; ++j) { u32x2 o; o.x = pk2(v[j].x, v[j].y); o.y = pk2(v[j].z, v[j].w); *((u32x2*)(hbout + (size_t)m * D) + lane + 64 * j) = o; }
            if (lane < 16) ss[(size_t)m * 16 + lane] = (lane == 0) ? s : 0.f;
        } else {
            const float rstd = rsqrtf(s * (1.0f / D) + EPS);
#pragma unroll
            for (int j = 0; j < 4; ++j) { const f32x4 g = *((const f32x4*)gfin + lane + 64 * j); *((f32x4*)(outf + (size_t)m * D) + lane + 64 * j) = v[j] * rstd * g; }
        }
    }
    return true;
}

__device__ __forceinline__ const float* inp_ptr(volatile LAS unsigned* LC, int i) { return (const float*)(((unsigned long long)(unsigned)__builtin_amdgcn_readfirstlane(LC[LC_PTR + 2 * i + 1]) << 32) | (unsigned long long)(unsigned)__builtin_amdgcn_readfirstlane(LC[LC_PTR + 2 * i])); }
__device__ __forceinline__ ConvJob conv_job(volatile LAS unsigned* LC, unsigned char* wsl, int id, int nsmall, int moe_wg, int moe_wd, int moe_gain) {
    ConvJob J;
    if (id < nsmall) {
        int mi = 0, rem = id;
        for (; mi < NMAT_SMALL - 1; ++mi) { const int it = (g_mats[mi].K >> 7) * ((g_mats[mi].N + 127) >> 7); if (rem < it) break; rem -= it; }
        const MatDesc d = g_mats[mi]; const int nn = (d.N + 127) >> 7;
        J.W = inp_ptr(LC, d.in_idx); J.gain = d.gain_idx >= 0 ? inp_ptr(LC, d.gain_idx) : nullptr; J.WT = (bf16*)(wsl + d.dst_off); J.K = d.K; J.N = d.N; J.mode = d.mode; J.rowoff = d.rowoff; J.k0 = (rem / nn) * 128; J.n0 = (rem % nn) * 128; J.tiled = (d.K == 2816) ? 1 : 0; J.f8 = (DENSE_DN_FP8 && d.K == 2816) ? 1 : 0; J.wscale = J.f8 ? 64.0f : 1.0f; J.pad = 0;
    } else {
        const int r = id - nsmall, e = r / MOE_ITEMS_E, q = r - e * MOE_ITEMS_E;
        if (q < 352) { J.W = inp_ptr(LC, moe_wg) + (size_t)e * 1024 * 5632; J.gain = inp_ptr(LC, moe_gain); J.WT = (bf16*)(wsl + OFF_MGU + e * MOE_GU_BYTES); J.K = 1024; J.N = 5632; J.mode = 3; J.rowoff = 0; J.k0 = (q / 44) * 128; J.n0 = (q % 44) * 128; }
        else { const int q2 = q - 352; J.W = inp_ptr(LC, moe_wd) + (size_t)e * 2816 * 1024; J.gain = nullptr; J.WT = (bf16*)(wsl + OFF_MDN + e * MOE_DN_BYTES); J.K = 2816; J.N = 1024; J.mode = 0; J.rowoff = 0; J.k0 = (q2 / 8) * 128; J.n0 = (q2 % 8) * 128; }
        J.f8 = 1; J.wscale = 64.0f; J.tiled = (q >= 352) ? 1 : 0; J.pad = 0;
    }
    return J;
}
__device__ __forceinline__ void conv_run(volatile LAS unsigned* LC, LAS unsigned char* lds, unsigned char* wsl, int cb, int Gs, int t, int nsmall, int total, int moe_wg, int moe_wd, int moe_gain) {
    LAS float* scr = (LAS float*)lds;
    int id = cb; bool have = id < total; ConvJob J{}; f32x4 v[8]; float gk[8];
#pragma unroll
    for (int i = 0; i < 8; ++i) { v[i] = (f32x4){0.f, 0.f, 0.f, 0.f}; gk[i] = 0.f; }
    if (have) { J = conv_job(LC, wsl, id, nsmall, moe_wg, moe_wd, moe_gain); conv_load(J, t, v, gk); }
    while (have) {
        conv_to_lds(scr, t, v, gk);
        __syncthreads();
        const int idn = id + Gs; const bool hn = idn < total; ConvJob Jn{};
        if (hn) { Jn = conv_job(LC, wsl, idn, nsmall, moe_wg, moe_wd, moe_gain); conv_load(Jn, t, v, gk); }
        conv_store(J, scr, t);
        __syncthreads();
        J = Jn; id = idn; have = hn;
    }
}

struct Args { const void* in[39]; float* out; unsigned char* ws; int ph_lo, ph_hi; };

#define INP(i) ((const float*)(((unsigned long long)(unsigned)__builtin_amdgcn_readfirstlane(LC[LC_PTR + 2 * (i) + 1]) << 32) | (unsigned long long)(unsigned)__builtin_amdgcn_readfirstlane(LC[LC_PTR + 2 * (i)])))
#define IN(k) (lo <= (k) && (k) < hi)
#define SEAM(k) do { if ((k) + 1 < hi) xcd_barrier(bar); } while (0)
#define SITE_BEGIN() int zz_; asm volatile("s_mov_b32 %0, 0" : "=s"(zz_)); unsigned char* wsl = args.ws + zz_; float* outl = args.out + zz_; const int cb = (int)blockIdx.x + zz_, Gs = (int)gridDim.x + zz_; \
    unsigned char* R0 = wsl + WS_R0; (void)R0; (void)outl
#define SSA(i) ((float*)(wsl + WS_SS) + (size_t)(i) * M * 16)
#define CSP ((const float2*)(wsl + WS_CS))
#define HBP ((bf16*)(wsl + WS_HB))

template <int l>
__device__ __forceinline__ void layer_phases(const Args& args, LAS unsigned char* lds, volatile LAS unsigned* LC, const XcdBarrier& bar, const int lo, const int hi) {
        if (l < 2) {
            if (SITE(1) && IN(PH(l, 0))) REP(1) {
                SITE_BEGIN();
                pg8::Gemm g{HBP, (const bf16*)(wsl + (l ? OFF_WD1 : OFF_WD0)), M, 768, 1024}; pg8::StaticOrder S; S.init(M, 768, Gs, cb);
                pg8::EpiDown E{SSA(0), CSP, (bf16*)(R0 + R_CQ), (bf16*)(R0 + R_CKV), (bf16*)(R0 + R_KR), SSA(2), SSA(3), MLA_FP8 ? R0 + R_K8T : nullptr};
                pg8::gemm_phase<pg8::EpiDown, pg8::StaticOrder, true, true>(lds, g, S, E);
                SEAM(PH(l, 0));
            }
            if (SITE(2) && IN(PH(l, 1))) REP(1) {
                if (MLA_FP8) {
                    { SITE_BEGIN();
                      pg8::Gemm g{(const bf16*)(R0 + R_CQ), (const bf16*)(wsl + (l ? OFF_WUQ1 : OFF_WUQ0)), M, 1536, 384}; pg8::StaticOrder S; S.init(M, 1536, Gs, cb);
                      pg8::EpiUq8 E{SSA(2), CSP, R0 + R_Q8, C2_MLA * 16.0f, 0};
                      pg8::gemm_phase<pg8::EpiUq8, pg8::StaticOrder, true, true>(lds, g, S, E); }
                    { SITE_BEGIN();
                      pg8::Gemm g{(const bf16*)(R0 + R_CKV), (const bf16*)(wsl + (l ? OFF_WUKV1 : OFF_WUKV0)), M, 1024, 256}; pg8::StaticOrder S; S.init(M, 1024, Gs, cb);
                      pg8::EpiKn8 E{SSA(3), R0 + R_K8T};
                      pg8::gemm_phase<pg8::EpiKn8, pg8::StaticOrder, true, true>(lds, g, S, E); }
                    { SITE_BEGIN();
                      pg8::Gemm g{(const bf16*)(wsl + (l ? OFF_WUKV1 : OFF_WUKV0)) + (size_t)1024 * 256, (const bf16*)(R0 + R_CKV), 1024, M, 256}; pg8::StaticOrder S; S.init(1024, M, Gs, cb);
                      pg8::EpiVt8 E{SSA(3), R0 + R_VT8T};
                      pg8::gemm_phase<pg8::EpiVt8, pg8::StaticOrder, true, true>(lds, g, S, E); }
                } else {
                { SITE_BEGIN();
                  pg8::Gemm g{(const bf16*)(R0 + R_CQ), (const bf16*)(wsl + (l ? OFF_WUQ1 : OFF_WUQ0)), M, 1536, 384}; pg8::StaticOrder S; S.init(M, 1536, Gs, cb);
                  pg8::EpiUq E{SSA(2), CSP, (bf16*)(R0 + R_Q), C2_MLA, 0};
                  pg8::gemm_phase<pg8::EpiUq, pg8::StaticOrder, true, true>(lds, g, S, E); }
                { SITE_BEGIN();
                  pg8::Gemm g{(const bf16*)(R0 + R_CKV), (const bf16*)(wsl + (l ? OFF_WUKV1 : OFF_WUKV0)), M, 2048, 256}; pg8::StaticOrder S; S.init(M, 2048, Gs, cb);
                  pg8::EpiProj E{SSA(3), (bf16*)(R0 + R_KN), (size_t)(R_V - R_KN) / 2, 1.0f, -1, 2, 1.0f / 256.0f, 0};
                  pg8::gemm_phase<pg8::EpiProj, pg8::StaticOrder, true, true>(lds, g, S, E); }
                }
                SEAM(PH(l, 1));
            }
            if (SITE(9) && IN(PH(l, 2))) REP(2) {
                SITE_BEGIN();
                const int vcu = (Gs % 8 == 0) ? (cb % 8) * (Gs / 8) + cb / 8 : cb;
                for (int u = vcu; u < 1024; u += Gs) { int b, hd, qb; att::unit_of(u, b, hd, qb);
                    if (MLA_FP8) att::mla8_unit((ATT_LAS char*)lds, R0 + R_Q8, R0 + R_K8T, R0 + R_VT8T, (bf16*)(R0 + R_O), b, hd, qb);
                    else att::mla_unit((ATT_LAS char*)lds, (const bf16*)(R0 + R_Q), (const bf16*)(R0 + R_KN), (const bf16*)(R0 + R_KR), (const bf16*)(R0 + R_V), (bf16*)(R0 + R_O), b, hd, qb); }
                SEAM(PH(l, 2));
            }
        } else {
            static_assert(R_VS - R_KS == R_QS - R_VS, "Ks|Vs|Qs equally spaced");
            if (SITE(3) && IN(PH(l, 0))) REP(7) {
                SITE_BEGIN();
                const int N = (l == 2) ? 3072 : 1024;
                pg8::Gemm g{HBP, (const bf16*)(wsl + (l == 2 ? OFF_WKVQ : OFF_WQ3)), M, N, 1024}; pg8::StaticOrder S; S.init(M, N, Gs, cb);
                pg8::EpiProj E{SSA(0), (bf16*)(R0 + ((l == 2) ? R_KS : R_QS)), (size_t)(R_VS - R_KS) / 2, C2_SB, (l == 2) ? 2 : 0, 4, 1.0f / 1024.0f, 0};
                pg8::gemm_phase<pg8::EpiProj, pg8::StaticOrder, true, true>(lds, g, S, E);
                SEAM(PH(l, 0));
            }
            if (SITE(10) && IN(PH(l, 2))) REP(3) {
                SITE_BEGIN();
                const int vcu = (Gs % 8 == 0) ? (cb % 8) * (Gs / 8) + cb / 8 : cb;
                for (int u = vcu; u < 1024; u += Gs) { int b, hd, qb; att::unit_of(u, b, hd, qb);
                    att::sb_unit((ATT_LAS char*)lds, (volatile ATT_LAS unsigned*)(LC + LC_SBDONE), (unsigned)(u + 1 + l * 4096), (const bf16*)(R0 + R_QS), (const bf16*)(R0 + R_KS), (const bf16*)(R0 + R_VS), (bf16*)(R0 + R_OS), b, hd, qb); }
                SEAM(PH(l, 2));
            }
        }
        if (SITE(4) && IN(PH(l, 3))) REP(11) {
            SITE_BEGIN();
            const long long wo = (l == 0) ? OFF_WO0 : (l == 1 ? OFF_WO1 : (l == 2 ? OFF_WO2 : OFF_WO3));
            pg8::Gemm g{(const bf16*)(R0 + (l < 2 ? R_O : R_OS)), (const bf16*)(wsl + wo), M, 1024, 1024}; pg8::StaticOrder S; S.init(M, 1024, Gs, cb);
            pg8::EpiRes E{HBP, DUMMY(11) ? (bf16*)(R0 + R_ACT) : HBP, DUMMY(11) ? SSA(2) : SSA(1), 1.0f, 0};
            pg8::gemm_phase<pg8::EpiRes, pg8::StaticOrder, true, true>(lds, g, S, E);
            SEAM(PH(l, 3));
        }
        const bool moe = (l & 1) != 0;
        if (SITE(11) && moe && IN(PH(l, 4))) REP(9) {
            SITE_BEGIN();
            int tid_ = threadIdx.x; asm volatile("" : "+v"(tid_));
            const int tid = tid_, lane = tid & 63, wave = __builtin_amdgcn_readfirstlane(tid >> 6);
            LAS int* lcnt = (LAS int*)lds; LAS int* gb = lcnt + 8; LAS int* le = lcnt + 16; LAS int* lp = le + 256; LAS float* lg = (LAS float*)(lp + 256);
            unsigned* cnt = (unsigned*)(wsl + WS_CTL) + CW_CNT + (l == 3 ? 64 : 0) + (DUMMY(9) ? 128 : 0);
            RInfo* rinfo = (RInfo*)(wsl + WS_RINFO);
            LAS float* RT = (LAS float*)(lds + 8192); router_load(RT, INP(l == 1 ? 19 : 34), INP(l == 1 ? 20 : 35), tid);
            for (int chunk = cb; chunk < M / 128; chunk += Gs) {
                if (tid < NE) lcnt[tid] = 0;
                __syncthreads();
                u32x2 hw[4][4], hn[4][4]; float ssc[4], ssn_[4];
#define RT_LOAD(dst, sdst, m_) do { const u32x2* hp_ = (const u32x2*)(HBP + (size_t)(m_) * D) + lane; dst[0] = hp_[0]; dst[1] = hp_[64]; dst[2] = hp_[128]; dst[3] = hp_[192]; sdst = sum16(SSA(1) + (size_t)(m_) * 16); } while (0)
#pragma unroll
                for (int r = 0; r < 4; ++r) RT_LOAD(hw[r], ssc[r], chunk * 128 + r * 8 + wave);
                for (int it = 0; it < 4; ++it) {
                    if (it < 3) {
#pragma unroll
                        for (int r = 0; r < 4; ++r) RT_LOAD(hn[r], ssn_[r], chunk * 128 + (4 * (it + 1) + r) * 8 + wave); }
                    float acc4[4][NE]; route_dot4(RT, hw, lane, acc4);
#pragma unroll
                    for (int r = 0; r < 4; ++r) { const int rl = (4 * it + r) * 8 + wave; int i1, i2; float g1, g2;
                        route_row(acc4[r], rsqrtf(ssc[r] * (1.0f / D) + EPS), lane, i1, i2, g1, g2);
                        if (lane == 0) { le[2 * rl] = i1; le[2 * rl + 1] = i2; lg[2 * rl] = g1; lg[2 * rl + 1] = g2; lp[2 * rl] = __hip_atomic_fetch_add(lcnt + i1, 1, __ATOMIC_RELAXED, __HIP_MEMORY_SCOPE_WORKGROUP); lp[2 * rl + 1] = __hip_atomic_fetch_add(lcnt + i2, 1, __ATOMIC_RELAXED, __HIP_MEMORY_SCOPE_WORKGROUP); } }
#pragma unroll
                    for (int r = 0; r < 4; ++r) {
#pragma unroll
                        for (int j = 0; j < 4; ++j) hw[r][j] = hn[r][j];
                        ssc[r] = ssn_[r]; }
                }
#undef RT_LOAD
                __syncthreads();
                if (tid < NE) gb[tid] = (int)__hip_atomic_fetch_add(cnt + tid, (unsigned)lcnt[tid], RLX_AGENT);
                __syncthreads();
                if (tid < 128) { RInfo ri; ri.e1 = le[2 * tid]; ri.e2 = le[2 * tid + 1]; ri.p1 = gb[ri.e1] + lp[2 * tid]; ri.p2 = gb[ri.e2] + lp[2 * tid + 1]; ri.g1 = lg[2 * tid]; ri.g2 = lg[2 * tid + 1]; ri.s1 = 0; ri.s2 = 0; rinfo[chunk * 128 + tid] = ri; }
                __syncthreads();
            }
            SEAM(PH(l, 4));
        }
        if (SITE(12) && moe && IN(PH(l, 5))) REP(8) {
            SITE_BEGIN();
            int tid_ = threadIdx.x; asm volatile("" : "+v"(tid_));
            const int tid = tid_, lane = tid & 63, wave = __builtin_amdgcn_readfirstlane(tid >> 6);
            unsigned* cnt = (unsigned*)(wsl + WS_CTL) + CW_CNT + (l == 3 ? 64 : 0);
            int* base_out = (int*)(wsl + WS_CTL) + CW_BASE + (l == 3 ? 64 : 0);
            RInfo* rinfo = (RInfo*)(wsl + WS_RINFO);
            unsigned char* xg8 = R0 + R_XG; float* ssg = (float*)(wsl + WS_SLOT); float* sgate = ssg + TMAX;
            int cn[NE], base[NE + 1]; base[0] = 0;
#pragma unroll
            for (int e = 0; e < NE; ++e) { cn[e] = (int)__builtin_amdgcn_readfirstlane(__hip_atomic_load(cnt + e, RLX_AGENT)); base[e + 1] = base[e] + ((cn[e] + 255) & ~255); }
            if (cb == 0 && tid <= NE) { int v = 0;
#pragma unroll
                for (int e = 0; e <= NE; ++e) if (tid == e) v = base[e];
                base_out[tid] = v; }
            const int gw = cb * NWAVES + wave, NGW = Gs * NWAVES;
            int2* tokslot = (int2*)(wsl + WS_TOKSLOT);
            for (int m0 = gw; m0 < M; m0 += 2 * NGW) {
                const int m1 = (m0 + NGW < M) ? m0 + NGW : m0;
                const RInfo ra = rinfo[m0], rb = rinfo[m1];
                const u32x4* sa = (const u32x4*)(HBP + (size_t)m0 * D) + 2 * lane; const u32x4* sb = (const u32x4*)(HBP + (size_t)m1 * D) + 2 * lane;
                const u32x4 a0 = sa[0], a1 = sa[1], c0 = sb[0], c1 = sb[1];
                float sva = 0.f, svb = 0.f; if (lane == 0) { sva = sum16(SSA(1) + (size_t)m0 * 16); svb = sum16(SSA(1) + (size_t)m1 * 16); }
                int ba1 = 0, ba2 = 0, bb1 = 0, bb2 = 0;
#pragma unroll
                for (int e = 0; e < NE; ++e) { if (ra.e1 == e) ba1 = base[e]; if (ra.e2 == e) ba2 = base[e]; if (rb.e1 == e) bb1 = base[e]; if (rb.e2 == e) bb2 = base[e]; }
                const int sa1 = ba1 + ra.p1, sa2 = ba2 + ra.p2, sb1 = bb1 + rb.p1, sb2 = bb2 + rb.p2;
                v4u oa, ob;
                oa.x = pg8::pk4_fp8(bf2f(a0.x), bf2f(a0.x >> 16), bf2f(a0.y), bf2f(a0.y >> 16)); oa.y = pg8::pk4_fp8(bf2f(a0.z), bf2f(a0.z >> 16), bf2f(a0.w), bf2f(a0.w >> 16));
                oa.z = pg8::pk4_fp8(bf2f(a1.x), bf2f(a1.x >> 16), bf2f(a1.y), bf2f(a1.y >> 16)); oa.w = pg8::pk4_fp8(bf2f(a1.z), bf2f(a1.z >> 16), bf2f(a1.w), bf2f(a1.w >> 16));
                ob.x = pg8::pk4_fp8(bf2f(c0.x), bf2f(c0.x >> 16), bf2f(c0.y), bf2f(c0.y >> 16)); ob.y = pg8::pk4_fp8(bf2f(c0.z), bf2f(c0.z >> 16), bf2f(c0.w), bf2f(c0.w >> 16));
                ob.z = pg8::pk4_fp8(bf2f(c1.x), bf2f(c1.x >> 16), bf2f(c1.y), bf2f(c1.y >> 16)); ob.w = pg8::pk4_fp8(bf2f(c1.z), bf2f(c1.z >> 16), bf2f(c1.w), bf2f(c1.w >> 16));
                *((v4u*)(xg8 + (size_t)sa1 * D) + lane) = oa; *((v4u*)(xg8 + (size_t)sa2 * D) + lane) = oa; *((v4u*)(xg8 + (size_t)sb1 * D) + lane) = ob; *((v4u*)(xg8 + (size_t)sb2 * D) + lane) = ob;
                if (lane == 0) { ssg[sa1] = sva; ssg[sa2] = sva; sgate[sa1] = ra.g1; sgate[sa2] = ra.g2; tokslot[m0] = make_int2(sa1, sa2);
                                 ssg[sb1] = svb; ssg[sb2] = svb; sgate[sb1] = rb.g1; sgate[sb2] = rb.g2; tokslot[m1] = make_int2(sb1, sb2); }
            }
            for (int e = cb; e < NE; e += Gs) {
                int plo = 0, phi = 0;
#pragma unroll
                for (int q = 0; q < NE; ++q) if (e == q) { plo = base[q] + cn[q]; phi = base[q + 1]; }
                for (int r = plo + wave; r < phi; r += NWAVES) { *((v4u*)(xg8 + (size_t)r * D) + lane) = (v4u){0u, 0u, 0u, 0u}; if (lane == 0) { ssg[r] = 1024.f; sgate[r] = 0.f; } }
            }
            SEAM(PH(l, 5));
        }
        if (SITE(5) && !moe && IN(PH(l, 6))) REP(4) {
            SITE_BEGIN();
            pg8::Gemm g{HBP, (const bf16*)(wsl + (l == 0 ? OFF_WGU0 : OFF_WGU2)), M, 5632, 1024}; pg8::StaticOrder S; S.init(M, 5632, Gs, cb);
            if (DENSE_DN_FP8) { pg8::EpiSwiglu8 E{SSA(1), R0 + R_ACT, 16, 1.0f};
                pg8::gemm_phase<pg8::EpiSwiglu8, pg8::StaticOrder, true, true>(lds, g, S, E); }
            else { pg8::EpiSwiglu E{SSA(1), (bf16*)(R0 + R_ACT), 16, 0};
                pg8::gemm_phase<pg8::EpiSwiglu, pg8::StaticOrder, true, true>(lds, g, S, E); }
            SEAM(PH(l, 6));
        }
        if (SITE(13) && moe && IN(PH(l, 6))) REP(5) {
            SITE_BEGIN();
            pg8::Gemm g{(const bf16*)(R0 + R_XG), (const bf16*)(wsl + OFF_MGU), TMAX, 5632, 512}; pg8::GroupedOrder S; S.initg((const int*)(wsl + WS_CTL) + CW_BASE + (l == 3 ? 64 : 0), 5632, Gs, cb, (size_t)MOE_GU_BYTES);
            pg8::EpiSwiglu8 E{(const float*)(wsl + WS_SLOT), R0 + R_ACTG, 1, 1.0f / 64.0f};
            pg8::gemm_phase<pg8::EpiSwiglu8, pg8::GroupedOrder, true, true, true>(lds, g, S, E);
            SEAM(PH(l, 6));
        }
        if (!moe) {
            if (SITE(6) && IN(PH(l, 7))) REP(12) {
                SITE_BEGIN();
                pg8::Gemm g{(const bf16*)(R0 + R_ACT), (const bf16*)(wsl + (l == 0 ? OFF_WDN0 : OFF_WDN2)), M, 1024, DENSE_DN_FP8 ? 1408 : 2816}; pg8::StaticOrder S; S.init(M, 1024, Gs, cb);
                pg8::EpiRes E{HBP, DUMMY(12) ? (bf16*)(R0 + R_QS) : HBP, DUMMY(12) ? SSA(2) : SSA(0), DENSE_DN_FP8 ? 1.0f / 512.0f : 1.0f, 0};
                if (DENSE_DN_FP8) pg8::gemm_phase<pg8::EpiRes, pg8::StaticOrder, true, true, true, true>(lds, g, S, E);
                else pg8::gemm_phase<pg8::EpiRes, pg8::StaticOrder, true, true, false, true>(lds, g, S, E);
                SEAM(PH(l, 7));
            }
        } else {
            if (SITE(7) && IN(PH(l, 7))) REP(6) {
                SITE_BEGIN();
                pg8::Gemm g{(const bf16*)(R0 + R_ACTG), (const bf16*)(wsl + OFF_MDN), TMAX, 1024, 1408}; pg8::GroupedOrder S;   S.initg((const int*)(wsl + WS_CTL) + CW_BASE + (l == 3 ? 64 : 0), 1024, Gs, cb, (size_t)MOE_DN_BYTES);
                pg8::MoeSplit sp; sp.init(S.nM, 4, Gs); S.nM = sp.nM_main; S.nwg = sp.nM_main * 4;
                pg8::EpiMdn E{(const float*)(wsl + WS_SLOT) + TMAX, (bf16*)(R0 + R_XG), 1.0f / 512.0f, 0};
                pg8::gemm_phase<pg8::EpiMdn, pg8::GroupedOrder, true, true, true, true>(lds, g, S, E);
                SEAM(PH(l, 7));
            }
            if (SITE(8) && IN(PH(l, 8))) REP(10) {
                SITE_BEGIN();
                int tid_ = threadIdx.x; asm volatile("" : "+v"(tid_));
                const int lane = tid_ & 63, wave = __builtin_amdgcn_readfirstlane(tid_ >> 6);
                pg8::MoeSplit sp; sp.init(__builtin_amdgcn_readfirstlane(((const int*)(wsl + WS_CTL) + CW_BASE + (l == 3 ? 64 : 0))[8]) / 256, 4, Gs);
                const int ntail = sp.ntail, thr = ntail ? sp.nM_main * 256 : 0x7fffffff;
                const bool tailcu = cb < ntail;
                const int gw = (cb - ntail) * NWAVES + wave, NGW = (Gs - ntail) * NWAVES;
                const int2* tokslot = (const int2*)(wsl + WS_TOKSLOT);
                const float* gf = (l == 3) ? INP(38) : nullptr;
                if (tailcu) {
                    pg8::Gemm g{(const bf16*)(R0 + R_ACTG), (const bf16*)(wsl + OFF_MDN), TMAX, 1024, 1408}; pg8::TailOrder S; S.initg((const int*)(wsl + WS_CTL) + CW_BASE + (l == 3 ? 64 : 0), 1024, Gs, cb, (size_t)MOE_DN_BYTES);
                    S.tpm = sp.nM_main + (cb >> 2); S.tpn = cb & 3;
                    pg8::EpiMdn E{(const float*)(wsl + WS_SLOT) + TMAX, (bf16*)(R0 + R_XG), 1.0f / 512.0f, 0};
                    pg8::gemm_phase<pg8::EpiMdn, pg8::TailOrder, true, true, true, true>(lds, g, S, E);
                }
                unsigned pend = 0u;
#pragma nounroll
                for (int pass = 0; pass < 2; ++pass) {
                    if (pass == 1) { if (ntail == 0) break; if (hi - lo > 1) xcd_barrier(bar); }
                    if (!tailcu) { int k = 0;
                        for (int m = gw; m < M; m += 2 * NGW, ++k) {
                            if (pass == 1 && k < 32 && !((pend >> k) & 1u)) continue;
                            bool did;
                            if (l == 1) did = combine_rows2<false>(HBP, DUMMY(10) ? (bf16*)(R0 + R_ACTG) : HBP, nullptr, (const bf16*)(R0 + R_XG), tokslot, DUMMY(10) ? SSA(2) : SSA(0), nullptr, m, (m + NGW < M) ? m + NGW : m, lane, thr, pass);
                            else did = combine_rows2<true>(HBP, nullptr, DUMMY(10) ? (float*)(R0 + R_ACTG) : outl, (const bf16*)(R0 + R_XG), tokslot, nullptr, gf, m, (m + NGW < M) ? m + NGW : m, lane, thr, pass);
                            if (pass == 0 && !did && k < 32) pend |= 1u << k;
                        }
                    }
                }
                if (l == 1) conv_run(LC, lds, wsl, cb, Gs, tid_, 0, MOE_ITEMS, 36, 37, 34);
                SEAM(PH(l, 8));
            }
        }
    }

__global__ void __launch_bounds__(NWAVES * 64, 2) mega(Args args) {
    extern __shared__ __attribute__((aligned(16))) unsigned char lds_raw[];
    LAS unsigned char* lds = (LAS unsigned char*)lds_raw;
    volatile LAS unsigned* LC = (volatile LAS unsigned*)(lds + LDSCTL_OFF);
    for (int u = threadIdx.x; u < (LDS_BYTES - LDSCTL_OFF) / 4; u += NWAVES * 64) LC[u] = 0u;
    __syncthreads();
    if (threadIdx.x == 0) {
#pragma unroll
        for (int i = 0; i < 39; ++i) { const unsigned long long p = (unsigned long long)args.in[i]; LC[LC_PTR + 2 * i] = (unsigned)p; LC[LC_PTR + 2 * i + 1] = (unsigned)(p >> 32); }
    }
    __syncthreads();
#ifdef MK_PER_PHASE
    const int lo = args.ph_lo, hi = args.ph_hi;
#else
    constexpr int lo = 0, hi = PH_END;
#endif
    XcdBarrier bar; bar.bar = (unsigned*)(args.ws + WS_CTL) + CW_BAR; bar.x = 0; bar.st = nullptr;
    if (hi - lo > 1) bar = xcd_barrier_post((unsigned*)(args.ws + WS_CTL) + CW_BAR, LC + LC_BAR);
    if (SITE(0) && IN(PH_PRO)) REP(0) {
        SITE_BEGIN();
        int tid_ = threadIdx.x; asm volatile("" : "+v"(tid_));
        const int lane = tid_ & 63, wave = __builtin_amdgcn_readfirstlane(tid_ >> 6);
        const int gw = cb * NWAVES + wave, NGW = Gs * NWAVES;
        for (int l = 0; l < 2; ++l) { bf16* wd = (bf16*)(wsl + (l ? OFF_WD1 : OFF_WD0)) + (size_t)704 * 1024;
            for (int i = cb * 512 + tid_; i < 64 * 1024 / 8; i += Gs * 512) ((v4u*)wd)[i] = (v4u){0u, 0u, 0u, 0u}; }
        conv_run(LC, lds, wsl, cb, Gs, tid_, SMALL_ITEMS, SMALL_ITEMS + MOE_ITEMS, 21, 22, 19);
        for (int m = gw; m < M; m += NGW) prep_row(INP(0), (const int*)INP(1), HBP, SSA(0), (float2*)(wsl + WS_CS), m, lane);
        SEAM(PH_PRO);
    }

    layer_phases<0>(args, lds, LC, bar, lo, hi);
    layer_phases<1>(args, lds, LC, bar, lo, hi);
    layer_phases<2>(args, lds, LC, bar, lo, hi);
    layer_phases<3>(args, lds, LC, bar, lo, hi);
#undef IN
#undef SEAM
#undef INP
#undef SSA
}


extern "C" void kernel_launch(void* const* d_in, const int* in_sizes, int n_in, void* d_out, int out_size, void* d_ws, size_t ws_size, hipStream_t stream) {
    if (n_in != 39 || out_size != M * D || ws_size < WS_END) { fprintf(stderr, "kernel_launch: unexpected shapes (n_in %d out %d ws %zu need %zu)\n", n_in, out_size, ws_size, (size_t)WS_END); return; }
    static int once = 0, grid = 256;
    if (!once) { once = 1;
        { int dev = 0, cus = 0; if (hipGetDevice(&dev) == hipSuccess && hipDeviceGetAttribute(&cus, hipDeviceAttributeMultiprocessorCount, dev) == hipSuccess && cus > 0) grid = cus; }
        (void)hipFuncSetAttribute((const void*)mega, hipFuncAttributeMaxDynamicSharedMemorySize, LDS_BYTES); }
    unsigned char* ws = (unsigned char*)d_ws;
    float* out = (float*)d_out;
    Args a{};
    for (int i = 0; i < 39; ++i) a.in[i] = d_in[i];
    a.out = out; a.ws = ws;
    auto phase = [&](int p) { a.ph_lo = p; a.ph_hi = p + 1; hipLaunchKernelGGL(mega, dim3(grid), dim3(NWAVES * 64), LDS_BYTES, stream, a); }; (void)phase;

    (void)hipMemsetAsync(ws + WS_CTL, 0, CTL_BYTES, stream);
#ifdef MK_PER_PHASE
    for (int p = 0; p < PH_END; ++p) phase(p);
#else
    a.ph_lo = 0; a.ph_hi = PH_END;
    hipLaunchKernelGGL(mega, dim3(grid), dim3(NWAVES * 64), LDS_BYTES, stream, a);
#endif
}
```

```cpp
#include <hip/hip_runtime.h>
#include <cstdio>
#include <cstdint>

#ifndef REPEAT
#define REPEAT -1
#endif
#ifndef DENSE_DN_FP8
#define DENSE_DN_FP8 1
#endif
#ifndef MLA_FP8
#define MLA_FP8 1
#endif
typedef unsigned short bf16;
typedef float f32x4 __attribute__((ext_vector_type(4)));
typedef float f32x16 __attribute__((ext_vector_type(16)));
typedef unsigned u32x4 __attribute__((ext_vector_type(4)));
typedef unsigned u32x2 __attribute__((ext_vector_type(2)));

constexpr int NB = 8, S = 4096, D = 1024, M = NB * S;
constexpr int NH = 8, QKN = 128, QKR = 64, QKD = QKN + QKR, VH = 128, QL = 384, KVL = 256;
constexpr int NDOWN = QL + KVL + QKR;
constexpr int FF = 2816, NE = 8;
constexpr float EPS = 1e-6f;
constexpr float LOG2E = 1.4426950408889634f, LN2 = 0.6931471805599453f;
constexpr float C2_MLA = 0.07216878364870322f * LOG2E;
constexpr float C2_SB = 0.08838834764831845f * LOG2E;
constexpr int TMAX = 2 * M + NE * 256;

constexpr size_t MiB = 1u << 20;
constexpr size_t WS_CTL = 0, CTL_BYTES = 1 * MiB;
constexpr size_t WS_SS = 1 * MiB;
constexpr size_t WS_CS = 9 * MiB;
constexpr size_t WS_RINFO = 17 * MiB;
constexpr size_t WS_SLOT = 18 * MiB;
constexpr size_t WS_TOKSLOT = WS_SLOT + 768 * 1024;
constexpr size_t WS_HB = 19 * MiB;
constexpr size_t WS_R0 = 83 * MiB;
constexpr size_t R_CQ = 0, R_CKV = 24 * MiB, R_KR = 40 * MiB, R_Q = 44 * MiB, R_KN = 140 * MiB, R_V = 204 * MiB, R_O = 268 * MiB;
constexpr size_t R_Q8 = 44 * MiB, R_K8T = 92 * MiB, R_VT8T = 144 * MiB;
constexpr int K8_PITCH = 208, K8_TILE = 64 * K8_PITCH, VT8_PITCH = 80, VT8_TILE = 128 * VT8_PITCH;
static_assert(R_Q8 + (size_t)M * 1536 <= R_K8T && R_K8T + (size_t)4096 * K8_TILE <= R_VT8T && R_VT8T + (size_t)4096 * VT8_TILE <= R_O, "fp8 MLA buffers");
constexpr size_t R_ACT = 0;
constexpr size_t R_KS = 176 * MiB, R_VS = 240 * MiB, R_QS = 304 * MiB, R_OS = 368 * MiB;
constexpr size_t R_XG = 0, R_ACTG = 132 * MiB;
constexpr size_t WS_WSMALL = 578 * MiB, WS_WMOE = 635 * MiB;
constexpr size_t WS_END = 767 * MiB;
constexpr int CW_CNT = 64;
constexpr int CW_BAR = 4096;
constexpr int CW_BASE = 256;

__device__ __forceinline__ unsigned f2bf(float f) { unsigned u = __builtin_bit_cast(unsigned, f); return (u + 0x7fffu + ((u >> 16) & 1u)) >> 16; }
__device__ __forceinline__ float bf2f(unsigned b) { return __builtin_bit_cast(float, (b & 0xffffu) << 16); }
__device__ __forceinline__ unsigned pk2(float lo, float hi) { return f2bf(lo) | (f2bf(hi) << 16); }
__device__ __forceinline__ float wave_sum(float v) {
#pragma unroll
    for (int o = 1; o < 64; o <<= 1) v += __shfl_xor(v, o);
    return v;
}
__device__ __forceinline__ float wave_max(float v) {
#pragma unroll
    for (int o = 1; o < 64; o <<= 1) v = fmaxf(v, __shfl_xor(v, o));
    return v;
}
__device__ __forceinline__ int crow(int r, int hi) { return (r & 3) + 8 * (r >> 2) + 4 * hi; }

__device__ __forceinline__ float sum16(const float* p) { const f32x4 a = *(const f32x4*)p, b = *(const f32x4*)(p + 4), c = *(const f32x4*)(p + 8), d = *(const f32x4*)(p + 12);
    return (((a.x + a.y) + (a.z + a.w)) + ((b.x + b.y) + (b.z + b.w))) + (((c.x + c.y) + (c.z + c.w)) + ((d.x + d.y) + (d.z + d.w))); }
struct RInfo { int e1, e2, p1, p2; float g1, g2; int s1, s2; };

namespace pg8 {
#define PG8_LAS __attribute__((address_space(3)))
typedef unsigned short bf16_t;
typedef short bf16x8 __attribute__((ext_vector_type(8)));
typedef float f32x4 __attribute__((ext_vector_type(4)));
typedef unsigned u32x4 __attribute__((ext_vector_type(4)));
constexpr int BM = 256, BK = 64, HALF = 128, HTB = HALF * BK * 2  , STAGE_BYTES = 8 * HTB, NXCD = 8, WGM = 8;

__host__ __device__ __forceinline__ int lds_byte(int r, int c) { const int st = (r >> 4) * 2 + (c >> 5), rr = r & 15, cc = c & 31, ob = rr * 64 + cc * 2; return st * 1024 + (ob ^ (((ob >> 9) & 1) << 5)); }
__host__ __device__ __forceinline__ void stage_rc(int b, int& R, int& C) { const int st = b / 1024, sb = b % 1024, swz = sb ^ (((sb >> 9) & 1) << 5); R = (st >> 1) * 16 + swz / 64; C = (st & 1) * 32 + (swz % 64) / 2; }
__host__ __device__ __forceinline__ int perm32(int rho) { const int n = rho >> 4, i = rho & 15; return 8 * (i >> 2) + 4 * n + (i & 3); }

struct Unit { int pm, pn; };
struct Gemm { const bf16_t* A; const bf16_t* Bt; int M, N, K; };

struct StaticOrder {
    int nM, nN, nwg, G, c;
    __host__ __device__ void init(int M, int N, int G_, int c_) { nM = M / BM; nN = N / BM; nwg = nM * nN; G = G_; c = c_; }
    __host__ __device__ bool next(int i, Unit& u) const {
        const long L = (long)i * G + c; if (L >= nwg) return false;
        int wgid = (int)L; { const int q = nwg / NXCD, r = nwg % NXCD, xcd = wgid % NXCD, off = wgid / NXCD; wgid = (xcd < r ? xcd * (q + 1) : r * (q + 1) + (xcd - r) * q) + off; }
        const int nig = WGM * nN, gid = wgid / nig, fm = gid * WGM, gsz = (nM - fm) < WGM ? (nM - fm) : WGM;
        u.pm = fm + ((wgid % nig) % gsz); u.pn = (wgid % nig) / gsz; return true;
    }
    __device__ __forceinline__ void a_ready(const Unit&) const {}
    __device__ __forceinline__ void done(const Unit&) const {}
    __device__ __forceinline__ size_t boff(const Unit&) const { return 0; }
};

__device__ __forceinline__ unsigned cvt_pk_bf16(float lo, float hi) { unsigned r; asm volatile("v_cvt_pk_bf16_f32 %0, %1, %2" : "=v"(r) : "v"(lo), "v"(hi)); return r; }
typedef unsigned u32x2 __attribute__((ext_vector_type(2)));
__device__ __forceinline__ u32x4 pack8(const f32x4 a, const f32x4 b) { u32x4 w; w.x = cvt_pk_bf16(a[0], a[1]); w.y = cvt_pk_bf16(a[2], a[3]); w.z = cvt_pk_bf16(b[0], b[1]); w.w = cvt_pk_bf16(b[2], b[3]); return w; }
__device__ __forceinline__ float sumsq8(const f32x4 a, const f32x4 b) { return ((a[0] * a[0] + a[1] * a[1]) + (a[2] * a[2] + a[3] * a[3])) + ((b[0] * b[0] + b[1] * b[1]) + (b[2] * b[2] + b[3] * b[3])); }
__device__ __forceinline__ float red_fq(float q) {
    q += __uint_as_float((unsigned)__builtin_amdgcn_ds_swizzle((int)__float_as_uint(q), 0x401F));
    { auto rr = __builtin_amdgcn_permlane32_swap(__float_as_uint(q), __float_as_uint(q), false, false); q = __uint_as_float(rr[0]) + __uint_as_float(rr[1]); }
    return q; }
__device__ __forceinline__ float row_ss(const float* ss, int stride, int nq, int r, int fq) { if (stride == 1) return ss[r]; float q = 0.f; if (fq < nq) { const f32x4 v = *(const f32x4*)(ss + (size_t)r * 16 + fq * 4); q = (v[0] + v[1]) + (v[2] + v[3]); } return red_fq(q); }
constexpr float EPSN = 1e-6f;
__device__ __forceinline__ void row_sums(float (&q)[8], const float* ss, int stride, int nq, int row0, int fq) {
    if (stride == 1) {
#pragma unroll
        for (int g = 0; g < 8; ++g) q[g] = ss[row0 + (g >> 2) * HALF + (g & 3) * 16];
        asm volatile("" :: "v"(q[0]), "v"(q[1]), "v"(q[2]), "v"(q[3]), "v"(q[4]), "v"(q[5]), "v"(q[6]), "v"(q[7]));
        return;
    }
    f32x4 raw[8]; const int fqc = (fq < nq) ? fq : 0;
#pragma unroll
    for (int g = 0; g < 8; ++g) raw[g] = *(const f32x4*)(ss + (size_t)(row0 + (g >> 2) * HALF + (g & 3) * 16) * 16 + fqc * 4);
    asm volatile("" :: "v"(raw[0]), "v"(raw[1]), "v"(raw[2]), "v"(raw[3]), "v"(raw[4]), "v"(raw[5]), "v"(raw[6]), "v"(raw[7]));
    float t[8];
#pragma unroll
    for (int g = 0; g < 8; ++g) { const float sm = (raw[g][0] + raw[g][1]) + (raw[g][2] + raw[g][3]); q[g] = (fq < nq) ? sm : 0.f; }
#pragma unroll
    for (int g = 0; g < 8; ++g) t[g] = __uint_as_float((unsigned)__builtin_amdgcn_ds_swizzle((int)__float_as_uint(q[g]), 0x401F));
#pragma unroll
    for (int g = 0; g < 8; ++g) q[g] += t[g];
#pragma unroll
    for (int g = 0; g < 8; ++g) { auto rr = __builtin_amdgcn_permlane32_swap(__float_as_uint(q[g]), __float_as_uint(q[g]), false, false); q[g] = __uint_as_float(rr[0]) + __uint_as_float(rr[1]); }
}
#define EPI_ROW_SCALES(rs_, ss_, stride_, nq_, expr) float rs_[8]; { float q_[8]; row_sums(q_, ss_, stride_, nq_, u.pm * BM + wr * 64 + fr, fq); _Pragma("unroll") for (int g_ = 0; g_ < 8; ++g_) { const float q = q_[g_]; rs_[g_] = (expr); } }
__device__ __forceinline__ float rsq_(float x) { return __builtin_amdgcn_rsqf(x); }
constexpr int TOUCH_SINK = STAGE_BYTES + 4096;
__device__ __forceinline__ void touch_line(PG8_LAS unsigned char* lds, const void* p) { __builtin_amdgcn_global_load_lds((const unsigned*)p, (PG8_LAS unsigned*)(lds + TOUCH_SINK), 4, 0, 0); }
__device__ __forceinline__ void touch_rows16(PG8_LAS unsigned char* lds, const float* ss, int row0, int tid) { if (tid < 128) touch_line(lds, (const char*)(ss + (size_t)row0 * 16) + tid * 128); }
__device__ __forceinline__ void touch_rows1(PG8_LAS unsigned char* lds, const float* ss, int row0, int tid) { if (tid < 8) touch_line(lds, (const char*)(ss + row0) + tid * 128); }
__device__ __forceinline__ unsigned pk4_fp8(float a, float b, float c, float d) {
    a = __builtin_amdgcn_fmed3f(a, -448.f, 448.f); b = __builtin_amdgcn_fmed3f(b, -448.f, 448.f); c = __builtin_amdgcn_fmed3f(c, -448.f, 448.f); d = __builtin_amdgcn_fmed3f(d, -448.f, 448.f);
    int w = __builtin_amdgcn_cvt_pk_fp8_f32(a, b, 0, false); w = __builtin_amdgcn_cvt_pk_fp8_f32(c, d, w, true); return (unsigned)w; }

struct EpiDown { static constexpr bool PERM = true, AFTER_DRAIN = false, PROBE2 = false;
    const float* ss; const float2* cs; bf16_t* cq; bf16_t* ckv; bf16_t* kr; float* ssq; float* sskv; unsigned char* k8t;
    __device__ __forceinline__ void touch(PG8_LAS unsigned char* lds, const Unit& u, int tid) const { touch_rows16(lds, ss, u.pm * BM, tid); }
    __device__ __forceinline__ void operator()(const f32x4 (&acc)[2][2][4][2], const Unit& u0, int wr, int wc, int fr, int fq) const {
        Unit u = u0; asm volatile("" : "+s"(u.pm), "+s"(u.pn));
        EPI_ROW_SCALES(rs, ss, 16, 4, rsq_(q * (1.0f / 1024.0f) + EPSN))
#pragma unroll
        for (int ai = 0; ai < 2; ++ai)
#pragma unroll
            for (int m = 0; m < 4; ++m) { const int r = u.pm * BM + ai * HALF + wr * 64 + m * 16 + fr; const float rstd = rs[ai * 4 + m];
#pragma unroll
                for (int bj = 0; bj < 2; ++bj) { const int c = u.pn * BM + bj * HALF + wc * 32, cl = c + fq * 8;
                    const f32x4 v0 = acc[ai][bj][m][0] * rstd, v1 = acc[ai][bj][m][1] * rstd;
                    if (c < 384) { *(u32x4*)(cq + (size_t)r * 384 + cl) = pack8(v0, v1); const float q = red_fq(sumsq8(v0, v1)); if (fq == 0) ssq[(size_t)r * 16 + (c >> 5)] = q; }
                    else if (c < 640) { *(u32x4*)(ckv + (size_t)r * 256 + (cl - 384)) = pack8(v0, v1); const float q = red_fq(sumsq8(v0, v1)); if (fq == 0) sskv[(size_t)r * 16 + ((c - 384) >> 5)] = q; }
                    else if (c < 704) { const int i0 = (cl - 640) >> 1; const f32x4 t01 = *(const f32x4*)(cs + (size_t)r * 32 + i0), t23 = *(const f32x4*)(cs + (size_t)r * 32 + i0 + 2);
                        const f32x4 o0 = {v0[0] * t01[0] - v0[1] * t01[1], v0[0] * t01[1] + v0[1] * t01[0], v0[2] * t01[2] - v0[3] * t01[3], v0[2] * t01[3] + v0[3] * t01[2]};
                        const f32x4 o1 = {v1[0] * t23[0] - v1[1] * t23[1], v1[0] * t23[1] + v1[1] * t23[0], v1[2] * t23[2] - v1[3] * t23[3], v1[2] * t23[3] + v1[3] * t23[2]};
                        if (k8t) { u32x2 w; w.x = pk4_fp8(o0[0], o0[1], o0[2], o0[3]); w.y = pk4_fp8(o1[0], o1[1], o1[2], o1[3]); const int b = r >> 12, key = r & 4095, j = key >> 6, kk = key & 63;
#pragma unroll
                            for (int h2 = 0; h2 < 8; ++h2) *(u32x2*)(k8t + (size_t)((b * 8 + h2) * 64 + j) * 13312 + kk * 208 + 128 + (cl - 640)) = w; }
                        else *(u32x4*)(kr + (size_t)r * 64 + (cl - 640)) = pack8(o0, o1); }
                } }
    }
};
struct EpiUq { static constexpr bool PERM = true, AFTER_DRAIN = false, PROBE2 = false;
    const float* ssq; const float2* cs; bf16_t* Q; float c2; int pad;
    __device__ __forceinline__ void touch(PG8_LAS unsigned char* lds, const Unit& u, int tid) const { touch_rows16(lds, ssq, u.pm * BM, tid); }
    __device__ __forceinline__ void operator()(const f32x4 (&acc)[2][2][4][2], const Unit& u0, int wr, int wc, int fr, int fq) const {
        Unit u = u0; asm volatile("" : "+s"(u.pm), "+s"(u.pn));
        EPI_ROW_SCALES(rs, ssq, 16, 3, rsq_(q * (1.0f / 384.0f) + EPSN) * c2)
#pragma unroll
        for (int ai = 0; ai < 2; ++ai)
#pragma unroll
            for (int m = 0; m < 4; ++m) { const int r = u.pm * BM + ai * HALF + wr * 64 + m * 16 + fr; const float rstd = rs[ai * 4 + m];
#pragma unroll
                for (int bj = 0; bj < 2; ++bj) { const int c = u.pn * BM + bj * HALF + wc * 32, cl = c + fq * 8, d = c % 192;
                    const f32x4 v0 = acc[ai][bj][m][0] * rstd, v1 = acc[ai][bj][m][1] * rstd;
                    if (d < 128) { *(u32x4*)(Q + (size_t)r * 1536 + cl) = pack8(v0, v1); }
                    else { const int i0 = ((d - 128) >> 1) + fq * 4; const f32x4 t01 = *(const f32x4*)(cs + (size_t)r * 32 + i0), t23 = *(const f32x4*)(cs + (size_t)r * 32 + i0 + 2);
                        const f32x4 o0 = {v0[0] * t01[0] - v0[1] * t01[1], v0[0] * t01[1] + v0[1] * t01[0], v0[2] * t01[2] - v0[3] * t01[3], v0[2] * t01[3] + v0[3] * t01[2]};
                        const f32x4 o1 = {v1[0] * t23[0] - v1[1] * t23[1], v1[0] * t23[1] + v1[1] * t23[0], v1[2] * t23[2] - v1[3] * t23[3], v1[2] * t23[3] + v1[3] * t23[2]};
                        *(u32x4*)(Q + (size_t)r * 1536 + cl) = pack8(o0, o1); }
                } }
    }
};
struct EpiUq8 { static constexpr bool PERM = true, AFTER_DRAIN = false, PROBE2 = false;
    const float* ssq; const float2* cs; unsigned char* Q8; float c2; int pad;
    __device__ __forceinline__ void touch(PG8_LAS unsigned char* lds, const Unit& u, int tid) const { touch_rows16(lds, ssq, u.pm * BM, tid); }
    __device__ __forceinline__ void operator()(const f32x4 (&acc)[2][2][4][2], const Unit& u0, int wr, int wc, int fr, int fq) const {
        Unit u = u0; asm volatile("" : "+s"(u.pm), "+s"(u.pn));
        EPI_ROW_SCALES(rs, ssq, 16, 3, rsq_(q * (1.0f / 384.0f) + EPSN) * c2)
#pragma unroll
        for (int ai = 0; ai < 2; ++ai)
#pragma unroll
            for (int m = 0; m < 4; ++m) { const int r = u.pm * BM + ai * HALF + wr * 64 + m * 16 + fr; const float rstd = rs[ai * 4 + m];
#pragma unroll
                for (int bj = 0; bj < 2; ++bj) { const int c = u.pn * BM + bj * HALF + wc * 32, cl = c + fq * 8, d = c % 192;
                    f32x4 v0 = acc[ai][bj][m][0] * rstd, v1 = acc[ai][bj][m][1] * rstd;
                    if (d >= 128) { const int i0 = ((d - 128) >> 1) + fq * 4; const f32x4 t01 = *(const f32x4*)(cs + (size_t)r * 32 + i0), t23 = *(const f32x4*)(cs + (size_t)r * 32 + i0 + 2);
                        const f32x4 o0 = {v0[0] * t01[0] - v0[1] * t01[1], v0[0] * t01[1] + v0[1] * t01[0], v0[2] * t01[2] - v0[3] * t01[3], v0[2] * t01[3] + v0[3] * t01[2]};
                        const f32x4 o1 = {v1[0] * t23[0] - v1[1] * t23[1], v1[0] * t23[1] + v1[1] * t23[0], v1[2] * t23[2] - v1[3] * t23[3], v1[2] * t23[3] + v1[3] * t23[2]};
                        v0 = o0; v1 = o1; }
                    u32x2 w; w.x = pk4_fp8(v0[0], v0[1], v0[2], v0[3]); w.y = pk4_fp8(v1[0], v1[1], v1[2], v1[3]);
                    *(u32x2*)(Q8 + (size_t)r * 1536 + cl) = w; } }
    }
};
struct EpiKn8 { static constexpr bool PERM = true, AFTER_DRAIN = false, PROBE2 = false;
    const float* sskv; unsigned char* K8T;
    __device__ __forceinline__ void touch(PG8_LAS unsigned char* lds, const Unit& u, int tid) const { touch_rows16(lds, sskv, u.pm * BM, tid); }
    __device__ __forceinline__ void operator()(const f32x4 (&acc)[2][2][4][2], const Unit& u0, int wr, int wc, int fr, int fq) const {
        Unit u = u0; asm volatile("" : "+s"(u.pm), "+s"(u.pn));
        EPI_ROW_SCALES(rs, sskv, 16, 2, rsq_(q * (1.0f / 256.0f) + EPSN))
#pragma unroll
        for (int ai = 0; ai < 2; ++ai)
#pragma unroll
            for (int m = 0; m < 4; ++m) { const int r = u.pm * BM + ai * HALF + wr * 64 + m * 16 + fr; const float rstd = rs[ai * 4 + m];
                const int b = r >> 12, key = r & 4095, j = key >> 6, kk = key & 63;
#pragma unroll
                for (int bj = 0; bj < 2; ++bj) { const int head = 2 * u.pn + bj; const f32x4 v0 = acc[ai][bj][m][0] * rstd, v1 = acc[ai][bj][m][1] * rstd;
                    u32x2 w; w.x = pk4_fp8(v0[0], v0[1], v0[2], v0[3]); w.y = pk4_fp8(v1[0], v1[1], v1[2], v1[3]);
                    *(u32x2*)(K8T + (size_t)((b * 8 + head) * 64 + j) * 13312 + kk * 208 + wc * 32 + fq * 8) = w; } }
    }
};
struct EpiVt8 { static constexpr bool PERM = true, AFTER_DRAIN = false, PROBE2 = false;
    const float* sskv; unsigned char* VT8T;
    __device__ __forceinline__ void touch(PG8_LAS unsigned char* lds, const Unit& u, int tid) const { touch_rows16(lds, sskv, u.pn * BM, tid); }
    __device__ __forceinline__ void operator()(const f32x4 (&acc)[2][2][4][2], const Unit& u0, int wr, int wc, int fr, int fq) const {
        Unit u = u0; asm volatile("" : "+s"(u.pm), "+s"(u.pn));
        float sc[2][8];
#pragma unroll
        for (int bj = 0; bj < 2; ++bj) { const int c = u.pn * BM + bj * HALF + wc * 32 + fq * 8;
            f32x4 s0[8], s1[8];
#pragma unroll
            for (int i = 0; i < 8; ++i) { s0[i] = *(const f32x4*)(sskv + (size_t)(c + i) * 16); s1[i] = *(const f32x4*)(sskv + (size_t)(c + i) * 16 + 4); }
            asm volatile("" :: "v"(s0[0]), "v"(s0[1]), "v"(s0[2]), "v"(s0[3]), "v"(s0[4]), "v"(s0[5]), "v"(s0[6]), "v"(s0[7]), "v"(s1[0]), "v"(s1[1]), "v"(s1[2]), "v"(s1[3]), "v"(s1[4]), "v"(s1[5]), "v"(s1[6]), "v"(s1[7]));
#pragma unroll
            for (int i = 0; i < 8; ++i) sc[bj][i] = rsq_((((s0[i][0] + s0[i][1]) + (s0[i][2] + s0[i][3])) + ((s1[i][0] + s1[i][1]) + (s1[i][2] + s1[i][3]))) * (1.0f / 256.0f) + EPSN); }
#pragma unroll
        for (int ai = 0; ai < 2; ++ai)
#pragma unroll
            for (int m = 0; m < 4; ++m) { const int rr = u.pm * BM + ai * HALF + wr * 64 + m * 16 + fr, head = rr >> 7, d = rr & 127;
#pragma unroll
                for (int bj = 0; bj < 2; ++bj) { const int c = u.pn * BM + bj * HALF + wc * 32 + fq * 8, b = c >> 12, key = c & 4095, j = key >> 6, kk = key & 63;
                    const f32x4 v0 = acc[ai][bj][m][0], v1 = acc[ai][bj][m][1];
                    u32x2 w; w.x = pk4_fp8(v0[0] * sc[bj][0], v0[1] * sc[bj][1], v0[2] * sc[bj][2], v0[3] * sc[bj][3]); w.y = pk4_fp8(v1[0] * sc[bj][4], v1[1] * sc[bj][5], v1[2] * sc[bj][6], v1[3] * sc[bj][7]);
                    *(u32x2*)(VT8T + (size_t)((b * 8 + head) * 64 + j) * 10240 + d * 80 + kk) = w; } }
    }
};
struct EpiUkv { static constexpr bool PERM = true, AFTER_DRAIN = false, PROBE2 = false;
    const float* sskv; bf16_t* KN; bf16_t* V;
    __device__ __forceinline__ void touch(PG8_LAS unsigned char* lds, const Unit& u, int tid) const { touch_rows16(lds, sskv, u.pm * BM, tid); }
    __device__ __forceinline__ void operator()(const f32x4 (&acc)[2][2][4][2], const Unit& u0, int wr, int wc, int fr, int fq) const {
        Unit u = u0; asm volatile("" : "+s"(u.pm), "+s"(u.pn));
        EPI_ROW_SCALES(rs, sskv, 16, 2, rsq_(q * (1.0f / 256.0f) + EPSN))
#pragma unroll
        for (int ai = 0; ai < 2; ++ai)
#pragma unroll
            for (int m = 0; m < 4; ++m) { const int r = u.pm * BM + ai * HALF + wr * 64 + m * 16 + fr; const float rstd = rs[ai * 4 + m];
                const size_t o = (size_t)r * 1024 + u.pn * 128 + wc * 32 + fq * 8;
                *(u32x4*)(KN + o) = pack8(acc[ai][0][m][0] * rstd, acc[ai][0][m][1] * rstd);
                *(u32x4*)(V + o) = pack8(acc[ai][1][m][0] * rstd, acc[ai][1][m][1] * rstd); }
    }
};
__device__ __forceinline__ f32x4 bf4_lo(const u32x4 w) { return (f32x4){__uint_as_float(w.x << 16), __uint_as_float(w.x & 0xffff0000u), __uint_as_float(w.y << 16), __uint_as_float(w.y & 0xffff0000u)}; }
__device__ __forceinline__ f32x4 bf4_hi(const u32x4 w) { return (f32x4){__uint_as_float(w.z << 16), __uint_as_float(w.z & 0xffff0000u), __uint_as_float(w.w << 16), __uint_as_float(w.w & 0xffff0000u)}; }
struct EpiRes { static constexpr bool PERM = true, AFTER_DRAIN = false, PROBE2 = false;
    const bf16_t* hin; bf16_t* hb; float* ssn; float ascale; int pad;
    __device__ __forceinline__ void touch(PG8_LAS unsigned char* lds, const Unit& u, int tid) const { _Pragma("unroll") for (int i = 0; i < 2; ++i) { const int li = tid + 512 * i; touch_line(lds, (const char*)(hin + (size_t)(u.pm * BM + (li >> 2)) * 1024 + u.pn * BM) + (li & 3) * 128); } }
    __device__ __forceinline__ void operator()(const f32x4 (&acc)[2][2][4][2], const Unit& u0, int wr, int wc, int fr, int fq) const {
        Unit u = u0; asm volatile("" : "+s"(u.pm), "+s"(u.pn));
        const size_t o00 = (size_t)(u.pm * BM + wr * 64 + fr) * 1024 + u.pn * BM + wc * 32 + fq * 8;
        u32x4 h0[8], h1[8];
#pragma unroll
        for (int g = 0; g < 8; ++g) { const size_t og = o00 + (size_t)((g >> 2) * HALF + (g & 3) * 16) * 1024; h0[g] = *(const u32x4*)(hin + og); h1[g] = *(const u32x4*)(hin + og + HALF); }
        asm volatile("" :: "v"(h0[0]), "v"(h0[1]), "v"(h0[2]), "v"(h0[3]), "v"(h0[4]), "v"(h0[5]), "v"(h0[6]), "v"(h0[7]), "v"(h1[0]), "v"(h1[1]), "v"(h1[2]), "v"(h1[3]), "v"(h1[4]), "v"(h1[5]), "v"(h1[6]), "v"(h1[7]));
#pragma unroll
        for (int g = 0; g < 8; ++g) { const int ai = g >> 2, m = g & 3; const int r = u.pm * BM + ai * HALF + wr * 64 + m * 16 + fr;
            float q = 0.f;
#pragma unroll
            for (int bj = 0; bj < 2; ++bj) { const size_t o = o00 + (size_t)(ai * HALF + m * 16) * 1024 + bj * HALF; const u32x4 hv = bj ? h1[g] : h0[g];
                const f32x4 o0 = bf4_lo(hv) + acc[ai][bj][m][0] * ascale, o1 = bf4_hi(hv) + acc[ai][bj][m][1] * ascale;
                *(u32x4*)(hb + o) = pack8(o0, o1); q += sumsq8(o0, o1); }
            q = red_fq(q); if (fq == 0) ssn[(size_t)r * 16 + u.pn * 4 + wc] = q; }
    }
};
struct EpiSwiglu { static constexpr bool PERM = true, AFTER_DRAIN = false, PROBE2 = true;
    const float* ss; bf16_t* act; int ss_stride; int pad;
    __device__ __forceinline__ void touch(PG8_LAS unsigned char* lds, const Unit& u, int tid) const { if (ss_stride == 1) touch_rows1(lds, ss, u.pm * BM, tid); else touch_rows16(lds, ss, u.pm * BM, tid); }
    __device__ __forceinline__ void operator()(const f32x4 (&acc)[2][2][4][2], const Unit& u0, int wr, int wc, int fr, int fq) const {
        Unit u = u0; asm volatile("" : "+s"(u.pm), "+s"(u.pn));
        bf16_t* abase = act + ((size_t)(u.pm * 44 + 2 * u.pn + (wc >> 1)) * 256 + wr * 64 + fr) * 64 + (wc & 1) * 32 + fq * 8;
        EPI_ROW_SCALES(rs, ss, ss_stride, 4, rsq_(q * (1.0f / 1024.0f) + EPSN))
#pragma unroll
        for (int ai = 0; ai < 2; ++ai)
#pragma unroll
            for (int m = 0; m < 4; ++m) { const float rstd = rs[ai * 4 + m];
                f32x4 a[2];
                const float c1 = -1.4426950408889634f * rstd, ic2 = __builtin_amdgcn_rcpf(rstd * rstd);
#pragma unroll
                for (int n = 0; n < 2; ++n) { const f32x4 ag = acc[ai][0][m][n], t = ag * acc[ai][1][m][n];
#pragma unroll
                    for (int j = 0; j < 4; ++j) a[n][j] = t[j] * __builtin_amdgcn_rcpf(__builtin_fmaf(__builtin_amdgcn_exp2f(ag[j] * c1), ic2, ic2)); }
                *(u32x4*)(abase + (ai * HALF + m * 16) * 64) = pack8(a[0], a[1]); }
    }
};
__device__ __forceinline__ unsigned pk4_fp8_nc(float a, float b, float c, float d) { int w = __builtin_amdgcn_cvt_pk_fp8_f32(a, b, 0, false); w = __builtin_amdgcn_cvt_pk_fp8_f32(c, d, w, true); return (unsigned)w; }
struct EpiSwiglu8 { static constexpr bool PERM = true, AFTER_DRAIN = false, PROBE2 = false;
    const float* ss; unsigned char* act; int ss_stride; float ascale;
    __device__ __forceinline__ void touch(PG8_LAS unsigned char* lds, const Unit& u, int tid) const { if (ss_stride == 1) touch_rows1(lds, ss, u.pm * BM, tid); else touch_rows16(lds, ss, u.pm * BM, tid); }
    __device__ __forceinline__ void operator()(const f32x4 (&acc)[2][2][4][2], const Unit& u0, int wr, int wc, int fr, int fq) const {
        Unit u = u0; asm volatile("" : "+s"(u.pm), "+s"(u.pn));
        unsigned char* abase = act + (size_t)(u.pm * 22 + u.pn) * 32768 + (wr * 64 + fr) * 128 + wc * 32 + fq * 8;
        EPI_ROW_SCALES(rs, ss, ss_stride, 4, rsq_(q * (1.0f / 1024.0f) + EPSN) * ascale)
#pragma unroll
        for (int ai = 0; ai < 2; ++ai)
#pragma unroll
            for (int m = 0; m < 4; ++m) { const float rstd = rs[ai * 4 + m];
                f32x4 a[2];
                const float c1 = -1.4426950408889634f * rstd, ic2 = __builtin_amdgcn_rcpf(rstd * rstd * 8.0f);
#pragma unroll
                for (int n = 0; n < 2; ++n) { const f32x4 ag = acc[ai][0][m][n], t = ag * acc[ai][1][m][n];
#pragma unroll
                    for (int j = 0; j < 4; ++j) a[n][j] = t[j] * __builtin_amdgcn_rcpf(__builtin_fmaf(__builtin_amdgcn_exp2f(ag[j] * c1), ic2, ic2)); }
                u32x2 w; w.x = pk4_fp8(a[0][0], a[0][1], a[0][2], a[0][3]); w.y = pk4_fp8(a[1][0], a[1][1], a[1][2], a[1][3]);
                *(u32x2*)(abase + (ai * HALF + m * 16) * 128) = w; }
    }
};
struct EpiProj { static constexpr bool PERM = true, AFTER_DRAIN = false, PROBE2 = false;
    const float* ss; bf16_t* o0; size_t tstride; float qs; int qt; int nq; float invd; int pad;
    __device__ __forceinline__ void touch(PG8_LAS unsigned char* lds, const Unit& u, int tid) const { touch_rows16(lds, ss, u.pm * BM, tid); }
    __device__ __forceinline__ void operator()(const f32x4 (&acc)[2][2][4][2], const Unit& u0, int wr, int wc, int fr, int fq) const {
        Unit u = u0; asm volatile("" : "+s"(u.pm), "+s"(u.pn));
        const int t = u.pn >> 2; bf16_t* dst = o0 + (size_t)t * tstride; const float sc = (t == qt) ? qs : 1.0f;
        EPI_ROW_SCALES(rs, ss, 16, nq, rsq_(q * invd + EPSN) * sc)
#pragma unroll
        for (int ai = 0; ai < 2; ++ai)
#pragma unroll
            for (int m = 0; m < 4; ++m) { const int r = u.pm * BM + ai * HALF + wr * 64 + m * 16 + fr; const float rstd = rs[ai * 4 + m];
#pragma unroll
                for (int bj = 0; bj < 2; ++bj) *(u32x4*)(dst + (size_t)r * 1024 + (u.pn & 3) * BM + bj * HALF + wc * 32 + fq * 8) = pack8(acc[ai][bj][m][0] * rstd, acc[ai][bj][m][1] * rstd); }
    }
};
struct EpiMdn { static constexpr bool PERM = true, AFTER_DRAIN = false, PROBE2 = false;
    const float* sgate; bf16_t* y; float scale; int pad;
    __device__ __forceinline__ void touch(PG8_LAS unsigned char* lds, const Unit& u, int tid) const { touch_rows1(lds, sgate, u.pm * BM, tid); }
    __device__ __forceinline__ void operator()(const f32x4 (&acc)[2][2][4][2], const Unit& u0, int wr, int wc, int fr, int fq) const {
        Unit u = u0; asm volatile("" : "+s"(u.pm), "+s"(u.pn));
        EPI_ROW_SCALES(rs, sgate, 1, 0, q * scale)
#pragma unroll
        for (int ai = 0; ai < 2; ++ai)
#pragma unroll
            for (int m = 0; m < 4; ++m) { const int r = u.pm * BM + ai * HALF + wr * 64 + m * 16 + fr; const float g = rs[ai * 4 + m];
#pragma unroll
                for (int bj = 0; bj < 2; ++bj) *(u32x4*)(y + (size_t)r * 1024 + u.pn * BM + bj * HALF + wc * 32 + fq * 8) = pack8(acc[ai][bj][m][0] * g, acc[ai][bj][m][1] * g); }
    }
};
struct GroupedOrder : StaticOrder {
    int b1, b2, b3, b4, b5, b6, b7; size_t estride;
    __device__ __forceinline__ void initg(const int* base, int N, int G_, int c_, size_t estride_) { init(__builtin_amdgcn_readfirstlane(base[8]), N, G_, c_); b1 = __builtin_amdgcn_readfirstlane(base[1]); b2 = __builtin_amdgcn_readfirstlane(base[2]); b3 = __builtin_amdgcn_readfirstlane(base[3]); b4 = __builtin_amdgcn_readfirstlane(base[4]); b5 = __builtin_amdgcn_readfirstlane(base[5]); b6 = __builtin_amdgcn_readfirstlane(base[6]); b7 = __builtin_amdgcn_readfirstlane(base[7]); estride = estride_; }
    __device__ __forceinline__ void initd(int M, int N, int G_, int c_) { init(M, N, G_, c_); b1 = b2 = b3 = b4 = b5 = b6 = b7 = 0x7fffffff; estride = 0; }
    __device__ __forceinline__ size_t boff(const Unit& u) const { const int r = u.pm * BM; const int e = (r >= b1) + (r >= b2) + (r >= b3) + (r >= b4) + (r >= b5) + (r >= b6) + (r >= b7); return (size_t)e * estride; }
};
struct MoeSplit { int nM_main, ntail;
    __device__ __forceinline__ void init(int nM, int nN, int G) { const int nwg = nM * nN, t = nwg % G; const bool on = (G % nN == 0) && t != 0 && t * 4 <= G && nwg > G; ntail = on ? t : 0; nM_main = (nwg - ntail) / nN; } };
struct TailOrder : GroupedOrder { int tpm, tpn;
    __device__ __forceinline__ bool next(int i, Unit& u) const { if (i != 0) return false; u.pm = tpm; u.pn = tpn; return true; } };
typedef int v8i_t __attribute__((ext_vector_type(8)));
typedef int v4i_t __attribute__((ext_vector_type(4)));
__device__ __forceinline__ v8i_t cat8(const bf16x8 lo, const bf16x8 hi) { const v4i_t a = __builtin_bit_cast(v4i_t, lo), b = __builtin_bit_cast(v4i_t, hi); return __builtin_shufflevector(a, b, 0, 1, 2, 3, 4, 5, 6, 7); }
template <class Epi, class Sched, bool ALIGN_EPI = false, bool SP2 = false, bool F8 = false, bool TILED = false>
__device__ __forceinline__ void gemm_phase(PG8_LAS unsigned char* lds, const Gemm g, const Sched& S, const Epi& E) {
    int tid_ = threadIdx.x; asm volatile("" : "+v"(tid_));
    const int tid = tid_, wid = __builtin_amdgcn_readfirstlane(tid >> 6), lane = tid & 63, wr = wid >> 2, wc = wid & 3, fr = lane & 15, fq = lane >> 4;
    int K_ = g.K; asm volatile("" : "+s"(K_));
    const int K = K_, nt = K / BK;
    unsigned voffA[2], voffB[2];
#pragma unroll
    for (int i = 0; i < 2; ++i) { int R, C; stage_rc(tid * 16 + i * 8192, R, C); const int Rb = Epi::PERM ? ((R & ~31) + perm32(R & 31)) : R;
        voffA[i] = TILED ? (unsigned)(R * 128 + C * 2) : (unsigned)(R * K + C) * 2u; voffB[i] = TILED ? (unsigned)(Rb * 128 + C * 2) : (unsigned)(Rb * K + C) * 2u; }
    const size_t kstep = TILED ? (size_t)32768 : (size_t)(BK * 2);
    const size_t hstep = TILED ? (size_t)16384 : (size_t)HALF * K * 2;
    const size_t tstep = (size_t)BM * K * 2;
    const unsigned ldsw = (unsigned)wid * 1024u;
    const int aoff = lds_byte(wr * 64 + fr, fq * 8), boff = lds_byte(wc * 32 + fr, fq * 8);
#define PG8_SA(b, h) (((b) * 2 + (h)) * HTB)
#define PG8_SB(b, h) ((4 + (b) * 2 + (h)) * HTB)
#define PG8_STAGE(bufoff, gbase, voff) do { _Pragma("unroll") for (int _i = 0; _i < 2; ++_i) \
        __builtin_amdgcn_global_load_lds((const unsigned*)((const char*)(gbase) + (voff)[_i]), (PG8_LAS unsigned*)(lds + (bufoff) + ldsw + _i * 8192), 16, 0, 0); } while (0)
#define PG8_LD16(off) (*(const PG8_LAS v4i_t*)(lds + (off)))
#define PG8_LDA(dst, b, h) do { if constexpr (F8) { _Pragma("unroll") for (int m = 0; m < 4; ++m) dst##8[m] = __builtin_shufflevector(PG8_LD16(PG8_SA(b, h) + aoff + m * 2048), PG8_LD16(PG8_SA(b, h) + aoff + m * 2048 + 1024), 0, 1, 2, 3, 4, 5, 6, 7); } \
        else { _Pragma("unroll") for (int m = 0; m < 4; ++m) _Pragma("unroll") for (int k = 0; k < 2; ++k) dst[m][k] = *(const PG8_LAS bf16x8*)(lds + PG8_SA(b, h) + aoff + m * 2048 + k * 1024); } } while (0)
#define PG8_LDB(dst, b, h) do { if constexpr (F8) { _Pragma("unroll") for (int n = 0; n < 2; ++n) dst##8[n] = __builtin_shufflevector(PG8_LD16(PG8_SB(b, h) + boff + n * 2048), PG8_LD16(PG8_SB(b, h) + boff + n * 2048 + 1024), 0, 1, 2, 3, 4, 5, 6, 7); } \
        else { _Pragma("unroll") for (int n = 0; n < 2; ++n) _Pragma("unroll") for (int k = 0; k < 2; ++k) dst[n][k] = *(const PG8_LAS bf16x8*)(lds + PG8_SB(b, h) + boff + n * 2048 + k * 1024); } } while (0)
#define PG8_MMA(ai, bj, At, Bt) do { __builtin_amdgcn_s_setprio(1); \
        if constexpr (F8) { asm volatile("s_nop 1"); _Pragma("unroll") for (int m = 0; m < 4; ++m) _Pragma("unroll") for (int n = 0; n < 2; ++n) \
            asm volatile("v_mfma_scale_f32_16x16x128_f8f6f4 %0, %1, %2, %0, %3, %3 op_sel_hi:[0,0,0]" : "+v"(acc[ai][bj][m][n]) : "v"(Bt##8[n]), "v"(At##8[m]), "v"(one_scale)); } \
        else { _Pragma("unroll") for (int m = 0; m < 4; ++m) _Pragma("unroll") for (int n = 0; n < 2; ++n) _Pragma("unroll") for (int k = 0; k < 2; ++k) \
            acc[ai][bj][m][n] = __builtin_amdgcn_mfma_f32_16x16x32_bf16(Bt[n][k], At[m][k], acc[ai][bj][m][n], 0, 0, 0); } \
        __builtin_amdgcn_s_setprio(0); } while (0)
#define PG8_WAIT_V(n) asm volatile("s_waitcnt vmcnt(" #n ")" ::: "memory")
#define PG8_WAIT_L(n) asm volatile("s_waitcnt lgkmcnt(" #n ")" ::: "memory")
#define PG8_BAR __builtin_amdgcn_s_barrier()
#define PG8_SCHED __builtin_amdgcn_sched_barrier(0)
    Unit cur, nxt; int ui = 0;
    if (!S.next(0, cur)) return;
    float zero_; asm volatile("v_mov_b32 %0, 0" : "=v"(zero_));
    f32x4 acc[2][2][4][2];
#pragma unroll
    for (int a = 0; a < 2; ++a)
#pragma unroll
        for (int b = 0; b < 2; ++b)
#pragma unroll
            for (int m = 0; m < 4; ++m)
#pragma unroll
                for (int n = 0; n < 2; ++n) acc[a][b][m][n] = (f32x4){0.f, 0.f, 0.f, 0.f};
    const int one_scale = 0x7F7F7F7F; (void)one_scale;
    const char* cA = (const char*)g.A + (size_t)cur.pm * tstep; const char* cB = (const char*)g.Bt + S.boff(cur) + (size_t)cur.pn * tstep;
    S.a_ready(cur);
    if constexpr (SP2) {
        PG8_STAGE(PG8_SB(0, 0), cB, voffB); PG8_STAGE(PG8_SB(0, 1), cB + hstep, voffB); PG8_STAGE(PG8_SA(0, 0), cA, voffA); PG8_STAGE(PG8_SA(0, 1), cA + hstep, voffA);
        if (wr == 1) PG8_BAR;
        PG8_WAIT_V(2); PG8_BAR;
        PG8_STAGE(PG8_SB(1, 0), cB + kstep, voffB); PG8_STAGE(PG8_SA(1, 0), cA + kstep, voffA); PG8_STAGE(PG8_SB(1, 1), cB + hstep + kstep, voffB);
        PG8_WAIT_V(6); PG8_BAR;
    } else {
        PG8_STAGE(PG8_SB(0, 0), cB, voffB); PG8_STAGE(PG8_SA(0, 0), cA, voffA); PG8_STAGE(PG8_SB(0, 1), cB + hstep, voffB); PG8_STAGE(PG8_SA(0, 1), cA + hstep, voffA);
        if (wr == 1) PG8_BAR;
        PG8_WAIT_V(4); PG8_BAR;
        PG8_STAGE(PG8_SB(1, 0), cB + kstep, voffB); PG8_STAGE(PG8_SA(1, 0), cA + kstep, voffA); PG8_STAGE(PG8_SB(1, 1), cB + hstep + kstep, voffB);
        PG8_WAIT_V(6); PG8_BAR;
    }
    for (;;) {
        const bool has_next = S.next(ui + 1, nxt);
        const char* nA = has_next ? (const char*)g.A + (size_t)nxt.pm * tstep : cA; const char* nB = has_next ? (const char*)g.Bt + S.boff(nxt) + (size_t)nxt.pn * tstep : cB;
#pragma nounroll
        for (int t = 0; t < nt; t += 2) {
            bf16x8 At[4][2], B0[2][2], B1[2][2]; v8i_t At8[4], B08[2], B18[2];
            const bool last = (t == nt - 2);
            const char* a1 = cA + (size_t)(t + 1) * kstep;
            const char* a2 = last ? nA : cA + (size_t)(t + 2) * kstep; const char* b2 = last ? nB : cB + (size_t)(t + 2) * kstep;
            const char* a3 = a2 + kstep; const char* b3 = b2 + kstep;
            if (last && has_next) S.a_ready(nxt);
            if (last) { const int tl_ = wid * 64 + (int)__builtin_amdgcn_mbcnt_hi(~0u, __builtin_amdgcn_mbcnt_lo(~0u, 0u)); E.touch(lds, cur, tl_); PG8_SCHED; }
            if constexpr (SP2) {
            PG8_LDB(B0, 0, 0); PG8_LDB(B1, 0, 1); PG8_SCHED; PG8_LDA(At, 0, 0); PG8_STAGE(PG8_SA(1, 1), a1 + hstep, voffA);
            PG8_WAIT_V(8); PG8_WAIT_L(0); PG8_BAR; PG8_MMA(0, 0, At, B0); PG8_MMA(0, 1, At, B1); PG8_BAR; PG8_SCHED;
            PG8_LDA(At, 0, 1); PG8_STAGE(PG8_SB(0, 0), b2, voffB); PG8_STAGE(PG8_SB(0, 1), b2 + hstep, voffB); PG8_STAGE(PG8_SA(0, 0), a2, voffA);
            PG8_WAIT_V(8); PG8_WAIT_L(0); PG8_BAR; PG8_MMA(1, 0, At, B0); PG8_MMA(1, 1, At, B1); PG8_BAR; PG8_SCHED;
            PG8_LDB(B0, 1, 0); PG8_LDB(B1, 1, 1); PG8_SCHED; PG8_LDA(At, 1, 0); PG8_STAGE(PG8_SA(0, 1), a2 + hstep, voffA);
            PG8_WAIT_V(8); PG8_WAIT_L(0); PG8_BAR; PG8_MMA(0, 0, At, B0); PG8_MMA(0, 1, At, B1); PG8_BAR; PG8_SCHED;
            PG8_LDA(At, 1, 1); PG8_STAGE(PG8_SB(1, 0), b3, voffB); PG8_STAGE(PG8_SB(1, 1), b3 + hstep, voffB); PG8_STAGE(PG8_SA(1, 0), a3, voffA);
            PG8_WAIT_V(8); PG8_WAIT_L(0); PG8_BAR; PG8_MMA(1, 0, At, B0); PG8_MMA(1, 1, At, B1); PG8_BAR; PG8_SCHED;
            } else {
            PG8_LDB(B0, 0, 0); PG8_SCHED; PG8_LDA(At, 0, 0); PG8_STAGE(PG8_SA(1, 1), a1 + hstep, voffA);
            PG8_WAIT_L(8); PG8_BAR; PG8_WAIT_L(0); PG8_MMA(0, 0, At, B0); PG8_BAR; PG8_SCHED;
            PG8_LDB(B1, 0, 1); PG8_STAGE(PG8_SB(0, 0), b2, voffB);
            PG8_BAR; PG8_WAIT_L(0); PG8_MMA(0, 1, At, B1); PG8_BAR;
            PG8_LDA(At, 0, 1); PG8_STAGE(PG8_SA(0, 0), a2, voffA);
            PG8_BAR; PG8_WAIT_L(0); PG8_MMA(1, 0, At, B0); PG8_BAR; PG8_SCHED;
            PG8_STAGE(PG8_SB(0, 1), b2 + hstep, voffB);
            PG8_WAIT_V(6); PG8_BAR; PG8_MMA(1, 1, At, B1); PG8_BAR;
            PG8_LDB(B0, 1, 0); PG8_SCHED; PG8_LDA(At, 1, 0); PG8_STAGE(PG8_SA(0, 1), a2 + hstep, voffA);
            PG8_WAIT_L(8); PG8_BAR; PG8_WAIT_L(0); PG8_MMA(0, 0, At, B0); PG8_BAR; PG8_SCHED;
            PG8_LDB(B1, 1, 1); PG8_STAGE(PG8_SB(1, 0), b3, voffB);
            PG8_BAR; PG8_WAIT_L(0); PG8_MMA(0, 1, At, B1); PG8_BAR;
            PG8_LDA(At, 1, 1); PG8_STAGE(PG8_SA(1, 0), a3, voffA);
            PG8_BAR; PG8_WAIT_L(0); PG8_MMA(1, 0, At, B0); PG8_BAR; PG8_SCHED;
            PG8_STAGE(PG8_SB(1, 1), b3 + hstep, voffB);
            PG8_WAIT_V(6); PG8_BAR; PG8_MMA(1, 1, At, B1); PG8_BAR;
            }
        }
        if constexpr (F8) {
            asm volatile("s_nop 7\n\ts_nop 7" ::: "memory");
#pragma unroll
            for (int a_ = 0; a_ < 2; ++a_)
#pragma unroll
                for (int b_ = 0; b_ < 2; ++b_) asm volatile("" : "+v"(acc[a_][b_][0][0]), "+v"(acc[a_][b_][0][1]), "+v"(acc[a_][b_][1][0]), "+v"(acc[a_][b_][1][1]), "+v"(acc[a_][b_][2][0]), "+v"(acc[a_][b_][2][1]), "+v"(acc[a_][b_][3][0]), "+v"(acc[a_][b_][3][1]));
        }
        if constexpr (ALIGN_EPI) { if (wr == 0) PG8_BAR; }
        if constexpr (!Epi::AFTER_DRAIN) { E(acc, cur, wr, wc, fr, fq); if (REPEAT == 13 && Epi::PROBE2) { asm volatile("" ::: "memory"); E(acc, cur, wr, wc, fr, fq); } S.done(cur); }
        if (!has_next) break;
#pragma unroll
        for (int a = 0; a < 2; ++a)
#pragma unroll
            for (int b = 0; b < 2; ++b)
#pragma unroll
                for (int m = 0; m < 4; ++m)
#pragma unroll
                    for (int n = 0; n < 2; ++n) acc[a][b][m][n] = (f32x4){0.f, 0.f, 0.f, 0.f};
        cur = nxt; cA = nA; cB = nB; ++ui;
        if constexpr (ALIGN_EPI) { if (wr == 1) PG8_BAR; }
    }
    PG8_WAIT_V(0);
    if constexpr (!ALIGN_EPI) { if (wr == 0) PG8_BAR; }
    PG8_BAR;
    if constexpr (Epi::AFTER_DRAIN) { E.fused(acc, cur, wr, wc, fr, fq, lds, wid, lane); S.done(cur); }
#undef PG8_SA
#undef PG8_SB
#undef PG8_STAGE
#undef PG8_LDA
#undef PG8_LD16
#undef PG8_LDB
#undef PG8_MMA
#undef PG8_WAIT_V
#undef PG8_WAIT_L
#undef PG8_BAR
#undef PG8_SCHED
}
}


namespace att {
typedef short bf16x8 __attribute__((ext_vector_type(8)));
typedef short s16x4 __attribute__((ext_vector_type(4)));
typedef float f32x16 __attribute__((ext_vector_type(16)));
typedef unsigned u32x4 __attribute__((ext_vector_type(4)));
#define ATT_LAS __attribute__((address_space(3)))
#define SBAR() __builtin_amdgcn_sched_barrier(0)
constexpr int L_V = 0, L_K = 32768, L_KM = 49152, L_WS = 102400;
constexpr int KP_MLA = 400, KT_MLA = 64 * KP_MLA;
constexpr int KP_SB = 272, KT_SB = 64 * KP_SB;
static_assert(L_KM + 2 * KT_MLA <= L_WS && L_K + 2 * KT_SB <= L_WS && L_WS + 8 * 256 <= 131072, "attention LDS map");
constexpr float THR2 = 11.5f;

__device__ __forceinline__ int crow(int r, int hi) { return (r & 3) + 8 * (r >> 2) + 4 * hi; }
__device__ __forceinline__ unsigned cvtpk(float lo, float hi) { unsigned r; asm volatile("v_cvt_pk_bf16_f32 %0, %1, %2" : "=v"(r) : "v"(lo), "v"(hi)); return r; }
__device__ __forceinline__ int v_st(int k, int c) { const int kk = (k & ~0xC) | ((k & 4) << 1) | ((k & 8) >> 1); return ((kk >> 3) * 4 + (c >> 5)) * 512 + ((kk & 7) * 32 + (c & 31)) * 2; }
__device__ __forceinline__ int v_rd_base(int lane) { return ((lane & 3) << 3) | (((lane >> 2) & 3) << 6) | (((lane >> 4) & 1) << 5) | (((lane >> 5) & 1) << 8); }
constexpr int v_rd_off(int d0, int ks, int half) { return d0 * 512 + ks * 4096 + half * 2048; }
template <int OFF> __device__ __forceinline__ s16x4 tr_read(int vb) { s16x4 r; asm volatile("ds_read_b64_tr_b16 %0, %1 offset:%2" : "=&v"(r) : "v"(vb), "i"(OFF) : "memory"); return r; }
template <int D0> __device__ __forceinline__ void pv_one(f32x16& od, int vb, bf16x8 pa0, bf16x8 pa1, bf16x8 pa2, bf16x8 pa3) {
    const s16x4 l0 = tr_read<v_rd_off(D0, 0, 0)>(vb), h0 = tr_read<v_rd_off(D0, 0, 1)>(vb), l1 = tr_read<v_rd_off(D0, 1, 0)>(vb), h1 = tr_read<v_rd_off(D0, 1, 1)>(vb);
    const s16x4 l2 = tr_read<v_rd_off(D0, 2, 0)>(vb), h2 = tr_read<v_rd_off(D0, 2, 1)>(vb), l3 = tr_read<v_rd_off(D0, 3, 0)>(vb), h3 = tr_read<v_rd_off(D0, 3, 1)>(vb);
    asm volatile("s_waitcnt lgkmcnt(0)" ::: "memory"); SBAR();
#define ATT_PK(L, H) (bf16x8){L[0], L[1], L[2], L[3], H[0], H[1], H[2], H[3]}
    od = __builtin_amdgcn_mfma_f32_32x32x16_bf16(pa0, ATT_PK(l0, h0), od, 0, 0, 0);
    od = __builtin_amdgcn_mfma_f32_32x32x16_bf16(pa1, ATT_PK(l1, h1), od, 0, 0, 0);
    od = __builtin_amdgcn_mfma_f32_32x32x16_bf16(pa2, ATT_PK(l2, h2), od, 0, 0, 0);
    od = __builtin_amdgcn_mfma_f32_32x32x16_bf16(pa3, ATT_PK(l3, h3), od, 0, 0, 0);
#undef ATT_PK
}
__device__ __forceinline__ void pv_d0(f32x16* o, int vb, bf16x8 pa0, bf16x8 pa1, bf16x8 pa2, bf16x8 pa3) {
    pv_one<0>(o[0], vb, pa0, pa1, pa2, pa3); pv_one<1>(o[1], vb, pa0, pa1, pa2, pa3); pv_one<2>(o[2], vb, pa0, pa1, pa2, pa3); pv_one<3>(o[3], vb, pa0, pa1, pa2, pa3);
}
template <int ND0, int PITCH> __device__ __forceinline__ void qkt(f32x16& p0, f32x16& p1, const ATT_LAS char* Kt, const bf16x8* qr, int r32, int hi) {
    p0 = f32x16{}; p1 = f32x16{};
    const ATT_LAS char* kb = Kt + r32 * PITCH + hi * 16;
#pragma unroll
    for (int d0 = 0; d0 < ND0; ++d0) {
        const bf16x8 b0 = *(const ATT_LAS bf16x8*)(kb + d0 * 32), b1 = *(const ATT_LAS bf16x8*)(kb + 32 * PITCH + d0 * 32);
        p0 = __builtin_amdgcn_mfma_f32_32x32x16_bf16(b0, qr[d0], p0, 0, 0, 0);
        p1 = __builtin_amdgcn_mfma_f32_32x32x16_bf16(b1, qr[d0], p1, 0, 0, 0); }
}
__device__ __forceinline__ void pack_p(const f32x16& p0, const f32x16& p1, bf16x8& pa0, bf16x8& pa1, bf16x8& pa2, bf16x8& pa3) {
#define ATT_PK4(P, BASE, OUT) do { unsigned a0 = cvtpk(P[BASE + 0], P[BASE + 1]), a1 = cvtpk(P[BASE + 2], P[BASE + 3]);   \
    unsigned b0 = cvtpk(P[BASE + 4], P[BASE + 5]), b1 = cvtpk(P[BASE + 6], P[BASE + 7]);                              \
    auto r0 = __builtin_amdgcn_permlane32_swap(a0, b0, false, false); auto r1 = __builtin_amdgcn_permlane32_swap(a1, b1, false, false); \
    u32x4 w = {r0[0], r1[0], r0[1], r1[1]}; OUT = *reinterpret_cast<bf16x8*>(&w); } while (0)
    ATT_PK4(p0, 0, pa0); ATT_PK4(p0, 8, pa1); ATT_PK4(p1, 0, pa2); ATT_PK4(p1, 8, pa3);
#undef ATT_PK4
}
__device__ __forceinline__ void softmax_tile(f32x16& p0, f32x16& p1, float& m_reg, float& l_reg, float& alpha) {
    float pmax = p0[0];
#pragma unroll
    for (int r = 1; r < 16; ++r) pmax = fmaxf(pmax, p0[r]);
#pragma unroll
    for (int r = 0; r < 16; ++r) pmax = fmaxf(pmax, p1[r]);
    { auto rr = __builtin_amdgcn_permlane32_swap(__float_as_uint(pmax), __float_as_uint(pmax), false, false); pmax = fmaxf(__uint_as_float(rr[0]), __uint_as_float(rr[1])); }
    float mn;
    if (__builtin_expect(__all(pmax - m_reg <= THR2), 1)) { mn = m_reg; alpha = 1.f; }
    else { mn = fmaxf(m_reg, pmax); alpha = __builtin_amdgcn_exp2f(m_reg - mn); m_reg = mn; }
    float ps = 0.f;
#pragma unroll
    for (int r = 0; r < 16; ++r) { p0[r] = __builtin_amdgcn_exp2f(p0[r] - mn); ps += p0[r]; }
#pragma unroll
    for (int r = 0; r < 16; ++r) { p1[r] = __builtin_amdgcn_exp2f(p1[r] - mn); ps += p1[r]; }
    { auto rr = __builtin_amdgcn_permlane32_swap(__float_as_uint(ps), __float_as_uint(ps), false, false); ps = __uint_as_float(rr[0]) + __uint_as_float(rr[1]); }
    l_reg = l_reg * alpha + ps;
}

__device__ __forceinline__ void mla_smpv(f32x16& p0, f32x16& p1, float& m_reg, float& l_reg, f32x16 (&o)[4], ATT_LAS float* al_l, int r32, int hi, int vb) {
    float alpha; softmax_tile(p0, p1, m_reg, l_reg, alpha);
    if (__any(alpha < 1.f)) { if (hi == 0) al_l[r32] = alpha; asm volatile("s_waitcnt lgkmcnt(0)" ::: "memory");
#pragma unroll
        for (int d = 0; d < 4; ++d)
#pragma unroll
            for (int r = 0; r < 16; ++r) o[d][r] *= al_l[crow(r, hi)]; }
    bf16x8 pa0, pa1, pa2, pa3; pack_p(p0, p1, pa0, pa1, pa2, pa3); SBAR();
    pv_d0(o, vb, pa0, pa1, pa2, pa3);
}
__device__ __forceinline__ void store_o_tile(ATT_LAS char* stg, const f32x16 (&o)[4], const float* rl, bf16* Orow0, int lane, int r32, int hi) {
#pragma unroll
    for (int r = 0; r < 16; ++r) { const float sc = rl ? rl[r] : 1.0f; ATT_LAS char* rp = stg + crow(r, hi) * 272 + r32 * 2;
#pragma unroll
        for (int d0 = 0; d0 < 4; ++d0) *(ATT_LAS unsigned short*)(rp + d0 * 64) = (unsigned short)(cvtpk(o[d0][r] * sc, 0.f) & 0xffffu); }
    asm volatile("s_waitcnt lgkmcnt(0)" ::: "memory");
#pragma unroll
    for (int i = 0; i < 8; ++i) { const int q = lane + 64 * i, row = q >> 4, c16 = q & 15;
        const u32x4 v = *(const ATT_LAS u32x4*)(stg + row * 272 + c16 * 16);
        *(u32x4*)(Orow0 + (size_t)row * 1024 + c16 * 8) = v; }
    asm volatile("s_waitcnt lgkmcnt(0)" ::: "memory");
}
__device__ __forceinline__ void mla_unit(ATT_LAS char* lds, const bf16* __restrict__ Q, const bf16* __restrict__ KN, const bf16* __restrict__ KR, const bf16* __restrict__ V, bf16* __restrict__ O, int b, int hd, int qb) {
    int tid_ = threadIdx.x; asm volatile("" : "+v"(tid_));
    const int tid = tid_, wid = __builtin_amdgcn_readfirstlane(tid >> 6), lane = tid & 63, r32 = lane & 31, hi = lane >> 5;
    ATT_LAS char* Vl = lds + L_V; ATT_LAS char* Kl = lds + L_KM; ATT_LAS float* li_l = (ATT_LAS float*)(lds + L_WS) + wid * 64; ATT_LAS float* al_l = li_l + 32;
    const size_t tok0 = (size_t)b * S; const int q0 = qb * 256;
    bf16x8 qr[12];
    { const bf16* Qw = Q + (tok0 + q0 + wid * 32 + r32) * 1536 + hd * 192 + hi * 8;
#pragma unroll
      for (int d0 = 0; d0 < 12; ++d0) qr[d0] = *(const bf16x8*)(Qw + d0 * 16); }
    float m_reg = -1e30f, l_reg = 0.f; f32x16 o[4] = {};
    const int NT = 4 * qb + 4, jw = 4 * qb + (wid >> 1);
    const int sr = tid >> 4, sc = (tid & 15) * 8, vst0 = v_st(sr, sc), vst1 = v_st(32 + sr, sc);
    const bf16* vsrc = V + (tok0 + sr) * 1024 + hd * 128 + sc;
    const bf16* ksrc[3]; int kstr[3], kdst[3];
#pragma unroll
    for (int i = 0; i < 3; ++i) { const int q = tid + 512 * i, krow = q / 24, kc = q - krow * 24;
        ksrc[i] = (kc < 16) ? KN + (tok0 + krow) * 1024 + hd * 128 + kc * 8 : KR + (tok0 + krow) * 64 + (kc - 16) * 8;
        kstr[i] = (kc < 16) ? 64 * 1024 : 64 * 64; kdst[i] = krow * KP_MLA + kc * 16; }
    const int vb0 = (int)(uintptr_t)Vl + v_rd_base(lane);
    bf16x8 vs0, vs1, ks0, ks1, ks2;
#define MLA_SLOAD(j) do { vs0 = *(const bf16x8*)(vsrc + (size_t)(j) * 65536); vs1 = *(const bf16x8*)(vsrc + (size_t)(j) * 65536 + 32 * 1024); \
        ks0 = *(const bf16x8*)(ksrc[0] + (size_t)(j) * kstr[0]); ks1 = *(const bf16x8*)(ksrc[1] + (size_t)(j) * kstr[1]); ks2 = *(const bf16x8*)(ksrc[2] + (size_t)(j) * kstr[2]); } while (0)
#define MLA_SWRITE(kb, vbf) do { *(ATT_LAS bf16x8*)(Vl + (vbf) * 16384 + vst0) = vs0; *(ATT_LAS bf16x8*)(Vl + (vbf) * 16384 + vst1) = vs1; \
        *(ATT_LAS bf16x8*)(Kl + (kb) * KT_MLA + kdst[0]) = ks0; *(ATT_LAS bf16x8*)(Kl + (kb) * KT_MLA + kdst[1]) = ks1; *(ATT_LAS bf16x8*)(Kl + (kb) * KT_MLA + kdst[2]) = ks2; } while (0)
    const bool late = wid >= 4;
    f32x16 p0 = {}, p1 = {};
#define MLA_SMPV(vbuf) mla_smpv(p0, p1, m_reg, l_reg, o, al_l, r32, hi, vb0 + (vbuf) * 16384)
    MLA_SLOAD(0); asm volatile("s_waitcnt vmcnt(0)" ::: "memory"); MLA_SWRITE(0, 0); __syncthreads();
    int vcur = 0;
    for (int j = 0; j < NT; ++j) {
        const int cur = j & 1, vprev = (vcur == 0) ? 2 : vcur - 1, vnext = (vcur == 2) ? 0 : vcur + 1;
        if (j + 1 < NT) MLA_SLOAD(j + 1);
        if (!late && j <= jw) qkt<12, KP_MLA>(p0, p1, Kl + cur * KT_MLA, qr, r32, hi);
        SBAR();
        if (late ? (j >= 1 && j - 1 <= jw) : (j <= jw)) MLA_SMPV(late ? vprev : vcur);
        SBAR();
        if (late && j <= jw) { int r32b = r32; asm volatile("" : "+v"(r32b)); qkt<12, KP_MLA>(p0, p1, Kl + cur * KT_MLA, qr, r32b, hi); }
        if (j + 1 < NT) { asm volatile("s_waitcnt vmcnt(0)" ::: "memory"); MLA_SWRITE(cur ^ 1, vnext); }
        __syncthreads();
        vcur = vnext;
    }
    if (late && NT - 1 <= jw) { const int vlast = (vcur == 0) ? 2 : vcur - 1; MLA_SMPV(vlast); }
    __syncthreads();
#undef MLA_SMPV
#undef MLA_SLOAD
#undef MLA_SWRITE
    if (hi == 0) li_l[r32] = l_reg; asm volatile("s_waitcnt lgkmcnt(0)" ::: "memory");
    bf16* Ow = O + (tok0 + q0 + wid * 32) * 1024 + hd * 128 + r32;
#pragma unroll
    for (int r = 0; r < 16; ++r) { const float rl = __builtin_amdgcn_rcpf(li_l[crow(r, hi)]); const int orow = crow(r, hi);
#pragma unroll
        for (int d0 = 0; d0 < 4; ++d0) Ow[(size_t)orow * 1024 + d0 * 32] = (bf16)(cvtpk(o[d0][r] * rl, 0.f) & 0xffffu); }
}

typedef int v8i __attribute__((ext_vector_type(8)));
typedef int v4i __attribute__((ext_vector_type(4)));
constexpr int L8_K = 0, L8_V = 3 * 13312;
static_assert(L8_V + 3 * 10240 <= L_WS, "fp8 MLA LDS map");
#define MFMA8_32(accv, A, B) asm volatile("s_nop 4\n\tv_mfma_scale_f32_32x32x64_f8f6f4 %0, %1, %2, %0, %3, %3 op_sel_hi:[0,0,0]" : "+v"(accv) : "v"(A), "v"(B), "v"(one_scale))
#define MFMA8_32_Z(accv, A, B) asm volatile("s_nop 4\n\tv_mfma_scale_f32_32x32x64_f8f6f4 %0, %1, %2, 0, %3, %3 op_sel_hi:[0,0,0]" : "=&v"(accv) : "v"(A), "v"(B), "v"(one_scale))
#define MFMA8_32_LAST(accv, A, B) asm volatile("s_nop 1\n\tv_mfma_scale_f32_32x32x64_f8f6f4 %0, %1, %2, %0, %3, %3 op_sel_hi:[0,0,0]\n\ts_nop 15\n\ts_nop 15" : "+v"(accv) : "v"(A), "v"(B), "v"(one_scale))
__device__ __forceinline__ v8i ld32(const ATT_LAS char* p) { const v4i a = *(const ATT_LAS v4i*)p, b = *(const ATT_LAS v4i*)(p + 16); return __builtin_shufflevector(a, b, 0, 1, 2, 3, 4, 5, 6, 7); }
__device__ __forceinline__ unsigned pk4f8(float a, float b, float c, float d) { int w = __builtin_amdgcn_cvt_pk_fp8_f32(a, b, 0, false); w = __builtin_amdgcn_cvt_pk_fp8_f32(c, d, w, true); return (unsigned)w; }
__device__ __forceinline__ void softmax_tile8(f32x16& p0, f32x16& p1, float& m_reg, float& l_reg, float& alpha) {
    float pmax = p0[0];
#pragma unroll
    for (int r = 1; r < 16; ++r) pmax = fmaxf(pmax, p0[r]);
#pragma unroll
    for (int r = 0; r < 16; ++r) pmax = fmaxf(pmax, p1[r]);
    { auto rr = __builtin_amdgcn_permlane32_swap(__float_as_uint(pmax), __float_as_uint(pmax), false, false); pmax = fmaxf(__uint_as_float(rr[0]), __uint_as_float(rr[1])); }
    float mn;
    if (__builtin_expect(__all(pmax - m_reg <= 128.f), 1)) { mn = m_reg; alpha = 1.f; }
    else { mn = fmaxf(m_reg, pmax); alpha = __builtin_amdgcn_exp2f((m_reg - mn) * 0.0625f); m_reg = mn; }
    float ps = 0.f; const float mb = mn * 0.0625f;
#pragma unroll
    for (int r = 0; r < 16; ++r) { p0[r] = __builtin_amdgcn_exp2f(p0[r] * 0.0625f - mb); ps += p0[r]; }
#pragma unroll
    for (int r = 0; r < 16; ++r) { p1[r] = __builtin_amdgcn_exp2f(p1[r] * 0.0625f - mb); ps += p1[r]; }
    { auto rr = __builtin_amdgcn_permlane32_swap(__float_as_uint(ps), __float_as_uint(ps), false, false); ps = __uint_as_float(rr[0]) + __uint_as_float(rr[1]); }
    l_reg = l_reg * alpha + ps;
}
__device__ __forceinline__ void mla8_unit(ATT_LAS char* lds, const unsigned char* __restrict__ Q8, const unsigned char* __restrict__ K8T, const unsigned char* __restrict__ VT8T, bf16* __restrict__ O, int b, int hd, int qb) {
    int tid_ = threadIdx.x; asm volatile("" : "+v"(tid_));
    const int tid = tid_, wid = __builtin_amdgcn_readfirstlane(tid >> 6), lane = tid & 63, r32 = lane & 31, hi = lane >> 5;
    ATT_LAS char* Kl = lds + L8_K; ATT_LAS char* Vl = lds + L8_V; ATT_LAS float* li_l = (ATT_LAS float*)(lds + L_WS) + wid * 64; ATT_LAS float* al_l = li_l + 32;
    const size_t tok0 = (size_t)b * S; const int q0 = qb * 256;
    const int one_scale = 0x7F7F7F7F;
    v8i qr[3];
    { const unsigned char* Qw = Q8 + (tok0 + q0 + wid * 32 + r32) * 1536 + hd * 192 + hi * 32;
#pragma unroll
      for (int d = 0; d < 3; ++d) { const v4i a = *(const v4i*)(Qw + 64 * d), c = *(const v4i*)(Qw + 64 * d + 16); qr[d] = __builtin_shufflevector(a, c, 0, 1, 2, 3, 4, 5, 6, 7); } }
    float m_reg = -1e30f, l_reg = 0.f; f32x16 o[4] = {};
    const int NT = 4 * qb + 4, jw = 4 * qb + (wid >> 1);
    if (wid >= 4) __builtin_amdgcn_s_setprio(1);
    const unsigned char* kt = K8T + (size_t)((b * 8 + hd) * 64) * 13312 + lane * 16;
    const unsigned char* vt = VT8T + (size_t)((b * 8 + hd) * 64) * 10240 + lane * 16;
#define M8_DMA(j, slot) do { _Pragma("unroll") for (int i_ = 0; i_ < 3; ++i_) { int p_ = wid + 8 * i_; p_ = p_ > 22 ? 22 : p_; \
        if (p_ < 13) __builtin_amdgcn_global_load_lds((const unsigned*)(kt + (size_t)(j) * 13312 + p_ * 1024), (ATT_LAS unsigned*)(Kl + (slot) * 13312 + p_ * 1024), 16, 0, 0); \
        else __builtin_amdgcn_global_load_lds((const unsigned*)(vt + (size_t)(j) * 10240 + (p_ - 13) * 1024), (ATT_LAS unsigned*)(Vl + (slot) * 10240 + (p_ - 13) * 1024), 16, 0, 0); } } while (0)
    M8_DMA(0, 0); M8_DMA(1, 1);
    int slot = 0;
    for (int j = 0; j < NT; ++j) {
        if (j + 1 < NT) asm volatile("s_waitcnt vmcnt(3)" ::: "memory"); else asm volatile("s_waitcnt vmcnt(0)" ::: "memory");
        __builtin_amdgcn_s_barrier(); asm volatile("" ::: "memory");
        const int s2 = (slot == 0) ? 2 : slot - 1;
        if (j + 2 < NT) M8_DMA(j + 2, s2);
        if (j <= jw) {
            f32x16 p0, p1;
            const ATT_LAS char* kb = Kl + slot * 13312 + r32 * 208 + hi * 32;
            const ATT_LAS char* vbp = Vl + slot * 10240 + r32 * 80 + hi * 32;
            v8i ka[3], kc[3], vf[4];
#pragma unroll
            for (int d = 0; d < 3; ++d) { ka[d] = ld32(kb + 64 * d); kc[d] = ld32(kb + 32 * 208 + 64 * d); }
            MFMA8_32_Z(p0, ka[0], qr[0]); MFMA8_32_Z(p1, kc[0], qr[0]);
#pragma unroll
            for (int d = 1; d < 3; ++d) { MFMA8_32(p0, ka[d], qr[d]); MFMA8_32(p1, kc[d], qr[d]); }
#pragma unroll
            for (int d0 = 0; d0 < 4; ++d0) vf[d0] = ld32(vbp + d0 * 32 * 80);
            asm volatile("s_nop 15\n\ts_nop 15" : "+v"(p0), "+v"(p1));
            float alpha; softmax_tile8(p0, p1, m_reg, l_reg, alpha);
            if (__any(alpha < 1.f)) { if (hi == 0) al_l[r32] = alpha; asm volatile("s_waitcnt lgkmcnt(0)" ::: "memory");
#pragma unroll
                for (int d = 0; d < 4; ++d)
#pragma unroll
                    for (int r = 0; r < 16; ++r) o[d][r] *= al_l[crow(r, hi)]; }
            v8i pf;
#pragma unroll
            for (int g = 0; g < 4; ++g) { const unsigned ag = pk4f8(p0[4 * g], p0[4 * g + 1], p0[4 * g + 2], p0[4 * g + 3]), bg = pk4f8(p1[4 * g], p1[4 * g + 1], p1[4 * g + 2], p1[4 * g + 3]);
                auto rr = __builtin_amdgcn_permlane32_swap(ag, bg, false, false); pf[2 * g] = (int)rr[0]; pf[2 * g + 1] = (int)rr[1]; }
#pragma unroll
            for (int d0 = 0; d0 < 4; ++d0) MFMA8_32(o[d0], pf, vf[d0]);
            asm volatile("s_nop 15\n\ts_nop 15" : "+v"(o[0]), "+v"(o[1]), "+v"(o[2]), "+v"(o[3]));
        }
        slot = (slot == 2) ? 0 : slot + 1;
    }
#undef M8_DMA
    __builtin_amdgcn_s_setprio(0);
    __builtin_amdgcn_s_barrier(); asm volatile("" ::: "memory");
    if (hi == 0) li_l[r32] = l_reg; asm volatile("s_waitcnt lgkmcnt(0)" ::: "memory");
    float rl[16];
#pragma unroll
    for (int r = 0; r < 16; ++r) rl[r] = __builtin_amdgcn_rcpf(li_l[crow(r, hi)]);
    store_o_tile(lds + wid * 8704, o, rl, O + (tok0 + q0 + wid * 32) * 1024 + hd * 128, lane, r32, hi);
    __builtin_amdgcn_s_barrier(); asm volatile("" ::: "memory");
}

__device__ __forceinline__ void sb_unit(ATT_LAS char* lds, volatile ATT_LAS unsigned* done, unsigned seq, const bf16* __restrict__ Q, const bf16* __restrict__ K, const bf16* __restrict__ V, bf16* __restrict__ O, int b, int hd, int qb) {
    int tid_ = threadIdx.x; asm volatile("" : "+v"(tid_));
    const int tid = tid_, wid = __builtin_amdgcn_readfirstlane(tid >> 6), lane = tid & 63, r32 = lane & 31, hi = lane >> 5;
    ATT_LAS char* Vl = lds + L_V; ATT_LAS char* Kl = lds + L_K;
    const size_t tok0 = (size_t)b * S; const int q0 = qb * 256;
    bf16x8 qr[8];
    { const bf16* Qw = Q + (tok0 + q0 + wid * 32 + r32) * 1024 + hd * 128 + hi * 8;
#pragma unroll
      for (int d0 = 0; d0 < 8; ++d0) qr[d0] = *(const bf16x8*)(Qw + d0 * 16); }
    float carry = 1.f; f32x16 o[4] = {}; bool wdone = false;
    if (wid >= 4) __builtin_amdgcn_s_setprio(1);
    const int NT = 4 * qb + 4, jw = 4 * qb + (wid >> 1), lim = 32 * (wid & 1) + r32;
    const int sr = tid >> 4, sc = (tid & 15) * 8, vst0 = v_st(sr, sc), vst1 = v_st(32 + sr, sc), kst0 = sr * KP_SB + sc * 2, kst1 = (32 + sr) * KP_SB + sc * 2;
    const bf16* vsrc = V + (tok0 + sr) * 1024 + hd * 128 + sc; const bf16* ksrc = K + (tok0 + sr) * 1024 + hd * 128 + sc;
    const int vb0 = (int)(uintptr_t)Vl + v_rd_base(lane);
    bf16x8 vs0, vs1, ks0, ks1;
#define SB_SLOAD(j) do { vs0 = *(const bf16x8*)(vsrc + (size_t)(j) * 65536); vs1 = *(const bf16x8*)(vsrc + (size_t)(j) * 65536 + 32 * 1024); \
        ks0 = *(const bf16x8*)(ksrc + (size_t)(j) * 65536); ks1 = *(const bf16x8*)(ksrc + (size_t)(j) * 65536 + 32 * 1024); } while (0)
#define SB_SWRITE(bf) do { *(ATT_LAS bf16x8*)(Vl + (bf) * 16384 + vst0) = vs0; *(ATT_LAS bf16x8*)(Vl + (bf) * 16384 + vst1) = vs1; \
        *(ATT_LAS bf16x8*)(Kl + (bf) * KT_SB + kst0) = ks0; *(ATT_LAS bf16x8*)(Kl + (bf) * KT_SB + kst1) = ks1; } while (0)
    SB_SLOAD(NT - 1); asm volatile("s_waitcnt vmcnt(0)" ::: "memory"); SB_SWRITE(0); __syncthreads();
    for (int it = 0; it < NT; ++it) {
        const int cur = it & 1, j = NT - 1 - it;
        if (it + 1 < NT) SB_SLOAD(j - 1);
        if (j <= jw && !wdone) {
            f32x16 p0, p1, r0, r1;
            qkt<8, KP_SB>(p0, p1, Kl + cur * KT_SB, qr, r32, hi);
#pragma unroll
            for (int r = 0; r < 16; ++r) { const float e0 = __builtin_amdgcn_exp2f(fminf(p0[r], 64.f)), e1 = __builtin_amdgcn_exp2f(fminf(p1[r], 64.f));
                r0[r] = __builtin_amdgcn_rcpf(1.0f + e0); r1[r] = __builtin_amdgcn_rcpf(1.0f + e1); p0[r] = e0 * r0[r]; p1[r] = e1 * r1[r]; }
            if (j == jw) {
#pragma unroll
                for (int r = 0; r < 16; ++r) { const int key = crow(r, hi); if (key >= lim) { r0[r] = 1.f; p0[r] = 0.f; } if (key + 32 >= lim) { r1[r] = 1.f; p1[r] = 0.f; } }
            }
            float T[8], U[8], Tp[8];
#pragma unroll
            for (int g = 0; g < 4; ++g) {
                { const float a0 = r0[4 * g], a1 = r0[4 * g + 1], a2 = r0[4 * g + 2], a3 = r0[4 * g + 3]; const float x2 = a3, x1 = x2 * a2, x0 = x1 * a1; T[g] = x0 * a0; r0[4 * g] = x0; r0[4 * g + 1] = x1; r0[4 * g + 2] = x2; r0[4 * g + 3] = 1.f; }
                { const float a0 = r1[4 * g], a1 = r1[4 * g + 1], a2 = r1[4 * g + 2], a3 = r1[4 * g + 3]; const float x2 = a3, x1 = x2 * a2, x0 = x1 * a1; T[4 + g] = x0 * a0; r1[4 * g] = x0; r1[4 * g + 1] = x1; r1[4 * g + 2] = x2; r1[4 * g + 3] = 1.f; }
            }
#pragma unroll
            for (int g = 0; g < 8; ++g) { auto rr = __builtin_amdgcn_permlane32_swap(__float_as_uint(T[g]), __float_as_uint(T[g]), false, false); const float ta = __uint_as_float(rr[0]), tb = __uint_as_float(rr[1]); U[g] = ta * tb; Tp[g] = hi ? 1.f : tb; }
            float W = carry;
#pragma unroll
            for (int g = 7; g >= 0; --g) { const float F = W * Tp[g];
                if (g >= 4) { const int q = g - 4;
#pragma unroll
                    for (int e = 0; e < 4; ++e) p1[4 * q + e] *= r1[4 * q + e] * F; }
                else {
#pragma unroll
                    for (int e = 0; e < 4; ++e) p0[4 * g + e] *= r0[4 * g + e] * F; }
                W *= U[g]; }
            carry = W;
            bf16x8 pa0, pa1, pa2, pa3; pack_p(p0, p1, pa0, pa1, pa2, pa3); SBAR();
            pv_d0(o, vb0 + cur * 16384, pa0, pa1, pa2, pa3);
            wdone = __all(carry == 0.f);
        }
        if (wdone && lane == 0) done[(it & 1) * 8 + wid] = seq;
        if (it + 1 < NT) { asm volatile("s_waitcnt vmcnt(0)" ::: "memory"); SB_SWRITE(cur ^ 1); }
        __syncthreads();
        { const unsigned dv = (lane < 8) ? done[(it & 1) * 8 + lane] : seq; if (__all(dv == seq)) break; }
    }
#undef SB_SLOAD
#undef SB_SWRITE
    __builtin_amdgcn_s_setprio(0);
    store_o_tile(lds + wid * 8704, o, nullptr, O + (tok0 + q0 + wid * 32) * 1024 + hd * 128, lane, r32, hi);
    __syncthreads();
}
__device__ __forceinline__ void unit_of(int u, int& b, int& hd, int& qb) { const int bh = (u & 255) >> 2, s = u & 3, k = u >> 8; b = bh >> 3; hd = bh & 7; qb = (k == 0) ? s : (k == 1) ? 7 - s : (k == 2) ? 8 + s : 15 - s; }
}

#define LAS __attribute__((address_space(3)))
#define GAS __attribute__((address_space(1)))
constexpr int NWAVES = 8;
constexpr int RING_BYTES = 131072, LDSCTL_OFF = RING_BYTES, LDS_BYTES = 147456; static_assert(pg8::TOUCH_SINK >= LDSCTL_OFF + 1024 && pg8::TOUCH_SINK + 256 <= LDS_BYTES, "touch sink");
constexpr int LC_PTR = 0, LC_BAR = 96, LC_SBDONE = 128;

#define XB_TMO      128
#define XB_XCNT(j)  (256  + 64 * (j))
#define XB_XSUB(j)  (1280 + 64 * (j))
#define XB_XGEN(j)  (2304 + 64 * (j))
#define XB_TOP      3328
#define XB_TOPGEN   3392
#define XCD_BAR_WORDS 3456
#define XB_SPIN_CAP (1u << 18)

__device__ __forceinline__ unsigned xb_ld(unsigned* p)              { return __hip_atomic_load(p, __ATOMIC_RELAXED, __HIP_MEMORY_SCOPE_AGENT); }
__device__ __forceinline__ unsigned xb_add(unsigned* p, unsigned v) { return __hip_atomic_fetch_add(p, v, __ATOMIC_RELAXED, __HIP_MEMORY_SCOPE_AGENT); }
__device__ __forceinline__ unsigned xb_xcc_id() { return (unsigned)__builtin_amdgcn_s_getreg((3 << 11) | 20) & 0xFu; }
#define XB_SPIN(cond, bar) do { unsigned _sp = 0; while (cond) { __builtin_amdgcn_s_sleep(1); \
    if ((++_sp & 255u) == 0u) { if (xb_ld(&(bar)[XB_TMO])) break; if (_sp > XB_SPIN_CAP) { atomicAdd(&(bar)[XB_TMO], 1u); break; } } } } while (0)

struct XcdBarrier {
    unsigned* bar; unsigned x;
    volatile LAS unsigned* st;
};

__device__ __forceinline__ XcdBarrier xcd_barrier_post(unsigned* bar, volatile LAS unsigned* st) {
    XcdBarrier b; b.bar = bar; b.x = xb_xcc_id(); b.st = st;
    if (threadIdx.x == 0) (void)xb_add(&bar[XB_XCNT(b.x)], 1u);
    return b;
}
__device__ __forceinline__ void xcd_barrier_complete(unsigned* bar, unsigned x, unsigned& nloc, unsigned& nx) {
    const unsigned G = gridDim.x * gridDim.y * gridDim.z;
    unsigned sum, cnt, mine, sp = 0u;
    for (;;) {
        sum = 0u; cnt = 0u; mine = 0u;
        unsigned cv[16];
        { const unsigned* mid = &bar[XB_XCNT(8)];
          asm volatile("global_load_dword %0, %16, off offset:-2048 sc1\n\tglobal_load_dword %1, %16, off offset:-1792 sc1\n\tglobal_load_dword %2, %16, off offset:-1536 sc1\n\tglobal_load_dword %3, %16, off offset:-1280 sc1\n\t"
                       "global_load_dword %4, %16, off offset:-1024 sc1\n\tglobal_load_dword %5, %16, off offset:-768 sc1\n\tglobal_load_dword %6, %16, off offset:-512 sc1\n\tglobal_load_dword %7, %16, off offset:-256 sc1\n\t"
                       "global_load_dword %8, %16, off sc1\n\tglobal_load_dword %9, %16, off offset:256 sc1\n\tglobal_load_dword %10, %16, off offset:512 sc1\n\tglobal_load_dword %11, %16, off offset:768 sc1\n\t"
                       "global_load_dword %12, %16, off offset:1024 sc1\n\tglobal_load_dword %13, %16, off offset:1280 sc1\n\tglobal_load_dword %14, %16, off offset:1536 sc1\n\tglobal_load_dword %15, %16, off offset:1792 sc1\n\ts_waitcnt vmcnt(0)"
                       : "=&v"(cv[0]), "=&v"(cv[1]), "=&v"(cv[2]), "=&v"(cv[3]), "=&v"(cv[4]), "=&v"(cv[5]), "=&v"(cv[6]), "=&v"(cv[7]), "=&v"(cv[8]), "=&v"(cv[9]), "=&v"(cv[10]), "=&v"(cv[11]), "=&v"(cv[12]), "=&v"(cv[13]), "=&v"(cv[14]), "=&v"(cv[15])
                       : "v"(mid) : "memory"); }
        static_assert(XB_XCNT(1) - XB_XCNT(0) == 64, "census words are 256 bytes apart");
#pragma unroll
        for (unsigned j = 0; j < 16; ++j) { const unsigned c = cv[j]; sum += c; cnt += (c > 0u) ? 1u : 0u; mine = (j == x) ? c : mine; }
        if (sum == G) break;
        __builtin_amdgcn_s_sleep(1);
        if ((++sp & 255u) == 0u) { if (xb_ld(&bar[XB_TMO])) break; if (sp > XB_SPIN_CAP) { atomicAdd(&bar[XB_TMO], 1u); break; } }
    }
    nloc = mine > 0u ? mine : 1u; nx = cnt > 0u ? cnt : 1u;
}

__device__ __forceinline__ void xcd_barrier(const XcdBarrier& b) {
    asm volatile("s_waitcnt vmcnt(0)" ::: "memory");
    __syncthreads();
    if (threadIdx.x == 0) {
        unsigned* bar = b.bar;
        __builtin_amdgcn_s_waitcnt(0);
        unsigned nloc = b.st[0], nx = b.st[1];
        if (nloc == 0u) { xcd_barrier_complete(bar, b.x, nloc, nx); b.st[0] = nloc; b.st[1] = nx; }
        const unsigned old = xb_add(&bar[XB_XSUB(b.x)], 1u);
        const unsigned gen = old / nloc;
        if (old + 1u == (gen + 1u) * nloc) {
            __builtin_amdgcn_fence(__ATOMIC_RELEASE, "agent");
            asm volatile("s_waitcnt vmcnt(0)" ::: "memory");
            const unsigned og = xb_add(&bar[XB_TOP], 1u);
            const unsigned tg = og / nx;
            if (og + 1u == (tg + 1u) * nx) xb_add(&bar[XB_TOPGEN], 1u);
            else XB_SPIN(xb_ld(&bar[XB_TOPGEN]) == tg, bar);
            __builtin_amdgcn_fence(__ATOMIC_ACQUIRE, "agent");
            xb_add(&bar[XB_XGEN(b.x)], 1u);
            asm volatile("s_waitcnt vmcnt(0)" ::: "memory");
        } else {
            XB_SPIN(xb_ld(&bar[XB_XGEN(b.x)]) == gen, bar);
            __builtin_amdgcn_fence(__ATOMIC_ACQUIRE, "agent");
            asm volatile("s_waitcnt vmcnt(0)" ::: "memory");
        }
    }
    __syncthreads();
}


constexpr int PH_PRO = 0;
__host__ __device__ constexpr int PH(int l, int k) { return 1 + l * 10 + k; }
constexpr int PH_END = PH(3, 8) + 1;

struct MatDesc { int in_idx, gain_idx, K, N, mode, rowoff; long long src_off; long long dst_off; };
constexpr long long WSM = (long long)WS_WSMALL, WMO = (long long)WS_WMOE;
constexpr long long OFF_WD0 = WSM, OFF_WUQ0 = OFF_WD0 + 768LL * 1024 * 2, OFF_WUKV0 = OFF_WUQ0 + 1536LL * 384 * 2, OFF_WO0 = OFF_WUKV0 + 2048LL * 256 * 2;
constexpr long long OFF_WD1 = OFF_WO0 + 1024LL * 1024 * 2, OFF_WUQ1 = OFF_WD1 + 768LL * 1024 * 2, OFF_WUKV1 = OFF_WUQ1 + 1536LL * 384 * 2, OFF_WO1 = OFF_WUKV1 + 2048LL * 256 * 2;
constexpr long long OFF_WGU0 = OFF_WO1 + 1024LL * 1024 * 2, OFF_WDN0 = OFF_WGU0 + 5632LL * 1024 * 2;
constexpr long long OFF_WGU2 = OFF_WDN0 + 1024LL * 2816 * 2, OFF_WDN2 = OFF_WGU2 + 5632LL * 1024 * 2;
constexpr long long OFF_WKVQ = OFF_WDN2 + 1024LL * 2816 * 2, OFF_WQ3 = OFF_WKVQ + 3072LL * 1024 * 2, OFF_WO2 = OFF_WQ3 + 1024LL * 1024 * 2, OFF_WO3 = OFF_WO2 + 1024LL * 1024 * 2;
constexpr long long OFF_WSM_END = OFF_WO3 + 1024LL * 1024 * 2;
static_assert(OFF_WSM_END <= (long long)WS_WMOE, "small weights fit");
constexpr long long MOE_GU_BYTES = 5632LL * 1024, MOE_DN_BYTES = 1024LL * 2816;
constexpr long long OFF_MGU = WMO, OFF_MDN = WMO + 8 * MOE_GU_BYTES;
constexpr int NMAT_SMALL = 18;
__device__ const MatDesc g_mats[NMAT_SMALL] = {
    {3, 2, 1024, 704, 1, 0, 0, OFF_WD0}, {5, 4, 384, 1536, 2, 0, 0, OFF_WUQ0}, {7, 6, 256, 2048, 4, 0, 0, OFF_WUKV0}, {8, -1, 1024, 1024, 0, 0, 0, OFF_WO0},
    {13, 12, 1024, 704, 1, 0, 0, OFF_WD1}, {15, 14, 384, 1536, 2, 0, 0, OFF_WUQ1}, {17, 16, 256, 2048, 4, 0, 0, OFF_WUKV1}, {18, -1, 1024, 1024, 0, 0, 0, OFF_WO1},
    {10, 9, 1024, 5632, 3, 0, 0, OFF_WGU0}, {11, -1, 2816, 1024, 0, 0, 0, OFF_WDN0},
    {29, 28, 1024, 5632, 3, 0, 0, OFF_WGU2}, {30, -1, 2816, 1024, 0, 0, 0, OFF_WDN2},
    {24, 23, 1024, 2048, 0, 0, 0, OFF_WKVQ}, {26, 25, 1024, 1024, 0, 2048, 0, OFF_WKVQ}, {32, 31, 1024, 1024, 0, 0, 0, OFF_WQ3},
    {27, -1, 1024, 1024, 0, 0, 0, OFF_WO2}, {33, -1, 1024, 1024, 0, 0, 0, OFF_WO3},
    {3, 2, 0, 0, 9, 0, 0, OFF_WD0}
};
__device__ __forceinline__ int map_row(int mode, int n) {
    if (mode == 1) { return n < 640 ? n : (n < 672 ? 640 + 2 * (n - 640) : 641 + 2 * (n - 672)); }
    if (mode == 2) { const int hd = n / 192, d = n - hd * 192; return d < 128 ? n : (d < 160 ? hd * 192 + 128 + 2 * (d - 128) : hd * 192 + 129 + 2 * (d - 160)); }
    if (mode == 4) { const int hd = n >> 8, d = n & 255; return d < 128 ? hd * 128 + d : 1024 + hd * 128 + (d - 128); }
    if (mode == 3) { if (n < 2816) return 256 * (n >> 7) + (n & 127); const int n2 = n - 2816; return 256 * (n2 >> 7) + 128 + (n2 & 127); }
    return n;
}
typedef unsigned v4u __attribute__((ext_vector_type(4)));
struct ConvJob { const float* W; const float* gain; bf16* WT; int K, N, mode, rowoff, k0, n0; int f8; float wscale; int tiled; int pad; };
constexpr int CONV_PITCH = 129, SMALL_ITEMS = 2 * (48 + 36 + 32 + 64) + 2 * (352 + 176) + 128 + 64 + 64 + 64 + 64, MOE_ITEMS_E = 352 + 176, MOE_ITEMS = NE * MOE_ITEMS_E;
__device__ __forceinline__ void conv_load(const ConvJob& J, int t, f32x4 (&v)[8], float (&gk)[8]) {
    const int lane = t & 63, wave = t >> 6, n = J.n0 + 4 * ((lane & 7) + 8 * (wave & 3)), r0 = (wave >> 2) * 8 + (lane >> 3);
#pragma unroll
    for (int i = 0; i < 8; ++i) { const int k = J.k0 + r0 + 16 * i;
        v[i] = (n < J.N) ? __builtin_nontemporal_load((const f32x4*)(J.W + (size_t)k * J.N + n)) : (f32x4){0.f, 0.f, 0.f, 0.f};
        gk[i] = (J.gain ? J.gain[k] : 1.0f) * J.wscale; }
}
__device__ __forceinline__ void conv_to_lds(LAS float* scr, int t, const f32x4 (&v)[8], const float (&gk)[8]) {
    const int lane = t & 63, wave = t >> 6, c = 4 * ((lane & 7) + 8 * (wave & 3)), r0 = (wave >> 2) * 8 + (lane >> 3);
#pragma unroll
    for (int i = 0; i < 8; ++i) { LAS float* p = scr + (r0 + 16 * i) * CONV_PITCH + c; const f32x4 x = v[i] * gk[i]; p[0] = x[0]; p[1] = x[1]; p[2] = x[2]; p[3] = x[3]; }
}
__device__ __forceinline__ void conv_store(const ConvJob& J, const LAS float* scr, int t) {
    if (J.f8) {
        const int c = t >> 6, n_l = t & 63;
#pragma unroll
        for (int jj = 0; jj < 2; ++jj) { const int n = n_l + 64 * jj;
            if (J.n0 + n < J.N) { const LAS float* sp = scr + (16 * c) * CONV_PITCH + n;
                v4u o;
                o.x = pg8::pk4_fp8_nc(sp[0 * CONV_PITCH], sp[1 * CONV_PITCH], sp[2 * CONV_PITCH], sp[3 * CONV_PITCH]); o.y = pg8::pk4_fp8_nc(sp[4 * CONV_PITCH], sp[5 * CONV_PITCH], sp[6 * CONV_PITCH], sp[7 * CONV_PITCH]);
                o.z = pg8::pk4_fp8_nc(sp[8 * CONV_PITCH], sp[9 * CONV_PITCH], sp[10 * CONV_PITCH], sp[11 * CONV_PITCH]); o.w = pg8::pk4_fp8_nc(sp[12 * CONV_PITCH], sp[13 * CONV_PITCH], sp[14 * CONV_PITCH], sp[15 * CONV_PITCH]);
                const int row = J.rowoff + map_row(J.mode, J.n0 + n), k = J.k0 + 16 * c;
                if (J.tiled) *(v4u*)((unsigned char*)J.WT + (((size_t)(row >> 8) * (J.K >> 7) + (k >> 7)) * 256 + (row & 255)) * 128 + (k & 127)) = o;
                else *(v4u*)((unsigned char*)J.WT + (size_t)row * J.K + k) = o; } }
        return;
    }
    const int c_lo = t & 7, n_l = t >> 3;
#pragma unroll
    for (int jj = 0; jj < 4; ++jj) { const int n = n_l + 64 * (jj >> 1), c = c_lo + 8 * (jj & 1);
        if (J.n0 + n < J.N) { const LAS float* sp = scr + (8 * c) * CONV_PITCH + n;
            v4u o; o.x = pk2(sp[0 * CONV_PITCH], sp[1 * CONV_PITCH]); o.y = pk2(sp[2 * CONV_PITCH], sp[3 * CONV_PITCH]); o.z = pk2(sp[4 * CONV_PITCH], sp[5 * CONV_PITCH]); o.w = pk2(sp[6 * CONV_PITCH], sp[7 * CONV_PITCH]);
            const int row = J.rowoff + map_row(J.mode, J.n0 + n), k = J.k0 + 8 * c;
            if (J.tiled) *(v4u*)(J.WT + (((size_t)(row >> 8) * (J.K >> 6) + (k >> 6)) * 256 + (row & 255)) * 64 + (k & 63)) = o;
            else *(v4u*)(J.WT + (size_t)row * J.K + k) = o; } }
}

#ifndef SITES
#define SITES 0xffff
#endif
#define SITE(n) (((SITES) >> (n)) & 1)
#ifndef REPEAT
#define REPEAT -1
#endif
#define DUMMY(k) ((REPEAT == (k)) && rep_ == 0)
#define REP(k) for (int rep_ = 0; rep_ < ((REPEAT == (k)) ? 2 : 1); ++rep_)

#define RLX_AGENT __ATOMIC_RELAXED, __HIP_MEMORY_SCOPE_AGENT
__device__ __forceinline__ void prep_row(const float* __restrict__ x, const int* __restrict__ pos, bf16* __restrict__ hb, float* __restrict__ ss, float2* __restrict__ cs, int m, int lane) {
    const f32x4* xr = (const f32x4*)(x + (size_t)m * D) + lane;
    float s = 0.f;
#pragma unroll
    for (int j = 0; j < 4; ++j) { const f32x4 v = __builtin_nontemporal_load(xr + 64 * j); s += (v.x * v.x + v.y * v.y) + (v.z * v.z + v.w * v.w);
        u32x2 o; o.x = pk2(v.x, v.y); o.y = pk2(v.z, v.w); *((u32x2*)(hb + (size_t)m * D) + lane + 64 * j) = o; }
    s = wave_sum(s);
    if (lane < 16) ss[(size_t)m * 16 + lane] = (lane == 0) ? s : 0.f;
    if (lane < 32) {
        const float inv_freq = 1.0f / powf(10000.0f, (float)(2 * lane) / 64.0f);
        const float ang = (float)pos[m] * inv_freq;
        double t = (double)ang * 0.15915494309189535; t -= floor(t);
        const float a = (float)(t * 6.283185307179586);
        cs[(size_t)m * 32 + lane] = make_float2(cosf(a), sinf(a));
    }
}
__device__ __forceinline__ void router_load(LAS float* T, const float* __restrict__ gain, const float* __restrict__ R, int tid) {
    for (int i = tid; i < 1024; i += NWAVES * 64) { const int jq = i >> 6, ln = i & 63, k = 4 * ln + 256 * (jq >> 2) + (jq & 3); const float g = gain[k];
        const f32x4 r0 = *(const f32x4*)(R + (size_t)k * NE), r1 = *(const f32x4*)(R + (size_t)k * NE + 4);
        *(LAS f32x4*)(T + (size_t)i * 8) = r0 * g; *(LAS f32x4*)(T + (size_t)i * 8 + 4) = r1 * g; }
}
__device__ __forceinline__ void route_dot4(const LAS float* T, const u32x2 (&hw)[4][4], int lane, float (&acc)[4][NE]) {
#pragma unroll
    for (int r = 0; r < 4; ++r)
#pragma unroll
        for (int e = 0; e < NE; ++e) acc[r][e] = 0.f;
#pragma unroll
    for (int j = 0; j < 4; ++j)
#pragma unroll
        for (int q = 0; q < 4; ++q) { const LAS float* tp = T + (size_t)((4 * j + q) * 64 + lane) * 8; const f32x4 w0 = *(const LAS f32x4*)tp, w1 = *(const LAS f32x4*)(tp + 4);
#pragma unroll
            for (int r = 0; r < 4; ++r) { const unsigned wd = (q < 2) ? hw[r][j].x : hw[r][j].y; const float h = (q & 1) ? bf2f(wd >> 16) : bf2f(wd);
                acc[r][0] += h * w0[0]; acc[r][1] += h * w0[1]; acc[r][2] += h * w0[2]; acc[r][3] += h * w0[3]; acc[r][4] += h * w1[0]; acc[r][5] += h * w1[1]; acc[r][6] += h * w1[2]; acc[r][7] += h * w1[3]; } }
}
__device__ __forceinline__ void route_row(const float (&acc)[NE], float rstd, int lane, int& i1, int& i2, float& g1, float& g2) {
    const bool b0 = lane & 1, b1 = lane & 2, b2 = lane & 4;
    float w4[4], x2[2], y;
#pragma unroll
    for (int i = 0; i < 4; ++i) { const float snd = b0 ? acc[i] : acc[4 + i], kp = b0 ? acc[4 + i] : acc[i]; w4[i] = kp + __shfl_xor(snd, 1); }
#pragma unroll
    for (int i = 0; i < 2; ++i) { const float snd = b1 ? w4[i] : w4[2 + i], kp = b1 ? w4[2 + i] : w4[i]; x2[i] = kp + __shfl_xor(snd, 2); }
    { const float snd = b2 ? x2[0] : x2[1], kp = b2 ? x2[1] : x2[0]; y = kp + __shfl_xor(snd, 4); }
    y += __shfl_xor(y, 8); y += __shfl_xor(y, 16); y += __shfl_xor(y, 32);
    y *= rstd;
    float lg[NE];
#pragma unroll
    for (int e = 0; e < NE; ++e) lg[e] = __uint_as_float(__builtin_amdgcn_readlane(__float_as_uint(y), (e >> 2) + 2 * ((e >> 1) & 1) + 4 * (e & 1)));
    i1 = 0; float v1 = lg[0];
#pragma unroll
    for (int e = 1; e < NE; ++e) if (lg[e] > v1) { v1 = lg[e]; i1 = e; }
    i2 = -1; float v2 = -3.0e38f;
#pragma unroll
    for (int e = 0; e < NE; ++e) if (e != i1 && lg[e] > v2) { v2 = lg[e]; i2 = e; }
    const float e2 = __expf(v2 - v1); g1 = 1.0f / (1.0f + e2); g2 = e2 / (1.0f + e2);
}
template <bool FINAL>
__device__ __forceinline__ bool combine_rows2(const bf16* hbin, bf16* hbout, float* __restrict__ outf, const bf16* __restrict__ y, const int2* __restrict__ tokslot, float* __restrict__ ss, const float* __restrict__ gfin, int m0, int m1, int lane, int thr, int pass) {
    const int2 ta = tokslot[m0], tb = tokslot[m1];
    { const int mx_ = max(max(ta.x, ta.y), max(tb.x, tb.y)); const bool touch = __builtin_amdgcn_readfirstlane(mx_) >= thr;
      if (touch != (pass != 0)) return false; }
    u32x2 ha[4], hc[4], ya1[4], ya2[4], yb1[4], yb2[4];
#pragma unroll
    for (int j = 0; j < 4; ++j) { ha[j] = *((const u32x2*)(hbin + (size_t)m0 * D) + lane + 64 * j); hc[j] = *((const u32x2*)(hbin + (size_t)m1 * D) + lane + 64 * j); }
#pragma unroll
    for (int j = 0; j < 4; ++j) { ya1[j] = *((const u32x2*)(y + (size_t)ta.x * D) + lane + 64 * j); ya2[j] = *((const u32x2*)(y + (size_t)ta.y * D) + lane + 64 * j);
                                  yb1[j] = *((const u32x2*)(y + (size_t)tb.x * D) + lane + 64 * j); yb2[j] = *((const u32x2*)(y + (size_t)tb.y * D) + lane + 64 * j); }
#pragma unroll
    for (int t = 0; t < 2; ++t) {
        const int m = t ? m1 : m0; f32x4 v[4]; float s = 0.f;
#pragma unroll
        for (int j = 0; j < 4; ++j) { const u32x2 hw = t ? hc[j] : ha[j], a = t ? yb1[j] : ya1[j], c = t ? yb2[j] : ya2[j];
            v[j].x = bf2f(hw.x) + (bf2f(a.x) + bf2f(c.x)); v[j].y = bf2f(hw.x >> 16) + (bf2f(a.x >> 16) + bf2f(c.x >> 16)); v[j].z = bf2f(hw.y) + (bf2f(a.y) + bf2f(c.y)); v[j].w = bf2f(hw.y >> 16) + (bf2f(a.y >> 16) + bf2f(c.y >> 16));
            s += (v[j].x * v[j].x + v[j].y * v[j].y) + (v[j].z * v[j].z + v[j].w * v[j].w); }
        s = wave_sum(s);
        if (!FINAL) {
#pragma unroll
            for (int j = 0; j < 4; ++j) { u32x2 o; o.x = pk2(v[j].x, v[j].y); o.y = pk2(v[j].z, v[j].w); *((u32x2*)(hbout + (size_t)m * D) + lane + 64 * j) = o; }
            if (lane < 16) ss[(size_t)m * 16 + lane] = (lane == 0) ? s : 0.f;
        } else {
            const float rstd = rsqrtf(s * (1.0f / D) + EPS);
#pragma unroll
            for (int j = 0; j < 4; ++j) { const f32x4 g = *((const f32x4*)gfin + lane + 64 * j); *((f32x4*)(outf + (size_t)m * D) + lane + 64 * j) = v[j] * rstd * g; }
        }
    }
    return true;
}

__device__ __forceinline__ const float* inp_ptr(volatile LAS unsigned* LC, int i) { return (const float*)(((unsigned long long)(unsigned)__builtin_amdgcn_readfirstlane(LC[LC_PTR + 2 * i + 1]) << 32) | (unsigned long long)(unsigned)__builtin_amdgcn_readfirstlane(LC[LC_PTR + 2 * i])); }
__device__ __forceinline__ ConvJob conv_job(volatile LAS unsigned* LC, unsigned char* wsl, int id, int nsmall, int moe_wg, int moe_wd, int moe_gain) {
    ConvJob J;
    if (id < nsmall) {
        int mi = 0, rem = id;
        for (; mi < NMAT_SMALL - 1; ++mi) { const int it = (g_mats[mi].K >> 7) * ((g_mats[mi].N + 127) >> 7); if (rem < it) break; rem -= it; }
        const MatDesc d = g_mats[mi]; const int nn = (d.N + 127) >> 7;
        J.W = inp_ptr(LC, d.in_idx); J.gain = d.gain_idx >= 0 ? inp_ptr(LC, d.gain_idx) : nullptr; J.WT = (bf16*)(wsl + d.dst_off); J.K = d.K; J.N = d.N; J.mode = d.mode; J.rowoff = d.rowoff; J.k0 = (rem / nn) * 128; J.n0 = (rem % nn) * 128; J.tiled = (d.K == 2816) ? 1 : 0; J.f8 = (DENSE_DN_FP8 && d.K == 2816) ? 1 : 0; J.wscale = J.f8 ? 64.0f : 1.0f; J.pad = 0;
    } else {
        const int r = id - nsmall, e = r / MOE_ITEMS_E, q = r - e * MOE_ITEMS_E;
        if (q < 352) { J.W = inp_ptr(LC, moe_wg) + (size_t)e * 1024 * 5632; J.gain = inp_ptr(LC, moe_gain); J.WT = (bf16*)(wsl + OFF_MGU + e * MOE_GU_BYTES); J.K = 1024; J.N = 5632; J.mode = 3; J.rowoff = 0; J.k0 = (q / 44) * 128; J.n0 = (q % 44) * 128; }
        else { const int q2 = q - 352; J.W = inp_ptr(LC, moe_wd) + (size_t)e * 2816 * 1024; J.gain = nullptr; J.WT = (bf16*)(wsl + OFF_MDN + e * MOE_DN_BYTES); J.K = 2816; J.N = 1024; J.mode = 0; J.rowoff = 0; J.k0 = (q2 / 8) * 128; J.n0 = (q2 % 8) * 128; }
        J.f8 = 1; J.wscale = 64.0f; J.tiled = (q >= 352) ? 1 : 0; J.pad = 0;
    }
    return J;
}
__device__ __forceinline__ void conv_run(volatile LAS unsigned* LC, LAS unsigned char* lds, unsigned char* wsl, int cb, int Gs, int t, int nsmall, int total, int moe_wg, int moe_wd, int moe_gain) {
    LAS float* scr = (LAS float*)lds;
    int id = cb; bool have = id < total; ConvJob J{}; f32x4 v[8]; float gk[8];
#pragma unroll
    for (int i = 0; i < 8; ++i) { v[i] = (f32x4){0.f, 0.f, 0.f, 0.f}; gk[i] = 0.f; }
    if (have) { J = conv_job(LC, wsl, id, nsmall, moe_wg, moe_wd, moe_gain); conv_load(J, t, v, gk); }
    while (have) {
        conv_to_lds(scr, t, v, gk);
        __syncthreads();
        const int idn = id + Gs; const bool hn = idn < total; ConvJob Jn{};
        if (hn) { Jn = conv_job(LC, wsl, idn, nsmall, moe_wg, moe_wd, moe_gain); conv_load(Jn, t, v, gk); }
        conv_store(J, scr, t);
        __syncthreads();
        J = Jn; id = idn; have = hn;
    }
}

struct Args { const void* in[39]; float* out; unsigned char* ws; int ph_lo, ph_hi; };

#define INP(i) ((const float*)(((unsigned long long)(unsigned)__builtin_amdgcn_readfirstlane(LC[LC_PTR + 2 * (i) + 1]) << 32) | (unsigned long long)(unsigned)__builtin_amdgcn_readfirstlane(LC[LC_PTR + 2 * (i)])))
#define IN(k) (lo <= (k) && (k) < hi)
#define SEAM(k) do { if ((k) + 1 < hi) xcd_barrier(bar); } while (0)
#define SITE_BEGIN() int zz_; asm volatile("s_mov_b32 %0, 0" : "=s"(zz_)); unsigned char* wsl = args.ws + zz_; float* outl = args.out + zz_; const int cb = (int)blockIdx.x + zz_, Gs = (int)gridDim.x + zz_; \
    unsigned char* R0 = wsl + WS_R0; (void)R0; (void)outl
#define SSA(i) ((float*)(wsl + WS_SS) + (size_t)(i) * M * 16)
#define CSP ((const float2*)(wsl + WS_CS))
#define HBP ((bf16*)(wsl + WS_HB))

template <int l>
__device__ __forceinline__ void layer_phases(const Args& args, LAS unsigned char* lds, volatile LAS unsigned* LC, const XcdBarrier& bar, const int lo, const int hi) {
        if (l < 2) {
            if (SITE(1) && IN(PH(l, 0))) REP(1) {
                SITE_BEGIN();
                pg8::Gemm g{HBP, (const bf16*)(wsl + (l ? OFF_WD1 : OFF_WD0)), M, 768, 1024}; pg8::StaticOrder S; S.init(M, 768, Gs, cb);
                pg8::EpiDown E{SSA(0), CSP, (bf16*)(R0 + R_CQ), (bf16*)(R0 + R_CKV), (bf16*)(R0 + R_KR), SSA(2), SSA(3), MLA_FP8 ? R0 + R_K8T : nullptr};
                pg8::gemm_phase<pg8::EpiDown, pg8::StaticOrder, true, true>(lds, g, S, E);
                SEAM(PH(l, 0));
            }
            if (SITE(2) && IN(PH(l, 1))) REP(1) {
                if (MLA_FP8) {
                    { SITE_BEGIN();
                      pg8::Gemm g{(const bf16*)(R0 + R_CQ), (const bf16*)(wsl + (l ? OFF_WUQ1 : OFF_WUQ0)), M, 1536, 384}; pg8::StaticOrder S; S.init(M, 1536, Gs, cb);
                      pg8::EpiUq8 E{SSA(2), CSP, R0 + R_Q8, C2_MLA * 16.0f, 0};
                      pg8::gemm_phase<pg8::EpiUq8, pg8::StaticOrder, true, true>(lds, g, S, E); }
                    { SITE_BEGIN();
                      pg8::Gemm g{(const bf16*)(R0 + R_CKV), (const bf16*)(wsl + (l ? OFF_WUKV1 : OFF_WUKV0)), M, 1024, 256}; pg8::StaticOrder S; S.init(M, 1024, Gs, cb);
                      pg8::EpiKn8 E{SSA(3), R0 + R_K8T};
                      pg8::gemm_phase<pg8::EpiKn8, pg8::StaticOrder, true, true>(lds, g, S, E); }
                    { SITE_BEGIN();
                      pg8::Gemm g{(const bf16*)(wsl + (l ? OFF_WUKV1 : OFF_WUKV0)) + (size_t)1024 * 256, (const bf16*)(R0 + R_CKV), 1024, M, 256}; pg8::StaticOrder S; S.init(1024, M, Gs, cb);
                      pg8::EpiVt8 E{SSA(3), R0 + R_VT8T};
                      pg8::gemm_phase<pg8::EpiVt8, pg8::StaticOrder, true, true>(lds, g, S, E); }
                } else {
                { SITE_BEGIN();
                  pg8::Gemm g{(const bf16*)(R0 + R_CQ), (const bf16*)(wsl + (l ? OFF_WUQ1 : OFF_WUQ0)), M, 1536, 384}; pg8::StaticOrder S; S.init(M, 1536, Gs, cb);
                  pg8::EpiUq E{SSA(2), CSP, (bf16*)(R0 + R_Q), C2_MLA, 0};
                  pg8::gemm_phase<pg8::EpiUq, pg8::StaticOrder, true, true>(lds, g, S, E); }
                { SITE_BEGIN();
                  pg8::Gemm g{(const bf16*)(R0 + R_CKV), (const bf16*)(wsl + (l ? OFF_WUKV1 : OFF_WUKV0)), M, 2048, 256}; pg8::StaticOrder S; S.init(M, 2048, Gs, cb);
                  pg8::EpiProj E{SSA(3), (bf16*)(R0 + R_KN), (size_t)(R_V - R_KN) / 2, 1.0f, -1, 2, 1.0f / 256.0f, 0};
                  pg8::gemm_phase<pg8::EpiProj, pg8::StaticOrder, true, true>(lds, g, S, E); }
                }
                SEAM(PH(l, 1));
            }
            if (SITE(9) && IN(PH(l, 2))) REP(2) {
                SITE_BEGIN();
                const int vcu = (Gs % 8 == 0) ? (cb % 8) * (Gs / 8) + cb / 8 : cb;
                for (int u = vcu; u < 1024; u += Gs) { int b, hd, qb; att::unit_of(u, b, hd, qb);
                    if (MLA_FP8) att::mla8_unit((ATT_LAS char*)lds, R0 + R_Q8, R0 + R_K8T, R0 + R_VT8T, (bf16*)(R0 + R_O), b, hd, qb);
                    else att::mla_unit((ATT_LAS char*)lds, (const bf16*)(R0 + R_Q), (const bf16*)(R0 + R_KN), (const bf16*)(R0 + R_KR), (const bf16*)(R0 + R_V), (bf16*)(R0 + R_O), b, hd, qb); }
                SEAM(PH(l, 2));
            }
        } else {
            static_assert(R_VS - R_KS == R_QS - R_VS, "Ks|Vs|Qs equally spaced");
            if (SITE(3) && IN(PH(l, 0))) REP(7) {
                SITE_BEGIN();
                const int N = (l == 2) ? 3072 : 1024;
                pg8::Gemm g{HBP, (const bf16*)(wsl + (l == 2 ? OFF_WKVQ : OFF_WQ3)), M, N, 1024}; pg8::StaticOrder S; S.init(M, N, Gs, cb);
                pg8::EpiProj E{SSA(0), (bf16*)(R0 + ((l == 2) ? R_KS : R_QS)), (size_t)(R_VS - R_KS) / 2, C2_SB, (l == 2) ? 2 : 0, 4, 1.0f / 1024.0f, 0};
                pg8::gemm_phase<pg8::EpiProj, pg8::StaticOrder, true, true>(lds, g, S, E);
                SEAM(PH(l, 0));
            }
            if (SITE(10) && IN(PH(l, 2))) REP(3) {
                SITE_BEGIN();
                const int vcu = (Gs % 8 == 0) ? (cb % 8) * (Gs / 8) + cb / 8 : cb;
                for (int u = vcu; u < 1024; u += Gs) { int b, hd, qb; att::unit_of(u, b, hd, qb);
                    att::sb_unit((ATT_LAS char*)lds, (volatile ATT_LAS unsigned*)(LC + LC_SBDONE), (unsigned)(u + 1 + l * 4096), (const bf16*)(R0 + R_QS), (const bf16*)(R0 + R_KS), (const bf16*)(R0 + R_VS), (bf16*)(R0 + R_OS), b, hd, qb); }
                SEAM(PH(l, 2));
            }
        }
        if (SITE(4) && IN(PH(l, 3))) REP(11) {
            SITE_BEGIN();
            const long long wo = (l == 0) ? OFF_WO0 : (l == 1 ? OFF_WO1 : (l == 2 ? OFF_WO2 : OFF_WO3));
            pg8::Gemm g{(const bf16*)(R0 + (l < 2 ? R_O : R_OS)), (const bf16*)(wsl + wo), M, 1024, 1024}; pg8::StaticOrder S; S.init(M, 1024, Gs, cb);
            pg8::EpiRes E{HBP, DUMMY(11) ? (bf16*)(R0 + R_ACT) : HBP, DUMMY(11) ? SSA(2) : SSA(1), 1.0f, 0};
            pg8::gemm_phase<pg8::EpiRes, pg8::StaticOrder, true, true>(lds, g, S, E);
            SEAM(PH(l, 3));
        }
        const bool moe = (l & 1) != 0;
        if (SITE(11) && moe && IN(PH(l, 4))) REP(9) {
            SITE_BEGIN();
            int tid_ = threadIdx.x; asm volatile("" : "+v"(tid_));
            const int tid = tid_, lane = tid & 63, wave = __builtin_amdgcn_readfirstlane(tid >> 6);
            LAS int* lcnt = (LAS int*)lds; LAS int* gb = lcnt + 8; LAS int* le = lcnt + 16; LAS int* lp = le + 256; LAS float* lg = (LAS float*)(lp + 256);
            unsigned* cnt = (unsigned*)(wsl + WS_CTL) + CW_CNT + (l == 3 ? 64 : 0) + (DUMMY(9) ? 128 : 0);
            RInfo* rinfo = (RInfo*)(wsl + WS_RINFO);
            LAS float* RT = (LAS float*)(lds + 8192); router_load(RT, INP(l == 1 ? 19 : 34), INP(l == 1 ? 20 : 35), tid);
            for (int chunk = cb; chunk < M / 128; chunk += Gs) {
                if (tid < NE) lcnt[tid] = 0;
                __syncthreads();
                u32x2 hw[4][4], hn[4][4]; float ssc[4], ssn_[4];
#define RT_LOAD(dst, sdst, m_) do { const u32x2* hp_ = (const u32x2*)(HBP + (size_t)(m_) * D) + lane; dst[0] = hp_[0]; dst[1] = hp_[64]; dst[2] = hp_[128]; dst[3] = hp_[192]; sdst = sum16(SSA(1) + (size_t)(m_) * 16); } while (0)
#pragma unroll
                for (int r = 0; r < 4; ++r) RT_LOAD(hw[r], ssc[r], chunk * 128 + r * 8 + wave);
                for (int it = 0; it < 4; ++it) {
                    if (it < 3) {
#pragma unroll
                        for (int r = 0; r < 4; ++r) RT_LOAD(hn[r], ssn_[r], chunk * 128 + (4 * (it + 1) + r) * 8 + wave); }
                    float acc4[4][NE]; route_dot4(RT, hw, lane, acc4);
#pragma unroll
                    for (int r = 0; r < 4; ++r) { const int rl = (4 * it + r) * 8 + wave; int i1, i2; float g1, g2;
                        route_row(acc4[r], rsqrtf(ssc[r] * (1.0f / D) + EPS), lane, i1, i2, g1, g2);
                        if (lane == 0) { le[2 * rl] = i1; le[2 * rl + 1] = i2; lg[2 * rl] = g1; lg[2 * rl + 1] = g2; lp[2 * rl] = __hip_atomic_fetch_add(lcnt + i1, 1, __ATOMIC_RELAXED, __HIP_MEMORY_SCOPE_WORKGROUP); lp[2 * rl + 1] = __hip_atomic_fetch_add(lcnt + i2, 1, __ATOMIC_RELAXED, __HIP_MEMORY_SCOPE_WORKGROUP); } }
#pragma unroll
                    for (int r = 0; r < 4; ++r) {
#pragma unroll
                        for (int j = 0; j < 4; ++j) hw[r][j] = hn[r][j];
                        ssc[r] = ssn_[r]; }
                }
#undef RT_LOAD
                __syncthreads();
                if (tid < NE) gb[tid] = (int)__hip_atomic_fetch_add(cnt + tid, (unsigned)lcnt[tid], RLX_AGENT);
                __syncthreads();
                if (tid < 128) { RInfo ri; ri.e1 = le[2 * tid]; ri.e2 = le[2 * tid + 1]; ri.p1 = gb[ri.e1] + lp[2 * tid]; ri.p2 = gb[ri.e2] + lp[2 * tid + 1]; ri.g1 = lg[2 * tid]; ri.g2 = lg[2 * tid + 1]; ri.s1 = 0; ri.s2 = 0; rinfo[chunk * 128 + tid] = ri; }
                __syncthreads();
            }
            SEAM(PH(l, 4));
        }
        if (SITE(12) && moe && IN(PH(l, 5))) REP(8) {
            SITE_BEGIN();
            int tid_ = threadIdx.x; asm volatile("" : "+v"(tid_));
            const int tid = tid_, lane = tid & 63, wave = __builtin_amdgcn_readfirstlane(tid >> 6);
            unsigned* cnt = (unsigned*)(wsl + WS_CTL) + CW_CNT + (l == 3 ? 64 : 0);
            int* base_out = (int*)(wsl + WS_CTL) + CW_BASE + (l == 3 ? 64 : 0);
            RInfo* rinfo = (RInfo*)(wsl + WS_RINFO);
            unsigned char* xg8 = R0 + R_XG; float* ssg = (float*)(wsl + WS_SLOT); float* sgate = ssg + TMAX;
            int cn[NE], base[NE + 1]; base[0] = 0;
            const unsigned cv_ = __hip_atomic_load(cnt + (lane & 7), RLX_AGENT);
#pragma unroll
            for (int e = 0; e < NE; ++e) { cn[e] = (int)__builtin_amdgcn_readlane(cv_, e); base[e + 1] = base[e] + ((cn[e] + 255) & ~255); }
            if (cb == 0 && tid <= NE) { int v = 0;
#pragma unroll
                for (int e = 0; e <= NE; ++e) if (tid == e) v = base[e];
                base_out[tid] = v; }
            const int gw = cb * NWAVES + wave, NGW = Gs * NWAVES;
            int2* tokslot = (int2*)(wsl + WS_TOKSLOT);
            for (int m0 = gw; m0 < M; m0 += 2 * NGW) {
                const int m1 = (m0 + NGW < M) ? m0 + NGW : m0;
                const RInfo ra = rinfo[m0], rb = rinfo[m1];
                const u32x4* sa = (const u32x4*)(HBP + (size_t)m0 * D) + 2 * lane; const u32x4* sb = (const u32x4*)(HBP + (size_t)m1 * D) + 2 * lane;
                const u32x4 a0 = sa[0], a1 = sa[1], c0 = sb[0], c1 = sb[1];
                float sva = 0.f, svb = 0.f; if (lane == 0) { sva = sum16(SSA(1) + (size_t)m0 * 16); svb = sum16(SSA(1) + (size_t)m1 * 16); }
                int ba1 = 0, ba2 = 0, bb1 = 0, bb2 = 0;
#pragma unroll
                for (int e = 0; e < NE; ++e) { if (ra.e1 == e) ba1 = base[e]; if (ra.e2 == e) ba2 = base[e]; if (rb.e1 == e) bb1 = base[e]; if (rb.e2 == e) bb2 = base[e]; }
                const int sa1 = ba1 + ra.p1, sa2 = ba2 + ra.p2, sb1 = bb1 + rb.p1, sb2 = bb2 + rb.p2;
                v4u oa, ob;
                oa.x = pg8::pk4_fp8(bf2f(a0.x), bf2f(a0.x >> 16), bf2f(a0.y), bf2f(a0.y >> 16)); oa.y = pg8::pk4_fp8(bf2f(a0.z), bf2f(a0.z >> 16), bf2f(a0.w), bf2f(a0.w >> 16));
                oa.z = pg8::pk4_fp8(bf2f(a1.x), bf2f(a1.x >> 16), bf2f(a1.y), bf2f(a1.y >> 16)); oa.w = pg8::pk4_fp8(bf2f(a1.z), bf2f(a1.z >> 16), bf2f(a1.w), bf2f(a1.w >> 16));
                ob.x = pg8::pk4_fp8(bf2f(c0.x), bf2f(c0.x >> 16), bf2f(c0.y), bf2f(c0.y >> 16)); ob.y = pg8::pk4_fp8(bf2f(c0.z), bf2f(c0.z >> 16), bf2f(c0.w), bf2f(c0.w >> 16));
                ob.z = pg8::pk4_fp8(bf2f(c1.x), bf2f(c1.x >> 16), bf2f(c1.y), bf2f(c1.y >> 16)); ob.w = pg8::pk4_fp8(bf2f(c1.z), bf2f(c1.z >> 16), bf2f(c1.w), bf2f(c1.w >> 16));
                *((v4u*)(xg8 + (size_t)sa1 * D) + lane) = oa; *((v4u*)(xg8 + (size_t)sa2 * D) + lane) = oa; *((v4u*)(xg8 + (size_t)sb1 * D) + lane) = ob; *((v4u*)(xg8 + (size_t)sb2 * D) + lane) = ob;
                if (lane == 0) { ssg[sa1] = sva; ssg[sa2] = sva; sgate[sa1] = ra.g1; sgate[sa2] = ra.g2; tokslot[m0] = make_int2(sa1, sa2);
                                 ssg[sb1] = svb; ssg[sb2] = svb; sgate[sb1] = rb.g1; sgate[sb2] = rb.g2; tokslot[m1] = make_int2(sb1, sb2); }
            }
            for (int e = cb; e < NE; e += Gs) {
                int plo = 0, phi = 0;
#pragma unroll
                for (int q = 0; q < NE; ++q) if (e == q) { plo = base[q] + cn[q]; phi = base[q + 1]; }
                for (int r = plo + wave; r < phi; r += NWAVES) { *((v4u*)(xg8 + (size_t)r * D) + lane) = (v4u){0u, 0u, 0u, 0u}; if (lane == 0) { ssg[r] = 1024.f; sgate[r] = 0.f; } }
            }
            SEAM(PH(l, 5));
        }
        if (SITE(5) && !moe && IN(PH(l, 6))) REP(4) {
            SITE_BEGIN();
            pg8::Gemm g{HBP, (const bf16*)(wsl + (l == 0 ? OFF_WGU0 : OFF_WGU2)), M, 5632, 1024}; pg8::StaticOrder S; S.init(M, 5632, Gs, cb);
            if (DENSE_DN_FP8) { pg8::EpiSwiglu8 E{SSA(1), R0 + R_ACT, 16, 1.0f};
                pg8::gemm_phase<pg8::EpiSwiglu8, pg8::StaticOrder, true, true>(lds, g, S, E); }
            else { pg8::EpiSwiglu E{SSA(1), (bf16*)(R0 + R_ACT), 16, 0};
                pg8::gemm_phase<pg8::EpiSwiglu, pg8::StaticOrder, true, true>(lds, g, S, E); }
            SEAM(PH(l, 6));
        }
        if (SITE(13) && moe && IN(PH(l, 6))) REP(5) {
            SITE_BEGIN();
            pg8::Gemm g{(const bf16*)(R0 + R_XG), (const bf16*)(wsl + OFF_MGU), TMAX, 5632, 512}; pg8::GroupedOrder S; S.initg((const int*)(wsl + WS_CTL) + CW_BASE + (l == 3 ? 64 : 0), 5632, Gs, cb, (size_t)MOE_GU_BYTES);
            pg8::EpiSwiglu8 E{(const float*)(wsl + WS_SLOT), R0 + R_ACTG, 1, 1.0f / 64.0f};
            pg8::gemm_phase<pg8::EpiSwiglu8, pg8::GroupedOrder, true, true, true>(lds, g, S, E);
            SEAM(PH(l, 6));
        }
        if (!moe) {
            if (SITE(6) && IN(PH(l, 7))) REP(12) {
                SITE_BEGIN();
                pg8::Gemm g{(const bf16*)(R0 + R_ACT), (const bf16*)(wsl + (l == 0 ? OFF_WDN0 : OFF_WDN2)), M, 1024, DENSE_DN_FP8 ? 1408 : 2816}; pg8::StaticOrder S; S.init(M, 1024, Gs, cb);
                pg8::EpiRes E{HBP, DUMMY(12) ? (bf16*)(R0 + R_QS) : HBP, DUMMY(12) ? SSA(2) : SSA(0), DENSE_DN_FP8 ? 1.0f / 512.0f : 1.0f, 0};
                if (DENSE_DN_FP8) pg8::gemm_phase<pg8::EpiRes, pg8::StaticOrder, true, true, true, true>(lds, g, S, E);
                else pg8::gemm_phase<pg8::EpiRes, pg8::StaticOrder, true, true, false, true>(lds, g, S, E);
                SEAM(PH(l, 7));
            }
        } else {
            if (SITE(7) && IN(PH(l, 7))) REP(6) {
                SITE_BEGIN();
                pg8::Gemm g{(const bf16*)(R0 + R_ACTG), (const bf16*)(wsl + OFF_MDN), TMAX, 1024, 1408}; pg8::GroupedOrder S;   S.initg((const int*)(wsl + WS_CTL) + CW_BASE + (l == 3 ? 64 : 0), 1024, Gs, cb, (size_t)MOE_DN_BYTES);
                pg8::MoeSplit sp; sp.init(S.nM, 4, Gs); S.nM = sp.nM_main; S.nwg = sp.nM_main * 4;
                pg8::EpiMdn E{(const float*)(wsl + WS_SLOT) + TMAX, (bf16*)(R0 + R_XG), 1.0f / 512.0f, 0};
                pg8::gemm_phase<pg8::EpiMdn, pg8::GroupedOrder, true, true, true, true>(lds, g, S, E);
                SEAM(PH(l, 7));
            }
            if (SITE(8) && IN(PH(l, 8))) REP(10) {
                SITE_BEGIN();
                int tid_ = threadIdx.x; asm volatile("" : "+v"(tid_));
                const int lane = tid_ & 63, wave = __builtin_amdgcn_readfirstlane(tid_ >> 6);
                pg8::MoeSplit sp; sp.init(__builtin_amdgcn_readfirstlane(((const int*)(wsl + WS_CTL) + CW_BASE + (l == 3 ? 64 : 0))[8]) / 256, 4, Gs);
                const int ntail = sp.ntail, thr = ntail ? sp.nM_main * 256 : 0x7fffffff;
                const bool tailcu = cb < ntail;
                const int gw = (cb - ntail) * NWAVES + wave, NGW = (Gs - ntail) * NWAVES;
                const int2* tokslot = (const int2*)(wsl + WS_TOKSLOT);
                const float* gf = (l == 3) ? INP(38) : nullptr;
                if (tailcu) {
                    pg8::Gemm g{(const bf16*)(R0 + R_ACTG), (const bf16*)(wsl + OFF_MDN), TMAX, 1024, 1408}; pg8::TailOrder S; S.initg((const int*)(wsl + WS_CTL) + CW_BASE + (l == 3 ? 64 : 0), 1024, Gs, cb, (size_t)MOE_DN_BYTES);
                    S.tpm = sp.nM_main + (cb >> 2); S.tpn = cb & 3;
                    pg8::EpiMdn E{(const float*)(wsl + WS_SLOT) + TMAX, (bf16*)(R0 + R_XG), 1.0f / 512.0f, 0};
                    pg8::gemm_phase<pg8::EpiMdn, pg8::TailOrder, true, true, true, true>(lds, g, S, E);
                }
                unsigned pend = 0u;
#pragma nounroll
                for (int pass = 0; pass < 2; ++pass) {
                    if (pass == 1) { if (ntail == 0) break; if (hi - lo > 1) xcd_barrier(bar); }
                    if (!tailcu) { int k = 0;
                        for (int m = gw; m < M; m += 2 * NGW, ++k) {
                            if (pass == 1 && k < 32 && !((pend >> k) & 1u)) continue;
                            bool did;
                            if (l == 1) did = combine_rows2<false>(HBP, DUMMY(10) ? (bf16*)(R0 + R_ACTG) : HBP, nullptr, (const bf16*)(R0 + R_XG), tokslot, DUMMY(10) ? SSA(2) : SSA(0), nullptr, m, (m + NGW < M) ? m + NGW : m, lane, thr, pass);
                            else did = combine_rows2<true>(HBP, nullptr, DUMMY(10) ? (float*)(R0 + R_ACTG) : outl, (const bf16*)(R0 + R_XG), tokslot, nullptr, gf, m, (m + NGW < M) ? m + NGW : m, lane, thr, pass);
                            if (pass == 0 && !did && k < 32) pend |= 1u << k;
                        }
                    }
                }
                if (l == 1) conv_run(LC, lds, wsl, cb, Gs, tid_, 0, MOE_ITEMS, 36, 37, 34);
                SEAM(PH(l, 8));
            }
        }
    }

__global__ void __launch_bounds__(NWAVES * 64, 2) mega(Args args) {
    extern __shared__ __attribute__((aligned(16))) unsigned char lds_raw[];
    LAS unsigned char* lds = (LAS unsigned char*)lds_raw;
    volatile LAS unsigned* LC = (volatile LAS unsigned*)(lds + LDSCTL_OFF);
    for (int u = threadIdx.x; u < (LDS_BYTES - LDSCTL_OFF) / 4; u += NWAVES * 64) LC[u] = 0u;
    __syncthreads();
    if (threadIdx.x == 0) {
#pragma unroll
        for (int i = 0; i < 39; ++i) { const unsigned long long p = (unsigned long long)args.in[i]; LC[LC_PTR + 2 * i] = (unsigned)p; LC[LC_PTR + 2 * i + 1] = (unsigned)(p >> 32); }
    }
    __syncthreads();
#ifdef MK_PER_PHASE
    const int lo = args.ph_lo, hi = args.ph_hi;
#else
    constexpr int lo = 0, hi = PH_END;
#endif
    XcdBarrier bar; bar.bar = (unsigned*)(args.ws + WS_CTL) + CW_BAR; bar.x = 0; bar.st = nullptr;
    if (hi - lo > 1) bar = xcd_barrier_post((unsigned*)(args.ws + WS_CTL) + CW_BAR, LC + LC_BAR);
    if (SITE(0) && IN(PH_PRO)) REP(0) {
        SITE_BEGIN();
        int tid_ = threadIdx.x; asm volatile("" : "+v"(tid_));
        const int lane = tid_ & 63, wave = __builtin_amdgcn_readfirstlane(tid_ >> 6);
        const int gw = cb * NWAVES + wave, NGW = Gs * NWAVES;
        for (int l = 0; l < 2; ++l) { bf16* wd = (bf16*)(wsl + (l ? OFF_WD1 : OFF_WD0)) + (size_t)704 * 1024;
            for (int i = cb * 512 + tid_; i < 64 * 1024 / 8; i += Gs * 512) ((v4u*)wd)[i] = (v4u){0u, 0u, 0u, 0u}; }
        conv_run(LC, lds, wsl, cb, Gs, tid_, SMALL_ITEMS, SMALL_ITEMS + MOE_ITEMS, 21, 22, 19);
        for (int m = gw; m < M; m += NGW) prep_row(INP(0), (const int*)INP(1), HBP, SSA(0), (float2*)(wsl + WS_CS), m, lane);
        SEAM(PH_PRO);
    }

    layer_phases<0>(args, lds, LC, bar, lo, hi);
    layer_phases<1>(args, lds, LC, bar, lo, hi);
    layer_phases<2>(args, lds, LC, bar, lo, hi);
    layer_phases<3>(args, lds, LC, bar, lo, hi);
#undef IN
#undef SEAM
#undef INP
#undef SSA
}


extern "C" void kernel_launch(void* const* d_in, const int* in_sizes, int n_in, void* d_out, int out_size, void* d_ws, size_t ws_size, hipStream_t stream) {
    if (n_in != 39 || out_size != M * D || ws_size < WS_END) { fprintf(stderr, "kernel_launch: unexpected shapes (n_in %d out %d ws %zu need %zu)\n", n_in, out_size, ws_size, (size_t)WS_END); return; }
    static int once = 0, grid = 256;
    if (!once) { once = 1;
        { int dev = 0, cus = 0; if (hipGetDevice(&dev) == hipSuccess && hipDeviceGetAttribute(&cus, hipDeviceAttributeMultiprocessorCount, dev) == hipSuccess && cus > 0) grid = cus; }
        (void)hipFuncSetAttribute((const void*)mega, hipFuncAttributeMaxDynamicSharedMemorySize, LDS_BYTES); }
    unsigned char* ws = (unsigned char*)d_ws;
    float* out = (float*)d_out;
    Args a{};
    for (int i = 0; i < 39; ++i) a.in[i] = d_in[i];
    a.out = out; a.ws = ws;
    auto phase = [&](int p) { a.ph_lo = p; a.ph_hi = p + 1; hipLaunchKernelGGL(mega, dim3(grid), dim3(NWAVES * 64), LDS_BYTES, stream, a); }; (void)phase;

    (void)hipMemsetAsync(ws + WS_CTL, 0, CTL_BYTES, stream);
#ifdef MK_PER_PHASE
    for (int p = 0; p < PH_END; ++p) phase(p);
#else
    a.ph_lo = 0; a.ph_hi = PH_END;
    hipLaunchKernelGGL(mega, dim3(grid), dim3(NWAVES * 64), LDS_BYTES, stream, a);
#endif
}
```

```cpp
#include <hip/hip_runtime.h>
#include <cstdio>
#include <cstdint>

#ifndef REPEAT
#define REPEAT -1
#endif
#ifndef DENSE_DN_FP8
#define DENSE_DN_FP8 1
#endif
#ifndef MLA_FP8
#define MLA_FP8 1
#endif
typedef unsigned short bf16;
typedef float f32x4 __attribute__((ext_vector_type(4)));
typedef float f32x16 __attribute__((ext_vector_type(16)));
typedef unsigned u32x4 __attribute__((ext_vector_type(4)));
typedef unsigned u32x2 __attribute__((ext_vector_type(2)));

constexpr int NB = 8, S = 4096, D = 1024, M = NB * S;
constexpr int NH = 8, QKN = 128, QKR = 64, QKD = QKN + QKR, VH = 128, QL = 384, KVL = 256;
constexpr int NDOWN = QL + KVL + QKR;
constexpr int FF = 2816, NE = 8;
constexpr float EPS = 1e-6f;
constexpr float LOG2E = 1.4426950408889634f, LN2 = 0.6931471805599453f;
constexpr float C2_MLA = 0.07216878364870322f * LOG2E;
constexpr float C2_SB = 0.08838834764831845f * LOG2E;
constexpr int TMAX = 2 * M + NE * 256;

constexpr size_t MiB = 1u << 20;
constexpr size_t WS_CTL = 0, CTL_BYTES = 1 * MiB;
constexpr size_t WS_SS = 1 * MiB;
constexpr size_t WS_CS = 9 * MiB;
constexpr size_t WS_RINFO = 17 * MiB;
constexpr size_t WS_SLOT = 18 * MiB;
constexpr size_t WS_TOKSLOT = WS_SLOT + 768 * 1024;
constexpr size_t WS_HB = 19 * MiB;
constexpr size_t WS_R0 = 83 * MiB;
constexpr size_t R_CQ = 0, R_CKV = 24 * MiB, R_KR = 40 * MiB, R_Q = 44 * MiB, R_KN = 140 * MiB, R_V = 204 * MiB, R_O = 268 * MiB;
constexpr size_t R_Q8 = 44 * MiB, R_K8T = 92 * MiB, R_VT8T = 144 * MiB;
constexpr int K8_PITCH = 208, K8_TILE = 64 * K8_PITCH, VT8_PITCH = 80, VT8_TILE = 128 * VT8_PITCH;
static_assert(R_Q8 + (size_t)M * 1536 <= R_K8T && R_K8T + (size_t)4096 * K8_TILE <= R_VT8T && R_VT8T + (size_t)4096 * VT8_TILE <= R_O, "fp8 MLA buffers");
constexpr size_t R_ACT = 0;
constexpr size_t R_KS = 176 * MiB, R_VS = 240 * MiB, R_QS = 304 * MiB, R_OS = 368 * MiB;
constexpr size_t R_XG = 0, R_ACTG = 132 * MiB;
constexpr size_t WS_WSMALL = 578 * MiB, WS_WMOE = 635 * MiB;
constexpr size_t WS_END = 767 * MiB;
constexpr int CW_CNT = 64;
constexpr int CW_BAR = 4096;
constexpr int CW_BASE = 256;

__device__ __forceinline__ unsigned f2bf(float f) { unsigned u = __builtin_bit_cast(unsigned, f); return (u + 0x7fffu + ((u >> 16) & 1u)) >> 16; }
__device__ __forceinline__ float bf2f(unsigned b) { return __builtin_bit_cast(float, (b & 0xffffu) << 16); }
__device__ __forceinline__ unsigned pk2(float lo, float hi) { return f2bf(lo) | (f2bf(hi) << 16); }
__device__ __forceinline__ float wave_sum(float v) {
#pragma unroll
    for (int o = 1; o < 64; o <<= 1) v += __shfl_xor(v, o);
    return v;
}
__device__ __forceinline__ float wave_max(float v) {
#pragma unroll
    for (int o = 1; o < 64; o <<= 1) v = fmaxf(v, __shfl_xor(v, o));
    return v;
}
__device__ __forceinline__ int crow(int r, int hi) { return (r & 3) + 8 * (r >> 2) + 4 * hi; }

__device__ __forceinline__ float sum16(const float* p) { const f32x4 a = *(const f32x4*)p, b = *(const f32x4*)(p + 4), c = *(const f32x4*)(p + 8), d = *(const f32x4*)(p + 12);
    return (((a.x + a.y) + (a.z + a.w)) + ((b.x + b.y) + (b.z + b.w))) + (((c.x + c.y) + (c.z + c.w)) + ((d.x + d.y) + (d.z + d.w))); }
struct RInfo { int e1, e2, p1, p2; float g1, g2; int s1, s2; };

namespace pg8 {
#define PG8_LAS __attribute__((address_space(3)))
typedef unsigned short bf16_t;
typedef short bf16x8 __attribute__((ext_vector_type(8)));
typedef float f32x4 __attribute__((ext_vector_type(4)));
typedef unsigned u32x4 __attribute__((ext_vector_type(4)));
constexpr int BM = 256, BK = 64, HALF = 128, HTB = HALF * BK * 2  , STAGE_BYTES = 8 * HTB, NXCD = 8, WGM = 8;

__host__ __device__ __forceinline__ int lds_byte(int r, int c) { const int st = (r >> 4) * 2 + (c >> 5), rr = r & 15, cc = c & 31, ob = rr * 64 + cc * 2; return st * 1024 + (ob ^ (((ob >> 9) & 1) << 5)); }
__host__ __device__ __forceinline__ void stage_rc(int b, int& R, int& C) { const int st = b / 1024, sb = b % 1024, swz = sb ^ (((sb >> 9) & 1) << 5); R = (st >> 1) * 16 + swz / 64; C = (st & 1) * 32 + (swz % 64) / 2; }
__host__ __device__ __forceinline__ int perm32(int rho) { const int n = rho >> 4, i = rho & 15; return 8 * (i >> 2) + 4 * n + (i & 3); }

struct Unit { int pm, pn; };
struct Gemm { const bf16_t* A; const bf16_t* Bt; int M, N, K; };

struct StaticOrder {
    int nM, nN, nwg, G, c;
    __host__ __device__ void init(int M, int N, int G_, int c_) { nM = M / BM; nN = N / BM; nwg = nM * nN; G = G_; c = c_; }
    __host__ __device__ bool next(int i, Unit& u) const {
        const long L = (long)i * G + c; if (L >= nwg) return false;
        int wgid = (int)L; { const int q = nwg / NXCD, r = nwg % NXCD, xcd = wgid % NXCD, off = wgid / NXCD; wgid = (xcd < r ? xcd * (q + 1) : r * (q + 1) + (xcd - r) * q) + off; }
        const int nig = WGM * nN, gid = wgid / nig, fm = gid * WGM, gsz = (nM - fm) < WGM ? (nM - fm) : WGM;
        u.pm = fm + ((wgid % nig) % gsz); u.pn = (wgid % nig) / gsz; return true;
    }
    __device__ __forceinline__ void a_ready(const Unit&) const {}
    __device__ __forceinline__ void done(const Unit&) const {}
    __device__ __forceinline__ size_t boff(const Unit&) const { return 0; }
};

__device__ __forceinline__ unsigned cvt_pk_bf16(float lo, float hi) { unsigned r; asm volatile("v_cvt_pk_bf16_f32 %0, %1, %2" : "=v"(r) : "v"(lo), "v"(hi)); return r; }
typedef unsigned u32x2 __attribute__((ext_vector_type(2)));
__device__ __forceinline__ u32x4 pack8(const f32x4 a, const f32x4 b) { u32x4 w; w.x = cvt_pk_bf16(a[0], a[1]); w.y = cvt_pk_bf16(a[2], a[3]); w.z = cvt_pk_bf16(b[0], b[1]); w.w = cvt_pk_bf16(b[2], b[3]); return w; }
__device__ __forceinline__ float sumsq8(const f32x4 a, const f32x4 b) { return ((a[0] * a[0] + a[1] * a[1]) + (a[2] * a[2] + a[3] * a[3])) + ((b[0] * b[0] + b[1] * b[1]) + (b[2] * b[2] + b[3] * b[3])); }
__device__ __forceinline__ float red_fq(float q) {
    q += __uint_as_float((unsigned)__builtin_amdgcn_ds_swizzle((int)__float_as_uint(q), 0x401F));
    { auto rr = __builtin_amdgcn_permlane32_swap(__float_as_uint(q), __float_as_uint(q), false, false); q = __uint_as_float(rr[0]) + __uint_as_float(rr[1]); }
    return q; }
__device__ __forceinline__ float row_ss(const float* ss, int stride, int nq, int r, int fq) { if (stride == 1) return ss[r]; float q = 0.f; if (fq < nq) { const f32x4 v = *(const f32x4*)(ss + (size_t)r * 16 + fq * 4); q = (v[0] + v[1]) + (v[2] + v[3]); } return red_fq(q); }
constexpr float EPSN = 1e-6f;
__device__ __forceinline__ void row_sums(float (&q)[8], const float* ss, int stride, int nq, int row0, int fq) {
    if (stride == 1) {
#pragma unroll
        for (int g = 0; g < 8; ++g) q[g] = ss[row0 + (g >> 2) * HALF + (g & 3) * 16];
        asm volatile("" :: "v"(q[0]), "v"(q[1]), "v"(q[2]), "v"(q[3]), "v"(q[4]), "v"(q[5]), "v"(q[6]), "v"(q[7]));
        return;
    }
    f32x4 raw[8]; const int fqc = (fq < nq) ? fq : 0;
#pragma unroll
    for (int g = 0; g < 8; ++g) raw[g] = *(const f32x4*)(ss + (size_t)(row0 + (g >> 2) * HALF + (g & 3) * 16) * 16 + fqc * 4);
    asm volatile("" :: "v"(raw[0]), "v"(raw[1]), "v"(raw[2]), "v"(raw[3]), "v"(raw[4]), "v"(raw[5]), "v"(raw[6]), "v"(raw[7]));
    float t[8];
#pragma unroll
    for (int g = 0; g < 8; ++g) { const float sm = (raw[g][0] + raw[g][1]) + (raw[g][2] + raw[g][3]); q[g] = (fq < nq) ? sm : 0.f; }
#pragma unroll
    for (int g = 0; g < 8; ++g) t[g] = __uint_as_float((unsigned)__builtin_amdgcn_ds_swizzle((int)__float_as_uint(q[g]), 0x401F));
#pragma unroll
    for (int g = 0; g < 8; ++g) q[g] += t[g];
#pragma unroll
    for (int g = 0; g < 8; ++g) { auto rr = __builtin_amdgcn_permlane32_swap(__float_as_uint(q[g]), __float_as_uint(q[g]), false, false); q[g] = __uint_as_float(rr[0]) + __uint_as_float(rr[1]); }
}
#define EPI_ROW_SCALES(rs_, ss_, stride_, nq_, expr) float rs_[8]; { float q_[8]; row_sums(q_, ss_, stride_, nq_, u.pm * BM + wr * 64 + fr, fq); _Pragma("unroll") for (int g_ = 0; g_ < 8; ++g_) { const float q = q_[g_]; rs_[g_] = (expr); } }
__device__ __forceinline__ float rsq_(float x) { return __builtin_amdgcn_rsqf(x); }
constexpr int TOUCH_SINK = STAGE_BYTES + 4096;
__device__ __forceinline__ void touch_line(PG8_LAS unsigned char* lds, const void* p) { __builtin_amdgcn_global_load_lds((const unsigned*)p, (PG8_LAS unsigned*)(lds + TOUCH_SINK), 4, 0, 0); }
__device__ __forceinline__ void touch_rows16(PG8_LAS unsigned char* lds, const float* ss, int row0, int tid) { if (tid < 128) touch_line(lds, (const char*)(ss + (size_t)row0 * 16) + tid * 128); }
__device__ __forceinline__ void touch_rows1(PG8_LAS unsigned char* lds, const float* ss, int row0, int tid) { if (tid < 8) touch_line(lds, (const char*)(ss + row0) + tid * 128); }
__device__ __forceinline__ unsigned pk4_fp8(float a, float b, float c, float d) {
    a = __builtin_amdgcn_fmed3f(a, -448.f, 448.f); b = __builtin_amdgcn_fmed3f(b, -448.f, 448.f); c = __builtin_amdgcn_fmed3f(c, -448.f, 448.f); d = __builtin_amdgcn_fmed3f(d, -448.f, 448.f);
    int w = __builtin_amdgcn_cvt_pk_fp8_f32(a, b, 0, false); w = __builtin_amdgcn_cvt_pk_fp8_f32(c, d, w, true); return (unsigned)w; }

struct EpiDown { static constexpr bool PERM = true, AFTER_DRAIN = false, PROBE2 = false;
    const float* ss; const float2* cs; bf16_t* cq; bf16_t* ckv; bf16_t* kr; float* ssq; float* sskv; unsigned char* k8t;
    __device__ __forceinline__ void touch(PG8_LAS unsigned char* lds, const Unit& u, int tid) const { touch_rows16(lds, ss, u.pm * BM, tid); }
    __device__ __forceinline__ void operator()(const f32x4 (&acc)[2][2][4][2], const Unit& u0, int wr, int wc, int fr, int fq) const {
        Unit u = u0; asm volatile("" : "+s"(u.pm), "+s"(u.pn));
        EPI_ROW_SCALES(rs, ss, 16, 4, rsq_(q * (1.0f / 1024.0f) + EPSN))
#pragma unroll
        for (int ai = 0; ai < 2; ++ai)
#pragma unroll
            for (int m = 0; m < 4; ++m) { const int r = u.pm * BM + ai * HALF + wr * 64 + m * 16 + fr; const float rstd = rs[ai * 4 + m];
#pragma unroll
                for (int bj = 0; bj < 2; ++bj) { const int c = u.pn * BM + bj * HALF + wc * 32, cl = c + fq * 8;
                    const f32x4 v0 = acc[ai][bj][m][0] * rstd, v1 = acc[ai][bj][m][1] * rstd;
                    if (c < 384) { *(u32x4*)(cq + (size_t)r * 384 + cl) = pack8(v0, v1); const float q = red_fq(sumsq8(v0, v1)); if (fq == 0) ssq[(size_t)r * 16 + (c >> 5)] = q; }
                    else if (c < 640) { *(u32x4*)(ckv + (size_t)r * 256 + (cl - 384)) = pack8(v0, v1); const float q = red_fq(sumsq8(v0, v1)); if (fq == 0) sskv[(size_t)r * 16 + ((c - 384) >> 5)] = q; }
                    else if (c < 704) { const int i0 = (cl - 640) >> 1; const f32x4 t01 = *(const f32x4*)(cs + (size_t)r * 32 + i0), t23 = *(const f32x4*)(cs + (size_t)r * 32 + i0 + 2);
                        const f32x4 o0 = {v0[0] * t01[0] - v0[1] * t01[1], v0[0] * t01[1] + v0[1] * t01[0], v0[2] * t01[2] - v0[3] * t01[3], v0[2] * t01[3] + v0[3] * t01[2]};
                        const f32x4 o1 = {v1[0] * t23[0] - v1[1] * t23[1], v1[0] * t23[1] + v1[1] * t23[0], v1[2] * t23[2] - v1[3] * t23[3], v1[2] * t23[3] + v1[3] * t23[2]};
                        if (k8t) { u32x2 w; w.x = pk4_fp8(o0[0], o0[1], o0[2], o0[3]); w.y = pk4_fp8(o1[0], o1[1], o1[2], o1[3]); const int b = r >> 12, key = r & 4095, j = key >> 6, kk = key & 63;
#pragma unroll
                            for (int h2 = 0; h2 < 8; ++h2) *(u32x2*)(k8t + (size_t)((b * 8 + h2) * 64 + j) * 13312 + kk * 208 + 128 + (cl - 640)) = w; }
                        else *(u32x4*)(kr + (size_t)r * 64 + (cl - 640)) = pack8(o0, o1); }
                } }
    }
};
struct EpiUq { static constexpr bool PERM = true, AFTER_DRAIN = false, PROBE2 = false;
    const float* ssq; const float2* cs; bf16_t* Q; float c2; int pad;
    __device__ __forceinline__ void touch(PG8_LAS unsigned char* lds, const Unit& u, int tid) const { touch_rows16(lds, ssq, u.pm * BM, tid); }
    __device__ __forceinline__ void operator()(const f32x4 (&acc)[2][2][4][2], const Unit& u0, int wr, int wc, int fr, int fq) const {
        Unit u = u0; asm volatile("" : "+s"(u.pm), "+s"(u.pn));
        EPI_ROW_SCALES(rs, ssq, 16, 3, rsq_(q * (1.0f / 384.0f) + EPSN) * c2)
#pragma unroll
        for (int ai = 0; ai < 2; ++ai)
#pragma unroll
            for (int m = 0; m < 4; ++m) { const int r = u.pm * BM + ai * HALF + wr * 64 + m * 16 + fr; const float rstd = rs[ai * 4 + m];
#pragma unroll
                for (int bj = 0; bj < 2; ++bj) { const int c = u.pn * BM + bj * HALF + wc * 32, cl = c + fq * 8, d = c % 192;
                    const f32x4 v0 = acc[ai][bj][m][0] * rstd, v1 = acc[ai][bj][m][1] * rstd;
                    if (d < 128) { *(u32x4*)(Q + (size_t)r * 1536 + cl) = pack8(v0, v1); }
                    else { const int i0 = ((d - 128) >> 1) + fq * 4; const f32x4 t01 = *(const f32x4*)(cs + (size_t)r * 32 + i0), t23 = *(const f32x4*)(cs + (size_t)r * 32 + i0 + 2);
                        const f32x4 o0 = {v0[0] * t01[0] - v0[1] * t01[1], v0[0] * t01[1] + v0[1] * t01[0], v0[2] * t01[2] - v0[3] * t01[3], v0[2] * t01[3] + v0[3] * t01[2]};
                        const f32x4 o1 = {v1[0] * t23[0] - v1[1] * t23[1], v1[0] * t23[1] + v1[1] * t23[0], v1[2] * t23[2] - v1[3] * t23[3], v1[2] * t23[3] + v1[3] * t23[2]};
                        *(u32x4*)(Q + (size_t)r * 1536 + cl) = pack8(o0, o1); }
                } }
    }
};
struct EpiUq8 { static constexpr bool PERM = true, AFTER_DRAIN = false, PROBE2 = false;
    const float* ssq; const float2* cs; unsigned char* Q8; float c2; int pad;
    __device__ __forceinline__ void touch(PG8_LAS unsigned char* lds, const Unit& u, int tid) const { touch_rows16(lds, ssq, u.pm * BM, tid); }
    __device__ __forceinline__ void operator()(const f32x4 (&acc)[2][2][4][2], const Unit& u0, int wr, int wc, int fr, int fq) const {
        Unit u = u0; asm volatile("" : "+s"(u.pm), "+s"(u.pn));
        EPI_ROW_SCALES(rs, ssq, 16, 3, rsq_(q * (1.0f / 384.0f) + EPSN) * c2)
#pragma unroll
        for (int ai = 0; ai < 2; ++ai)
#pragma unroll
            for (int m = 0; m < 4; ++m) { const int r = u.pm * BM + ai * HALF + wr * 64 + m * 16 + fr; const float rstd = rs[ai * 4 + m];
#pragma unroll
                for (int bj = 0; bj < 2; ++bj) { const int c = u.pn * BM + bj * HALF + wc * 32, cl = c + fq * 8, d = c % 192;
                    f32x4 v0 = acc[ai][bj][m][0] * rstd, v1 = acc[ai][bj][m][1] * rstd;
                    if (d >= 128) { const int i0 = ((d - 128) >> 1) + fq * 4; const f32x4 t01 = *(const f32x4*)(cs + (size_t)r * 32 + i0), t23 = *(const f32x4*)(cs + (size_t)r * 32 + i0 + 2);
                        const f32x4 o0 = {v0[0] * t01[0] - v0[1] * t01[1], v0[0] * t01[1] + v0[1] * t01[0], v0[2] * t01[2] - v0[3] * t01[3], v0[2] * t01[3] + v0[3] * t01[2]};
                        const f32x4 o1 = {v1[0] * t23[0] - v1[1] * t23[1], v1[0] * t23[1] + v1[1] * t23[0], v1[2] * t23[2] - v1[3] * t23[3], v1[2] * t23[3] + v1[3] * t23[2]};
                        v0 = o0; v1 = o1; }
                    u32x2 w; w.x = pk4_fp8(v0[0], v0[1], v0[2], v0[3]); w.y = pk4_fp8(v1[0], v1[1], v1[2], v1[3]);
                    *(u32x2*)(Q8 + (size_t)r * 1536 + cl) = w; } }
    }
};
struct EpiKn8 { static constexpr bool PERM = true, AFTER_DRAIN = false, PROBE2 = false;
    const float* sskv; unsigned char* K8T;
    __device__ __forceinline__ void touch(PG8_LAS unsigned char* lds, const Unit& u, int tid) const { touch_rows16(lds, sskv, u.pm * BM, tid); }
    __device__ __forceinline__ void operator()(const f32x4 (&acc)[2][2][4][2], const Unit& u0, int wr, int wc, int fr, int fq) const {
        Unit u = u0; asm volatile("" : "+s"(u.pm), "+s"(u.pn));
        EPI_ROW_SCALES(rs, sskv, 16, 2, rsq_(q * (1.0f / 256.0f) + EPSN))
#pragma unroll
        for (int ai = 0; ai < 2; ++ai)
#pragma unroll
            for (int m = 0; m < 4; ++m) { const int r = u.pm * BM + ai * HALF + wr * 64 + m * 16 + fr; const float rstd = rs[ai * 4 + m];
                const int b = r >> 12, key = r & 4095, j = key >> 6, kk = key & 63;
#pragma unroll
                for (int bj = 0; bj < 2; ++bj) { const int head = 2 * u.pn + bj; const f32x4 v0 = acc[ai][bj][m][0] * rstd, v1 = acc[ai][bj][m][1] * rstd;
                    u32x2 w; w.x = pk4_fp8(v0[0], v0[1], v0[2], v0[3]); w.y = pk4_fp8(v1[0], v1[1], v1[2], v1[3]);
                    *(u32x2*)(K8T + (size_t)((b * 8 + head) * 64 + j) * 13312 + kk * 208 + wc * 32 + fq * 8) = w; } }
    }
};
struct EpiVt8 { static constexpr bool PERM = true, AFTER_DRAIN = false, PROBE2 = false;
    const float* sskv; unsigned char* VT8T;
    __device__ __forceinline__ void touch(PG8_LAS unsigned char* lds, const Unit& u, int tid) const { touch_rows16(lds, sskv, u.pn * BM, tid); }
    __device__ __forceinline__ void operator()(const f32x4 (&acc)[2][2][4][2], const Unit& u0, int wr, int wc, int fr, int fq) const {
        Unit u = u0; asm volatile("" : "+s"(u.pm), "+s"(u.pn));
        float sc[2][8];
#pragma unroll
        for (int bj = 0; bj < 2; ++bj) { const int c = u.pn * BM + bj * HALF + wc * 32 + fq * 8;
            f32x4 s0[8], s1[8];
#pragma unroll
            for (int i = 0; i < 8; ++i) { s0[i] = *(const f32x4*)(sskv + (size_t)(c + i) * 16); s1[i] = *(const f32x4*)(sskv + (size_t)(c + i) * 16 + 4); }
            asm volatile("" :: "v"(s0[0]), "v"(s0[1]), "v"(s0[2]), "v"(s0[3]), "v"(s0[4]), "v"(s0[5]), "v"(s0[6]), "v"(s0[7]), "v"(s1[0]), "v"(s1[1]), "v"(s1[2]), "v"(s1[3]), "v"(s1[4]), "v"(s1[5]), "v"(s1[6]), "v"(s1[7]));
#pragma unroll
            for (int i = 0; i < 8; ++i) sc[bj][i] = rsq_((((s0[i][0] + s0[i][1]) + (s0[i][2] + s0[i][3])) + ((s1[i][0] + s1[i][1]) + (s1[i][2] + s1[i][3]))) * (1.0f / 256.0f) + EPSN); }
#pragma unroll
        for (int ai = 0; ai < 2; ++ai)
#pragma unroll
            for (int m = 0; m < 4; ++m) { const int rr = u.pm * BM + ai * HALF + wr * 64 + m * 16 + fr, head = rr >> 7, d = rr & 127;
#pragma unroll
                for (int bj = 0; bj < 2; ++bj) { const int c = u.pn * BM + bj * HALF + wc * 32 + fq * 8, b = c >> 12, key = c & 4095, j = key >> 6, kk = key & 63;
                    const f32x4 v0 = acc[ai][bj][m][0], v1 = acc[ai][bj][m][1];
                    u32x2 w; w.x = pk4_fp8(v0[0] * sc[bj][0], v0[1] * sc[bj][1], v0[2] * sc[bj][2], v0[3] * sc[bj][3]); w.y = pk4_fp8(v1[0] * sc[bj][4], v1[1] * sc[bj][5], v1[2] * sc[bj][6], v1[3] * sc[bj][7]);
                    *(u32x2*)(VT8T + (size_t)((b * 8 + head) * 64 + j) * 10240 + d * 80 + kk) = w; } }
    }
};
struct EpiUkv { static constexpr bool PERM = true, AFTER_DRAIN = false, PROBE2 = false;
    const float* sskv; bf16_t* KN; bf16_t* V;
    __device__ __forceinline__ void touch(PG8_LAS unsigned char* lds, const Unit& u, int tid) const { touch_rows16(lds, sskv, u.pm * BM, tid); }
    __device__ __forceinline__ void operator()(const f32x4 (&acc)[2][2][4][2], const Unit& u0, int wr, int wc, int fr, int fq) const {
        Unit u = u0; asm volatile("" : "+s"(u.pm), "+s"(u.pn));
        EPI_ROW_SCALES(rs, sskv, 16, 2, rsq_(q * (1.0f / 256.0f) + EPSN))
#pragma unroll
        for (int ai = 0; ai < 2; ++ai)
#pragma unroll
            for (int m = 0; m < 4; ++m) { const int r = u.pm * BM + ai * HALF + wr * 64 + m * 16 + fr; const float rstd = rs[ai * 4 + m];
                const size_t o = (size_t)r * 1024 + u.pn * 128 + wc * 32 + fq * 8;
                *(u32x4*)(KN + o) = pack8(acc[ai][0][m][0] * rstd, acc[ai][0][m][1] * rstd);
                *(u32x4*)(V + o) = pack8(acc[ai][1][m][0] * rstd, acc[ai][1][m][1] * rstd); }
    }
};
__device__ __forceinline__ f32x4 bf4_lo(const u32x4 w) { return (f32x4){__uint_as_float(w.x << 16), __uint_as_float(w.x & 0xffff0000u), __uint_as_float(w.y << 16), __uint_as_float(w.y & 0xffff0000u)}; }
__device__ __forceinline__ f32x4 bf4_hi(const u32x4 w) { return (f32x4){__uint_as_float(w.z << 16), __uint_as_float(w.z & 0xffff0000u), __uint_as_float(w.w << 16), __uint_as_float(w.w & 0xffff0000u)}; }
struct EpiRes { static constexpr bool PERM = true, AFTER_DRAIN = false, PROBE2 = false;
    const bf16_t* hin; bf16_t* hb; float* ssn; float ascale; int pad;
    __device__ __forceinline__ void touch(PG8_LAS unsigned char* lds, const Unit& u, int tid) const { _Pragma("unroll") for (int i = 0; i < 2; ++i) { const int li = tid + 512 * i; touch_line(lds, (const char*)(hin + (size_t)(u.pm * BM + (li >> 2)) * 1024 + u.pn * BM) + (li & 3) * 128); } }
    __device__ __forceinline__ void operator()(const f32x4 (&acc)[2][2][4][2], const Unit& u0, int wr, int wc, int fr, int fq) const {
        Unit u = u0; asm volatile("" : "+s"(u.pm), "+s"(u.pn));
        const size_t o00 = (size_t)(u.pm * BM + wr * 64 + fr) * 1024 + u.pn * BM + wc * 32 + fq * 8;
        u32x4 h0[8], h1[8];
#pragma unroll
        for (int g = 0; g < 8; ++g) { const size_t og = o00 + (size_t)((g >> 2) * HALF + (g & 3) * 16) * 1024; h0[g] = *(const u32x4*)(hin + og); h1[g] = *(const u32x4*)(hin + og + HALF); }
        asm volatile("" :: "v"(h0[0]), "v"(h0[1]), "v"(h0[2]), "v"(h0[3]), "v"(h0[4]), "v"(h0[5]), "v"(h0[6]), "v"(h0[7]), "v"(h1[0]), "v"(h1[1]), "v"(h1[2]), "v"(h1[3]), "v"(h1[4]), "v"(h1[5]), "v"(h1[6]), "v"(h1[7]));
#pragma unroll
        for (int g = 0; g < 8; ++g) { const int ai = g >> 2, m = g & 3; const int r = u.pm * BM + ai * HALF + wr * 64 + m * 16 + fr;
            float q = 0.f;
#pragma unroll
            for (int bj = 0; bj < 2; ++bj) { const size_t o = o00 + (size_t)(ai * HALF + m * 16) * 1024 + bj * HALF; const u32x4 hv = bj ? h1[g] : h0[g];
                const f32x4 o0 = bf4_lo(hv) + acc[ai][bj][m][0] * ascale, o1 = bf4_hi(hv) + acc[ai][bj][m][1] * ascale;
                *(u32x4*)(hb + o) = pack8(o0, o1); q += sumsq8(o0, o1); }
            q = red_fq(q); if (fq == 0) ssn[(size_t)r * 16 + u.pn * 4 + wc] = q; }
    }
};
struct EpiSwiglu { static constexpr bool PERM = true, AFTER_DRAIN = false, PROBE2 = true;
    const float* ss; bf16_t* act; int ss_stride; int pad;
    __device__ __forceinline__ void touch(PG8_LAS unsigned char* lds, const Unit& u, int tid) const { if (ss_stride == 1) touch_rows1(lds, ss, u.pm * BM, tid); else touch_rows16(lds, ss, u.pm * BM, tid); }
    __device__ __forceinline__ void operator()(const f32x4 (&acc)[2][2][4][2], const Unit& u0, int wr, int wc, int fr, int fq) const {
        Unit u = u0; asm volatile("" : "+s"(u.pm), "+s"(u.pn));
        bf16_t* abase = act + ((size_t)(u.pm * 44 + 2 * u.pn + (wc >> 1)) * 256 + wr * 64 + fr) * 64 + (wc & 1) * 32 + fq * 8;
        EPI_ROW_SCALES(rs, ss, ss_stride, 4, rsq_(q * (1.0f / 1024.0f) + EPSN))
#pragma unroll
        for (int ai = 0; ai < 2; ++ai)
#pragma unroll
            for (int m = 0; m < 4; ++m) { const float rstd = rs[ai * 4 + m];
                f32x4 a[2];
                const float c1 = -1.4426950408889634f * rstd, ic2 = __builtin_amdgcn_rcpf(rstd * rstd);
#pragma unroll
                for (int n = 0; n < 2; ++n) { const f32x4 ag = acc[ai][0][m][n], t = ag * acc[ai][1][m][n];
#pragma unroll
                    for (int j = 0; j < 4; ++j) a[n][j] = t[j] * __builtin_amdgcn_rcpf(__builtin_fmaf(__builtin_amdgcn_exp2f(ag[j] * c1), ic2, ic2)); }
                *(u32x4*)(abase + (ai * HALF + m * 16) * 64) = pack8(a[0], a[1]); }
    }
};
__device__ __forceinline__ unsigned pk4_fp8_nc(float a, float b, float c, float d) { int w = __builtin_amdgcn_cvt_pk_fp8_f32(a, b, 0, false); w = __builtin_amdgcn_cvt_pk_fp8_f32(c, d, w, true); return (unsigned)w; }
struct EpiSwiglu8 { static constexpr bool PERM = true, AFTER_DRAIN = false, PROBE2 = false;
    const float* ss; unsigned char* act; int ss_stride; float ascale;
    __device__ __forceinline__ void touch(PG8_LAS unsigned char* lds, const Unit& u, int tid) const { if (ss_stride == 1) touch_rows1(lds, ss, u.pm * BM, tid); else touch_rows16(lds, ss, u.pm * BM, tid); }
    __device__ __forceinline__ void operator()(const f32x4 (&acc)[2][2][4][2], const Unit& u0, int wr, int wc, int fr, int fq) const {
        Unit u = u0; asm volatile("" : "+s"(u.pm), "+s"(u.pn));
        unsigned char* abase = act + (size_t)(u.pm * 22 + u.pn) * 32768 + (wr * 64 + fr) * 128 + wc * 32 + fq * 8;
        EPI_ROW_SCALES(rs, ss, ss_stride, 4, rsq_(q * (1.0f / 1024.0f) + EPSN) * ascale)
#pragma unroll
        for (int ai = 0; ai < 2; ++ai)
#pragma unroll
            for (int m = 0; m < 4; ++m) { const float rstd = rs[ai * 4 + m];
                f32x4 a[2];
                const float c1 = -1.4426950408889634f * rstd, ic2 = __builtin_amdgcn_rcpf(rstd * rstd * 8.0f);
#pragma unroll
                for (int n = 0; n < 2; ++n) { const f32x4 ag = acc[ai][0][m][n], t = ag * acc[ai][1][m][n];
#pragma unroll
                    for (int j = 0; j < 4; ++j) a[n][j] = t[j] * __builtin_amdgcn_rcpf(__builtin_fmaf(__builtin_amdgcn_exp2f(ag[j] * c1), ic2, ic2)); }
                u32x2 w; w.x = pk4_fp8(a[0][0], a[0][1], a[0][2], a[0][3]); w.y = pk4_fp8(a[1][0], a[1][1], a[1][2], a[1][3]);
                *(u32x2*)(abase + (ai * HALF + m * 16) * 128) = w; }
    }
};
struct EpiProj { static constexpr bool PERM = true, AFTER_DRAIN = false, PROBE2 = false;
    const float* ss; bf16_t* o0; size_t tstride; float qs; int qt; int nq; float invd; int pad;
    __device__ __forceinline__ void touch(PG8_LAS unsigned char* lds, const Unit& u, int tid) const { touch_rows16(lds, ss, u.pm * BM, tid); }
    __device__ __forceinline__ void operator()(const f32x4 (&acc)[2][2][4][2], const Unit& u0, int wr, int wc, int fr, int fq) const {
        Unit u = u0; asm volatile("" : "+s"(u.pm), "+s"(u.pn));
        const int t = u.pn >> 2; bf16_t* dst = o0 + (size_t)t * tstride; const float sc = (t == qt) ? qs : 1.0f;
        EPI_ROW_SCALES(rs, ss, 16, nq, rsq_(q * invd + EPSN) * sc)
#pragma unroll
        for (int ai = 0; ai < 2; ++ai)
#pragma unroll
            for (int m = 0; m < 4; ++m) { const int r = u.pm * BM + ai * HALF + wr * 64 + m * 16 + fr; const float rstd = rs[ai * 4 + m];
#pragma unroll
                for (int bj = 0; bj < 2; ++bj) *(u32x4*)(dst + (size_t)r * 1024 + (u.pn & 3) * BM + bj * HALF + wc * 32 + fq * 8) = pack8(acc[ai][bj][m][0] * rstd, acc[ai][bj][m][1] * rstd); }
    }
};
struct EpiMdn { static constexpr bool PERM = true, AFTER_DRAIN = false, PROBE2 = false;
    const float* sgate; bf16_t* y; float scale; int pad;
    __device__ __forceinline__ void touch(PG8_LAS unsigned char* lds, const Unit& u, int tid) const { touch_rows1(lds, sgate, u.pm * BM, tid); }
    __device__ __forceinline__ void operator()(const f32x4 (&acc)[2][2][4][2], const Unit& u0, int wr, int wc, int fr, int fq) const {
        Unit u = u0; asm volatile("" : "+s"(u.pm), "+s"(u.pn));
        EPI_ROW_SCALES(rs, sgate, 1, 0, q * scale)
#pragma unroll
        for (int ai = 0; ai < 2; ++ai)
#pragma unroll
            for (int m = 0; m < 4; ++m) { const int r = u.pm * BM + ai * HALF + wr * 64 + m * 16 + fr; const float g = rs[ai * 4 + m];
#pragma unroll
                for (int bj = 0; bj < 2; ++bj) *(u32x4*)(y + (size_t)r * 1024 + u.pn * BM + bj * HALF + wc * 32 + fq * 8) = pack8(acc[ai][bj][m][0] * g, acc[ai][bj][m][1] * g); }
    }
};
struct GroupedOrder : StaticOrder {
    int b1, b2, b3, b4, b5, b6, b7; size_t estride;
    __device__ __forceinline__ void initg(const int* base, int N, int G_, int c_, size_t estride_) { init(__builtin_amdgcn_readfirstlane(base[8]), N, G_, c_); b1 = __builtin_amdgcn_readfirstlane(base[1]); b2 = __builtin_amdgcn_readfirstlane(base[2]); b3 = __builtin_amdgcn_readfirstlane(base[3]); b4 = __builtin_amdgcn_readfirstlane(base[4]); b5 = __builtin_amdgcn_readfirstlane(base[5]); b6 = __builtin_amdgcn_readfirstlane(base[6]); b7 = __builtin_amdgcn_readfirstlane(base[7]); estride = estride_; }
    __device__ __forceinline__ void initd(int M, int N, int G_, int c_) { init(M, N, G_, c_); b1 = b2 = b3 = b4 = b5 = b6 = b7 = 0x7fffffff; estride = 0; }
    __device__ __forceinline__ size_t boff(const Unit& u) const { const int r = u.pm * BM; const int e = (r >= b1) + (r >= b2) + (r >= b3) + (r >= b4) + (r >= b5) + (r >= b6) + (r >= b7); return (size_t)e * estride; }
};
struct MoeSplit { int nM_main, ntail;
    __device__ __forceinline__ void init(int nM, int nN, int G) { const int nwg = nM * nN, t = nwg % G; const bool on = (G % nN == 0) && t != 0 && t * 4 <= G && nwg > G; ntail = on ? t : 0; nM_main = (nwg - ntail) / nN; } };
struct TailOrder : GroupedOrder { int tpm, tpn;
    __device__ __forceinline__ bool next(int i, Unit& u) const { if (i != 0) return false; u.pm = tpm; u.pn = tpn; return true; } };
typedef int v8i_t __attribute__((ext_vector_type(8)));
typedef int v4i_t __attribute__((ext_vector_type(4)));
__device__ __forceinline__ v8i_t cat8(const bf16x8 lo, const bf16x8 hi) { const v4i_t a = __builtin_bit_cast(v4i_t, lo), b = __builtin_bit_cast(v4i_t, hi); return __builtin_shufflevector(a, b, 0, 1, 2, 3, 4, 5, 6, 7); }
template <class Epi, class Sched, bool ALIGN_EPI = false, bool SP2 = false, bool F8 = false, bool TILED = false>
__device__ __forceinline__ void gemm_phase(PG8_LAS unsigned char* lds, const Gemm g, const Sched& S, const Epi& E) {
    int tid_ = threadIdx.x; asm volatile("" : "+v"(tid_));
    const int tid = tid_, wid = __builtin_amdgcn_readfirstlane(tid >> 6), lane = tid & 63, wr = wid >> 2, wc = wid & 3, fr = lane & 15, fq = lane >> 4;
    int K_ = g.K; asm volatile("" : "+s"(K_));
    const int K = K_, nt = K / BK;
    unsigned voffA[2], voffB[2];
#pragma unroll
    for (int i = 0; i < 2; ++i) { int R, C; stage_rc(tid * 16 + i * 8192, R, C); const int Rb = Epi::PERM ? ((R & ~31) + perm32(R & 31)) : R;
        voffA[i] = TILED ? (unsigned)(R * 128 + C * 2) : (unsigned)(R * K + C) * 2u; voffB[i] = TILED ? (unsigned)(Rb * 128 + C * 2) : (unsigned)(Rb * K + C) * 2u; }
    const size_t kstep = TILED ? (size_t)32768 : (size_t)(BK * 2);
    const size_t hstep = TILED ? (size_t)16384 : (size_t)HALF * K * 2;
    const size_t tstep = (size_t)BM * K * 2;
    const unsigned ldsw = (unsigned)wid * 1024u;
    const int aoff = lds_byte(wr * 64 + fr, fq * 8), boff = lds_byte(wc * 32 + fr, fq * 8);
#define PG8_SA(b, h) (((b) * 2 + (h)) * HTB)
#define PG8_SB(b, h) ((4 + (b) * 2 + (h)) * HTB)
#define PG8_STAGE(bufoff, gbase, voff) do { _Pragma("unroll") for (int _i = 0; _i < 2; ++_i) \
        __builtin_amdgcn_global_load_lds((const unsigned*)((const char*)(gbase) + (voff)[_i]), (PG8_LAS unsigned*)(lds + (bufoff) + ldsw + _i * 8192), 16, 0, 0); } while (0)
#define PG8_LD16(off) (*(const PG8_LAS v4i_t*)(lds + (off)))
#define PG8_LDA(dst, b, h) do { if constexpr (F8) { _Pragma("unroll") for (int m = 0; m < 4; ++m) dst##8[m] = __builtin_shufflevector(PG8_LD16(PG8_SA(b, h) + aoff + m * 2048), PG8_LD16(PG8_SA(b, h) + aoff + m * 2048 + 1024), 0, 1, 2, 3, 4, 5, 6, 7); } \
        else { _Pragma("unroll") for (int m = 0; m < 4; ++m) _Pragma("unroll") for (int k = 0; k < 2; ++k) dst[m][k] = *(const PG8_LAS bf16x8*)(lds + PG8_SA(b, h) + aoff + m * 2048 + k * 1024); } } while (0)
#define PG8_LDB(dst, b, h) do { if constexpr (F8) { _Pragma("unroll") for (int n = 0; n < 2; ++n) dst##8[n] = __builtin_shufflevector(PG8_LD16(PG8_SB(b, h) + boff + n * 2048), PG8_LD16(PG8_SB(b, h) + boff + n * 2048 + 1024), 0, 1, 2, 3, 4, 5, 6, 7); } \
        else { _Pragma("unroll") for (int n = 0; n < 2; ++n) _Pragma("unroll") for (int k = 0; k < 2; ++k) dst[n][k] = *(const PG8_LAS bf16x8*)(lds + PG8_SB(b, h) + boff + n * 2048 + k * 1024); } } while (0)
#define PG8_MMA(ai, bj, At, Bt) do { __builtin_amdgcn_s_setprio(1); \
        if constexpr (F8) { asm volatile("s_nop 1"); _Pragma("unroll") for (int m = 0; m < 4; ++m) _Pragma("unroll") for (int n = 0; n < 2; ++n) \
            asm volatile("v_mfma_scale_f32_16x16x128_f8f6f4 %0, %1, %2, %0, %3, %3 op_sel_hi:[0,0,0]" : "+v"(acc[ai][bj][m][n]) : "v"(Bt##8[n]), "v"(At##8[m]), "v"(one_scale)); } \
        else { _Pragma("unroll") for (int m = 0; m < 4; ++m) _Pragma("unroll") for (int n = 0; n < 2; ++n) _Pragma("unroll") for (int k = 0; k < 2; ++k) \
            acc[ai][bj][m][n] = __builtin_amdgcn_mfma_f32_16x16x32_bf16(Bt[n][k], At[m][k], acc[ai][bj][m][n], 0, 0, 0); } \
        __builtin_amdgcn_s_setprio(0); } while (0)
#define PG8_WAIT_V(n) asm volatile("s_waitcnt vmcnt(" #n ")" ::: "memory")
#define PG8_WAIT_L(n) asm volatile("s_waitcnt lgkmcnt(" #n ")" ::: "memory")
#define PG8_BAR __builtin_amdgcn_s_barrier()
#define PG8_SCHED __builtin_amdgcn_sched_barrier(0)
    Unit cur, nxt; int ui = 0;
    if (!S.next(0, cur)) return;
    float zero_; asm volatile("v_mov_b32 %0, 0" : "=v"(zero_));
    f32x4 acc[2][2][4][2];
#pragma unroll
    for (int a = 0; a < 2; ++a)
#pragma unroll
        for (int b = 0; b < 2; ++b)
#pragma unroll
            for (int m = 0; m < 4; ++m)
#pragma unroll
                for (int n = 0; n < 2; ++n) acc[a][b][m][n] = (f32x4){0.f, 0.f, 0.f, 0.f};
    const int one_scale = 0x7F7F7F7F; (void)one_scale;
    const char* cA = (const char*)g.A + (size_t)cur.pm * tstep; const char* cB = (const char*)g.Bt + S.boff(cur) + (size_t)cur.pn * tstep;
    S.a_ready(cur);
    if constexpr (SP2) {
        PG8_STAGE(PG8_SB(0, 0), cB, voffB); PG8_STAGE(PG8_SB(0, 1), cB + hstep, voffB); PG8_STAGE(PG8_SA(0, 0), cA, voffA); PG8_STAGE(PG8_SA(0, 1), cA + hstep, voffA);
        if (wr == 1) PG8_BAR;
        PG8_WAIT_V(2); PG8_BAR;
        PG8_STAGE(PG8_SB(1, 0), cB + kstep, voffB); PG8_STAGE(PG8_SA(1, 0), cA + kstep, voffA); PG8_STAGE(PG8_SB(1, 1), cB + hstep + kstep, voffB);
        PG8_WAIT_V(6); PG8_BAR;
    } else {
        PG8_STAGE(PG8_SB(0, 0), cB, voffB); PG8_STAGE(PG8_SA(0, 0), cA, voffA); PG8_STAGE(PG8_SB(0, 1), cB + hstep, voffB); PG8_STAGE(PG8_SA(0, 1), cA + hstep, voffA);
        if (wr == 1) PG8_BAR;
        PG8_WAIT_V(4); PG8_BAR;
        PG8_STAGE(PG8_SB(1, 0), cB + kstep, voffB); PG8_STAGE(PG8_SA(1, 0), cA + kstep, voffA); PG8_STAGE(PG8_SB(1, 1), cB + hstep + kstep, voffB);
        PG8_WAIT_V(6); PG8_BAR;
    }
    for (;;) {
        const bool has_next = S.next(ui + 1, nxt);
        const char* nA = has_next ? (const char*)g.A + (size_t)nxt.pm * tstep : cA; const char* nB = has_next ? (const char*)g.Bt + S.boff(nxt) + (size_t)nxt.pn * tstep : cB;
#pragma nounroll
        for (int t = 0; t < nt; t += 2) {
            bf16x8 At[4][2], B0[2][2], B1[2][2]; v8i_t At8[4], B08[2], B18[2];
            const bool last = (t == nt - 2);
            const char* a1 = cA + (size_t)(t + 1) * kstep;
            const char* a2 = last ? nA : cA + (size_t)(t + 2) * kstep; const char* b2 = last ? nB : cB + (size_t)(t + 2) * kstep;
            const char* a3 = a2 + kstep; const char* b3 = b2 + kstep;
            if (last && has_next) S.a_ready(nxt);
            if (last) { const int tl_ = wid * 64 + (int)__builtin_amdgcn_mbcnt_hi(~0u, __builtin_amdgcn_mbcnt_lo(~0u, 0u)); E.touch(lds, cur, tl_); PG8_SCHED; }
            if constexpr (SP2) {
            PG8_LDB(B0, 0, 0); PG8_LDB(B1, 0, 1); PG8_SCHED; PG8_LDA(At, 0, 0); PG8_STAGE(PG8_SA(1, 1), a1 + hstep, voffA);
            PG8_WAIT_V(8); PG8_WAIT_L(0); PG8_BAR; PG8_MMA(0, 0, At, B0); PG8_MMA(0, 1, At, B1); PG8_BAR; PG8_SCHED;
            PG8_LDA(At, 0, 1); PG8_STAGE(PG8_SB(0, 0), b2, voffB); PG8_STAGE(PG8_SB(0, 1), b2 + hstep, voffB); PG8_STAGE(PG8_SA(0, 0), a2, voffA);
            PG8_WAIT_V(8); PG8_WAIT_L(0); PG8_BAR; PG8_MMA(1, 0, At, B0); PG8_MMA(1, 1, At, B1); PG8_BAR; PG8_SCHED;
            PG8_LDB(B0, 1, 0); PG8_LDB(B1, 1, 1); PG8_SCHED; PG8_LDA(At, 1, 0); PG8_STAGE(PG8_SA(0, 1), a2 + hstep, voffA);
            PG8_WAIT_V(8); PG8_WAIT_L(0); PG8_BAR; PG8_MMA(0, 0, At, B0); PG8_MMA(0, 1, At, B1); PG8_BAR; PG8_SCHED;
            PG8_LDA(At, 1, 1); PG8_STAGE(PG8_SB(1, 0), b3, voffB); PG8_STAGE(PG8_SB(1, 1), b3 + hstep, voffB); PG8_STAGE(PG8_SA(1, 0), a3, voffA);
            PG8_WAIT_V(8); PG8_WAIT_L(0); PG8_BAR; PG8_MMA(1, 0, At, B0); PG8_MMA(1, 1, At, B1); PG8_BAR; PG8_SCHED;
            } else {
            PG8_LDB(B0, 0, 0); PG8_SCHED; PG8_LDA(At, 0, 0); PG8_STAGE(PG8_SA(1, 1), a1 + hstep, voffA);
            PG8_WAIT_L(8); PG8_BAR; PG8_WAIT_L(0); PG8_MMA(0, 0, At, B0); PG8_BAR; PG8_SCHED;
            PG8_LDB(B1, 0, 1); PG8_STAGE(PG8_SB(0, 0), b2, voffB);
            PG8_BAR; PG8_WAIT_L(0); PG8_MMA(0, 1, At, B1); PG8_BAR;
            PG8_LDA(At, 0, 1); PG8_STAGE(PG8_SA(0, 0), a2, voffA);
            PG8_BAR; PG8_WAIT_L(0); PG8_MMA(1, 0, At, B0); PG8_BAR; PG8_SCHED;
            PG8_STAGE(PG8_SB(0, 1), b2 + hstep, voffB);
            PG8_WAIT_V(6); PG8_BAR; PG8_MMA(1, 1, At, B1); PG8_BAR;
            PG8_LDB(B0, 1, 0); PG8_SCHED; PG8_LDA(At, 1, 0); PG8_STAGE(PG8_SA(0, 1), a2 + hstep, voffA);
            PG8_WAIT_L(8); PG8_BAR; PG8_WAIT_L(0); PG8_MMA(0, 0, At, B0); PG8_BAR; PG8_SCHED;
            PG8_LDB(B1, 1, 1); PG8_STAGE(PG8_SB(1, 0), b3, voffB);
            PG8_BAR; PG8_WAIT_L(0); PG8_MMA(0, 1, At, B1); PG8_BAR;
            PG8_LDA(At, 1, 1); PG8_STAGE(PG8_SA(1, 0), a3, voffA);
            PG8_BAR; PG8_WAIT_L(0); PG8_MMA(1, 0, At, B0); PG8_BAR; PG8_SCHED;
            PG8_STAGE(PG8_SB(1, 1), b3 + hstep, voffB);
            PG8_WAIT_V(6); PG8_BAR; PG8_MMA(1, 1, At, B1); PG8_BAR;
            }
        }
        if constexpr (F8) {
            asm volatile("s_nop 7\n\ts_nop 7" ::: "memory");
#pragma unroll
            for (int a_ = 0; a_ < 2; ++a_)
#pragma unroll
                for (int b_ = 0; b_ < 2; ++b_) asm volatile("" : "+v"(acc[a_][b_][0][0]), "+v"(acc[a_][b_][0][1]), "+v"(acc[a_][b_][1][0]), "+v"(acc[a_][b_][1][1]), "+v"(acc[a_][b_][2][0]), "+v"(acc[a_][b_][2][1]), "+v"(acc[a_][b_][3][0]), "+v"(acc[a_][b_][3][1]));
        }
        if constexpr (ALIGN_EPI) { if (wr == 0) PG8_BAR; }
        if constexpr (!Epi::AFTER_DRAIN) { E(acc, cur, wr, wc, fr, fq); if (REPEAT == 13 && Epi::PROBE2) { asm volatile("" ::: "memory"); E(acc, cur, wr, wc, fr, fq); } S.done(cur); }
        if (!has_next) break;
#pragma unroll
        for (int a = 0; a < 2; ++a)
#pragma unroll
            for (int b = 0; b < 2; ++b)
#pragma unroll
                for (int m = 0; m < 4; ++m)
#pragma unroll
                    for (int n = 0; n < 2; ++n) acc[a][b][m][n] = (f32x4){0.f, 0.f, 0.f, 0.f};
        cur = nxt; cA = nA; cB = nB; ++ui;
        if constexpr (ALIGN_EPI) { if (wr == 1) PG8_BAR; }
    }
    PG8_WAIT_V(0);
    if constexpr (!ALIGN_EPI) { if (wr == 0) PG8_BAR; }
    PG8_BAR;
    if constexpr (Epi::AFTER_DRAIN) { E.fused(acc, cur, wr, wc, fr, fq, lds, wid, lane); S.done(cur); }
#undef PG8_SA
#undef PG8_SB
#undef PG8_STAGE
#undef PG8_LDA
#undef PG8_LD16
#undef PG8_LDB
#undef PG8_MMA
#undef PG8_WAIT_V
#undef PG8_WAIT_L
#undef PG8_BAR
#undef PG8_SCHED
}
}


namespace att {
typedef short bf16x8 __attribute__((ext_vector_type(8)));
typedef short s16x4 __attribute__((ext_vector_type(4)));
typedef float f32x16 __attribute__((ext_vector_type(16)));
typedef unsigned u32x4 __attribute__((ext_vector_type(4)));
#define ATT_LAS __attribute__((address_space(3)))
#define SBAR() __builtin_amdgcn_sched_barrier(0)
constexpr int L_V = 0, L_K = 32768, L_KM = 49152, L_WS = 102400;
constexpr int KP_MLA = 400, KT_MLA = 64 * KP_MLA;
constexpr int KP_SB = 272, KT_SB = 64 * KP_SB;
static_assert(L_KM + 2 * KT_MLA <= L_WS && L_K + 2 * KT_SB <= L_WS && L_WS + 8 * 256 <= 131072, "attention LDS map");
constexpr float THR2 = 11.5f;

__device__ __forceinline__ int crow(int r, int hi) { return (r & 3) + 8 * (r >> 2) + 4 * hi; }
__device__ __forceinline__ unsigned cvtpk(float lo, float hi) { unsigned r; asm volatile("v_cvt_pk_bf16_f32 %0, %1, %2" : "=v"(r) : "v"(lo), "v"(hi)); return r; }
__device__ __forceinline__ int v_st(int k, int c) { const int kk = (k & ~0xC) | ((k & 4) << 1) | ((k & 8) >> 1); return ((kk >> 3) * 4 + (c >> 5)) * 512 + ((kk & 7) * 32 + (c & 31)) * 2; }
__device__ __forceinline__ int v_rd_base(int lane) { return ((lane & 3) << 3) | (((lane >> 2) & 3) << 6) | (((lane >> 4) & 1) << 5) | (((lane >> 5) & 1) << 8); }
constexpr int v_rd_off(int d0, int ks, int half) { return d0 * 512 + ks * 4096 + half * 2048; }
template <int OFF> __device__ __forceinline__ s16x4 tr_read(int vb) { s16x4 r; asm volatile("ds_read_b64_tr_b16 %0, %1 offset:%2" : "=&v"(r) : "v"(vb), "i"(OFF) : "memory"); return r; }
template <int D0> __device__ __forceinline__ void pv_one(f32x16& od, int vb, bf16x8 pa0, bf16x8 pa1, bf16x8 pa2, bf16x8 pa3) {
    const s16x4 l0 = tr_read<v_rd_off(D0, 0, 0)>(vb), h0 = tr_read<v_rd_off(D0, 0, 1)>(vb), l1 = tr_read<v_rd_off(D0, 1, 0)>(vb), h1 = tr_read<v_rd_off(D0, 1, 1)>(vb);
    const s16x4 l2 = tr_read<v_rd_off(D0, 2, 0)>(vb), h2 = tr_read<v_rd_off(D0, 2, 1)>(vb), l3 = tr_read<v_rd_off(D0, 3, 0)>(vb), h3 = tr_read<v_rd_off(D0, 3, 1)>(vb);
    asm volatile("s_waitcnt lgkmcnt(0)" ::: "memory"); SBAR();
#define ATT_PK(L, H) (bf16x8){L[0], L[1], L[2], L[3], H[0], H[1], H[2], H[3]}
    od = __builtin_amdgcn_mfma_f32_32x32x16_bf16(pa0, ATT_PK(l0, h0), od, 0, 0, 0);
    od = __builtin_amdgcn_mfma_f32_32x32x16_bf16(pa1, ATT_PK(l1, h1), od, 0, 0, 0);
    od = __builtin_amdgcn_mfma_f32_32x32x16_bf16(pa2, ATT_PK(l2, h2), od, 0, 0, 0);
    od = __builtin_amdgcn_mfma_f32_32x32x16_bf16(pa3, ATT_PK(l3, h3), od, 0, 0, 0);
#undef ATT_PK
}
__device__ __forceinline__ void pv_d0(f32x16* o, int vb, bf16x8 pa0, bf16x8 pa1, bf16x8 pa2, bf16x8 pa3) {
    pv_one<0>(o[0], vb, pa0, pa1, pa2, pa3); pv_one<1>(o[1], vb, pa0, pa1, pa2, pa3); pv_one<2>(o[2], vb, pa0, pa1, pa2, pa3); pv_one<3>(o[3], vb, pa0, pa1, pa2, pa3);
}
template <int ND0, int PITCH> __device__ __forceinline__ void qkt(f32x16& p0, f32x16& p1, const ATT_LAS char* Kt, const bf16x8* qr, int r32, int hi) {
    p0 = f32x16{}; p1 = f32x16{};
    const ATT_LAS char* kb = Kt + r32 * PITCH + hi * 16;
#pragma unroll
    for (int d0 = 0; d0 < ND0; ++d0) {
        const bf16x8 b0 = *(const ATT_LAS bf16x8*)(kb + d0 * 32), b1 = *(const ATT_LAS bf16x8*)(kb + 32 * PITCH + d0 * 32);
        p0 = __builtin_amdgcn_mfma_f32_32x32x16_bf16(b0, qr[d0], p0, 0, 0, 0);
        p1 = __builtin_amdgcn_mfma_f32_32x32x16_bf16(b1, qr[d0], p1, 0, 0, 0); }
}
__device__ __forceinline__ void pack_p(const f32x16& p0, const f32x16& p1, bf16x8& pa0, bf16x8& pa1, bf16x8& pa2, bf16x8& pa3) {
#define ATT_PK4(P, BASE, OUT) do { unsigned a0 = cvtpk(P[BASE + 0], P[BASE + 1]), a1 = cvtpk(P[BASE + 2], P[BASE + 3]);   \
    unsigned b0 = cvtpk(P[BASE + 4], P[BASE + 5]), b1 = cvtpk(P[BASE + 6], P[BASE + 7]);                              \
    auto r0 = __builtin_amdgcn_permlane32_swap(a0, b0, false, false); auto r1 = __builtin_amdgcn_permlane32_swap(a1, b1, false, false); \
    u32x4 w = {r0[0], r1[0], r0[1], r1[1]}; OUT = *reinterpret_cast<bf16x8*>(&w); } while (0)
    ATT_PK4(p0, 0, pa0); ATT_PK4(p0, 8, pa1); ATT_PK4(p1, 0, pa2); ATT_PK4(p1, 8, pa3);
#undef ATT_PK4
}
__device__ __forceinline__ void softmax_tile(f32x16& p0, f32x16& p1, float& m_reg, float& l_reg, float& alpha) {
    float pmax = p0[0];
#pragma unroll
    for (int r = 1; r < 16; ++r) pmax = fmaxf(pmax, p0[r]);
#pragma unroll
    for (int r = 0; r < 16; ++r) pmax = fmaxf(pmax, p1[r]);
    { auto rr = __builtin_amdgcn_permlane32_swap(__float_as_uint(pmax), __float_as_uint(pmax), false, false); pmax = fmaxf(__uint_as_float(rr[0]), __uint_as_float(rr[1])); }
    float mn;
    if (__builtin_expect(__all(pmax - m_reg <= THR2), 1)) { mn = m_reg; alpha = 1.f; }
    else { mn = fmaxf(m_reg, pmax); alpha = __builtin_amdgcn_exp2f(m_reg - mn); m_reg = mn; }
    float ps = 0.f;
#pragma unroll
    for (int r = 0; r < 16; ++r) { p0[r] = __builtin_amdgcn_exp2f(p0[r] - mn); ps += p0[r]; }
#pragma unroll
    for (int r = 0; r < 16; ++r) { p1[r] = __builtin_amdgcn_exp2f(p1[r] - mn); ps += p1[r]; }
    { auto rr = __builtin_amdgcn_permlane32_swap(__float_as_uint(ps), __float_as_uint(ps), false, false); ps = __uint_as_float(rr[0]) + __uint_as_float(rr[1]); }
    l_reg = l_reg * alpha + ps;
}

__device__ __forceinline__ void mla_smpv(f32x16& p0, f32x16& p1, float& m_reg, float& l_reg, f32x16 (&o)[4], ATT_LAS float* al_l, int r32, int hi, int vb) {
    float alpha; softmax_tile(p0, p1, m_reg, l_reg, alpha);
    if (__any(alpha < 1.f)) { if (hi == 0) al_l[r32] = alpha; asm volatile("s_waitcnt lgkmcnt(0)" ::: "memory");
#pragma unroll
        for (int d = 0; d < 4; ++d)
#pragma unroll
            for (int r = 0; r < 16; ++r) o[d][r] *= al_l[crow(r, hi)]; }
    bf16x8 pa0, pa1, pa2, pa3; pack_p(p0, p1, pa0, pa1, pa2, pa3); SBAR();
    pv_d0(o, vb, pa0, pa1, pa2, pa3);
}
__device__ __forceinline__ void store_o_tile(ATT_LAS char* stg, const f32x16 (&o)[4], const float* rl, bf16* Orow0, int lane, int r32, int hi) {
#pragma unroll
    for (int r = 0; r < 16; ++r) { const float sc = rl ? rl[r] : 1.0f; ATT_LAS char* rp = stg + crow(r, hi) * 272 + r32 * 2;
#pragma unroll
        for (int d0 = 0; d0 < 4; ++d0) *(ATT_LAS unsigned short*)(rp + d0 * 64) = (unsigned short)(cvtpk(o[d0][r] * sc, 0.f) & 0xffffu); }
    asm volatile("s_waitcnt lgkmcnt(0)" ::: "memory");
#pragma unroll
    for (int i = 0; i < 8; ++i) { const int q = lane + 64 * i, row = q >> 4, c16 = q & 15;
        const u32x4 v = *(const ATT_LAS u32x4*)(stg + row * 272 + c16 * 16);
        *(u32x4*)(Orow0 + (size_t)row * 1024 + c16 * 8) = v; }
    asm volatile("s_waitcnt lgkmcnt(0)" ::: "memory");
}
__device__ __forceinline__ void mla_unit(ATT_LAS char* lds, const bf16* __restrict__ Q, const bf16* __restrict__ KN, const bf16* __restrict__ KR, const bf16* __restrict__ V, bf16* __restrict__ O, int b, int hd, int qb) {
    int tid_ = threadIdx.x; asm volatile("" : "+v"(tid_));
    const int tid = tid_, wid = __builtin_amdgcn_readfirstlane(tid >> 6), lane = tid & 63, r32 = lane & 31, hi = lane >> 5;
    ATT_LAS char* Vl = lds + L_V; ATT_LAS char* Kl = lds + L_KM; ATT_LAS float* li_l = (ATT_LAS float*)(lds + L_WS) + wid * 64; ATT_LAS float* al_l = li_l + 32;
    const size_t tok0 = (size_t)b * S; const int q0 = qb * 256;
    bf16x8 qr[12];
    { const bf16* Qw = Q + (tok0 + q0 + wid * 32 + r32) * 1536 + hd * 192 + hi * 8;
#pragma unroll
      for (int d0 = 0; d0 < 12; ++d0) qr[d0] = *(const bf16x8*)(Qw + d0 * 16); }
    float m_reg = -1e30f, l_reg = 0.f; f32x16 o[4] = {};
    const int NT = 4 * qb + 4, jw = 4 * qb + (wid >> 1);
    const int sr = tid >> 4, sc = (tid & 15) * 8, vst0 = v_st(sr, sc), vst1 = v_st(32 + sr, sc);
    const bf16* vsrc = V + (tok0 + sr) * 1024 + hd * 128 + sc;
    const bf16* ksrc[3]; int kstr[3], kdst[3];
#pragma unroll
    for (int i = 0; i < 3; ++i) { const int q = tid + 512 * i, krow = q / 24, kc = q - krow * 24;
        ksrc[i] = (kc < 16) ? KN + (tok0 + krow) * 1024 + hd * 128 + kc * 8 : KR + (tok0 + krow) * 64 + (kc - 16) * 8;
        kstr[i] = (kc < 16) ? 64 * 1024 : 64 * 64; kdst[i] = krow * KP_MLA + kc * 16; }
    const int vb0 = (int)(uintptr_t)Vl + v_rd_base(lane);
    bf16x8 vs0, vs1, ks0, ks1, ks2;
#define MLA_SLOAD(j) do { vs0 = *(const bf16x8*)(vsrc + (size_t)(j) * 65536); vs1 = *(const bf16x8*)(vsrc + (size_t)(j) * 65536 + 32 * 1024); \
        ks0 = *(const bf16x8*)(ksrc[0] + (size_t)(j) * kstr[0]); ks1 = *(const bf16x8*)(ksrc[1] + (size_t)(j) * kstr[1]); ks2 = *(const bf16x8*)(ksrc[2] + (size_t)(j) * kstr[2]); } while (0)
#define MLA_SWRITE(kb, vbf) do { *(ATT_LAS bf16x8*)(Vl + (vbf) * 16384 + vst0) = vs0; *(ATT_LAS bf16x8*)(Vl + (vbf) * 16384 + vst1) = vs1; \
        *(ATT_LAS bf16x8*)(Kl + (kb) * KT_MLA + kdst[0]) = ks0; *(ATT_LAS bf16x8*)(Kl + (kb) * KT_MLA + kdst[1]) = ks1; *(ATT_LAS bf16x8*)(Kl + (kb) * KT_MLA + kdst[2]) = ks2; } while (0)
    const bool late = wid >= 4;
    f32x16 p0 = {}, p1 = {};
#define MLA_SMPV(vbuf) mla_smpv(p0, p1, m_reg, l_reg, o, al_l, r32, hi, vb0 + (vbuf) * 16384)
    MLA_SLOAD(0); asm volatile("s_waitcnt vmcnt(0)" ::: "memory"); MLA_SWRITE(0, 0); __syncthreads();
    int vcur = 0;
    for (int j = 0; j < NT; ++j) {
        const int cur = j & 1, vprev = (vcur == 0) ? 2 : vcur - 1, vnext = (vcur == 2) ? 0 : vcur + 1;
        if (j + 1 < NT) MLA_SLOAD(j + 1);
        if (!late && j <= jw) qkt<12, KP_MLA>(p0, p1, Kl + cur * KT_MLA, qr, r32, hi);
        SBAR();
        if (late ? (j >= 1 && j - 1 <= jw) : (j <= jw)) MLA_SMPV(late ? vprev : vcur);
        SBAR();
        if (late && j <= jw) { int r32b = r32; asm volatile("" : "+v"(r32b)); qkt<12, KP_MLA>(p0, p1, Kl + cur * KT_MLA, qr, r32b, hi); }
        if (j + 1 < NT) { asm volatile("s_waitcnt vmcnt(0)" ::: "memory"); MLA_SWRITE(cur ^ 1, vnext); }
        __syncthreads();
        vcur = vnext;
    }
    if (late && NT - 1 <= jw) { const int vlast = (vcur == 0) ? 2 : vcur - 1; MLA_SMPV(vlast); }
    __syncthreads();
#undef MLA_SMPV
#undef MLA_SLOAD
#undef MLA_SWRITE
    if (hi == 0) li_l[r32] = l_reg; asm volatile("s_waitcnt lgkmcnt(0)" ::: "memory");
    bf16* Ow = O + (tok0 + q0 + wid * 32) * 1024 + hd * 128 + r32;
#pragma unroll
    for (int r = 0; r < 16; ++r) { const float rl = __builtin_amdgcn_rcpf(li_l[crow(r, hi)]); const int orow = crow(r, hi);
#pragma unroll
        for (int d0 = 0; d0 < 4; ++d0) Ow[(size_t)orow * 1024 + d0 * 32] = (bf16)(cvtpk(o[d0][r] * rl, 0.f) & 0xffffu); }
}

typedef int v8i __attribute__((ext_vector_type(8)));
typedef int v4i __attribute__((ext_vector_type(4)));
constexpr int L8_K = 0, L8_V = 3 * 13312;
static_assert(L8_V + 3 * 10240 <= L_WS, "fp8 MLA LDS map");
#define MFMA8_32(accv, A, B) asm volatile("s_nop 4\n\tv_mfma_scale_f32_32x32x64_f8f6f4 %0, %1, %2, %0, %3, %3 op_sel_hi:[0,0,0]" : "+v"(accv) : "v"(A), "v"(B), "v"(one_scale))
#define MFMA8_32_Z(accv, A, B) asm volatile("s_nop 4\n\tv_mfma_scale_f32_32x32x64_f8f6f4 %0, %1, %2, 0, %3, %3 op_sel_hi:[0,0,0]" : "=&v"(accv) : "v"(A), "v"(B), "v"(one_scale))
#define MFMA8_32_LAST(accv, A, B) asm volatile("s_nop 1\n\tv_mfma_scale_f32_32x32x64_f8f6f4 %0, %1, %2, %0, %3, %3 op_sel_hi:[0,0,0]\n\ts_nop 15\n\ts_nop 15" : "+v"(accv) : "v"(A), "v"(B), "v"(one_scale))
__device__ __forceinline__ v8i ld32(const ATT_LAS char* p) { const v4i a = *(const ATT_LAS v4i*)p, b = *(const ATT_LAS v4i*)(p + 16); return __builtin_shufflevector(a, b, 0, 1, 2, 3, 4, 5, 6, 7); }
__device__ __forceinline__ unsigned pk4f8(float a, float b, float c, float d) { int w = __builtin_amdgcn_cvt_pk_fp8_f32(a, b, 0, false); w = __builtin_amdgcn_cvt_pk_fp8_f32(c, d, w, true); return (unsigned)w; }
__device__ __forceinline__ void softmax_tile8(f32x16& p0, f32x16& p1, float& m_reg, float& l_reg, float& alpha) {
    float pmax = p0[0];
#pragma unroll
    for (int r = 1; r < 16; ++r) pmax = fmaxf(pmax, p0[r]);
#pragma unroll
    for (int r = 0; r < 16; ++r) pmax = fmaxf(pmax, p1[r]);
    { auto rr = __builtin_amdgcn_permlane32_swap(__float_as_uint(pmax), __float_as_uint(pmax), false, false); pmax = fmaxf(__uint_as_float(rr[0]), __uint_as_float(rr[1])); }
    float mn;
    if (__builtin_expect(__all(pmax - m_reg <= 128.f), 1)) { mn = m_reg; alpha = 1.f; }
    else { mn = fmaxf(m_reg, pmax); alpha = __builtin_amdgcn_exp2f((m_reg - mn) * 0.0625f); m_reg = mn; }
    float ps = 0.f; const float mb = mn * 0.0625f;
#pragma unroll
    for (int r = 0; r < 16; ++r) { p0[r] = __builtin_amdgcn_exp2f(p0[r] * 0.0625f - mb); ps += p0[r]; }
#pragma unroll
    for (int r = 0; r < 16; ++r) { p1[r] = __builtin_amdgcn_exp2f(p1[r] * 0.0625f - mb); ps += p1[r]; }
    { auto rr = __builtin_amdgcn_permlane32_swap(__float_as_uint(ps), __float_as_uint(ps), false, false); ps = __uint_as_float(rr[0]) + __uint_as_float(rr[1]); }
    l_reg = l_reg * alpha + ps;
}
__device__ __forceinline__ void mla8_unit(ATT_LAS char* lds, const unsigned char* __restrict__ Q8, const unsigned char* __restrict__ K8T, const unsigned char* __restrict__ VT8T, bf16* __restrict__ O, int b, int hd, int qb) {
    int tid_ = threadIdx.x; asm volatile("" : "+v"(tid_));
    const int tid = tid_, wid = __builtin_amdgcn_readfirstlane(tid >> 6), lane = tid & 63, r32 = lane & 31, hi = lane >> 5;
    ATT_LAS char* Kl = lds + L8_K; ATT_LAS char* Vl = lds + L8_V; ATT_LAS float* li_l = (ATT_LAS float*)(lds + L_WS) + wid * 64; ATT_LAS float* al_l = li_l + 32;
    const size_t tok0 = (size_t)b * S; const int q0 = qb * 256;
    const int one_scale = 0x7F7F7F7F;
    v8i qr[3];
    { const unsigned char* Qw = Q8 + (tok0 + q0 + wid * 32 + r32) * 1536 + hd * 192 + hi * 32;
#pragma unroll
      for (int d = 0; d < 3; ++d) { const v4i a = *(const v4i*)(Qw + 64 * d), c = *(const v4i*)(Qw + 64 * d + 16); qr[d] = __builtin_shufflevector(a, c, 0, 1, 2, 3, 4, 5, 6, 7); } }
    float m_reg = -1e30f, l_reg = 0.f; f32x16 o[4] = {};
    const int NT = 4 * qb + 4, jw = 4 * qb + (wid >> 1);
    if (wid >= 4) __builtin_amdgcn_s_setprio(1);
    const unsigned char* kt = K8T + (size_t)((b * 8 + hd) * 64) * 13312 + lane * 16;
    const unsigned char* vt = VT8T + (size_t)((b * 8 + hd) * 64) * 10240 + lane * 16;
#define M8_DMA(j, slot) do { _Pragma("unroll") for (int i_ = 0; i_ < 3; ++i_) { int p_ = wid + 8 * i_; p_ = p_ > 22 ? 22 : p_; \
        if (p_ < 13) __builtin_amdgcn_global_load_lds((const unsigned*)(kt + (size_t)(j) * 13312 + p_ * 1024), (ATT_LAS unsigned*)(Kl + (slot) * 13312 + p_ * 1024), 16, 0, 0); \
        else __builtin_amdgcn_global_load_lds((const unsigned*)(vt + (size_t)(j) * 10240 + (p_ - 13) * 1024), (ATT_LAS unsigned*)(Vl + (slot) * 10240 + (p_ - 13) * 1024), 16, 0, 0); } } while (0)
    M8_DMA(0, 0); M8_DMA(1, 1);
    int slot = 0;
    for (int j = 0; j < NT; ++j) {
        if (j + 1 < NT) asm volatile("s_waitcnt vmcnt(3)" ::: "memory"); else asm volatile("s_waitcnt vmcnt(0)" ::: "memory");
        __builtin_amdgcn_s_barrier(); asm volatile("" ::: "memory");
        const int s2 = (slot == 0) ? 2 : slot - 1;
        if (j + 2 < NT) M8_DMA(j + 2, s2);
        if (j <= jw) {
            f32x16 p0, p1;
            const ATT_LAS char* kb = Kl + slot * 13312 + r32 * 208 + hi * 32;
            const ATT_LAS char* vbp = Vl + slot * 10240 + r32 * 80 + hi * 32;
            v8i ka[3], kc[3], vf[4];
#pragma unroll
            for (int d = 0; d < 3; ++d) { ka[d] = ld32(kb + 64 * d); kc[d] = ld32(kb + 32 * 208 + 64 * d); }
            MFMA8_32_Z(p0, ka[0], qr[0]); MFMA8_32_Z(p1, kc[0], qr[0]);
#pragma unroll
            for (int d = 1; d < 3; ++d) { MFMA8_32(p0, ka[d], qr[d]); MFMA8_32(p1, kc[d], qr[d]); }
#pragma unroll
            for (int d0 = 0; d0 < 4; ++d0) vf[d0] = ld32(vbp + d0 * 32 * 80);
            asm volatile("s_nop 15\n\ts_nop 15" : "+v"(p0), "+v"(p1));
            float alpha; softmax_tile8(p0, p1, m_reg, l_reg, alpha);
            if (__any(alpha < 1.f)) { if (hi == 0) al_l[r32] = alpha; asm volatile("s_waitcnt lgkmcnt(0)" ::: "memory");
#pragma unroll
                for (int d = 0; d < 4; ++d)
#pragma unroll
                    for (int r = 0; r < 16; ++r) o[d][r] *= al_l[crow(r, hi)]; }
            v8i pf;
#pragma unroll
            for (int g = 0; g < 4; ++g) { const unsigned ag = pk4f8(p0[4 * g], p0[4 * g + 1], p0[4 * g + 2], p0[4 * g + 3]), bg = pk4f8(p1[4 * g], p1[4 * g + 1], p1[4 * g + 2], p1[4 * g + 3]);
                auto rr = __builtin_amdgcn_permlane32_swap(ag, bg, false, false); pf[2 * g] = (int)rr[0]; pf[2 * g + 1] = (int)rr[1]; }
#pragma unroll
            for (int d0 = 0; d0 < 4; ++d0) MFMA8_32(o[d0], pf, vf[d0]);
            asm volatile("s_nop 15\n\ts_nop 15" : "+v"(o[0]), "+v"(o[1]), "+v"(o[2]), "+v"(o[3]));
        }
        slot = (slot == 2) ? 0 : slot + 1;
    }
#undef M8_DMA
    __builtin_amdgcn_s_setprio(0);
    __builtin_amdgcn_s_barrier(); asm volatile("" ::: "memory");
    if (hi == 0) li_l[r32] = l_reg; asm volatile("s_waitcnt lgkmcnt(0)" ::: "memory");
    float rl[16];
#pragma unroll
    for (int r = 0; r < 16; ++r) rl[r] = __builtin_amdgcn_rcpf(li_l[crow(r, hi)]);
    store_o_tile(lds + wid * 8704, o, rl, O + (tok0 + q0 + wid * 32) * 1024 + hd * 128, lane, r32, hi);
    __builtin_amdgcn_s_barrier(); asm volatile("" ::: "memory");
}

__device__ __forceinline__ void sb_unit(ATT_LAS char* lds, volatile ATT_LAS unsigned* done, unsigned seq, const bf16* __restrict__ Q, const bf16* __restrict__ K, const bf16* __restrict__ V, bf16* __restrict__ O, int b, int hd, int qb) {
    int tid_ = threadIdx.x; asm volatile("" : "+v"(tid_));
    const int tid = tid_, wid = __builtin_amdgcn_readfirstlane(tid >> 6), lane = tid & 63, r32 = lane & 31, hi = lane >> 5;
    ATT_LAS char* Vl = lds + L_V; ATT_LAS char* Kl = lds + L_K;
    const size_t tok0 = (size_t)b * S; const int q0 = qb * 256;
    bf16x8 qr[8];
    { const bf16* Qw = Q + (tok0 + q0 + wid * 32 + r32) * 1024 + hd * 128 + hi * 8;
#pragma unroll
      for (int d0 = 0; d0 < 8; ++d0) qr[d0] = *(const bf16x8*)(Qw + d0 * 16); }
    float carry = 1.f; f32x16 o[4] = {}; bool wdone = false;
    if (wid >= 4) __builtin_amdgcn_s_setprio(1);
    const int NT = 4 * qb + 4, jw = 4 * qb + (wid >> 1), lim = 32 * (wid & 1) + r32;
    const int sr = tid >> 4, sc = (tid & 15) * 8, vst0 = v_st(sr, sc), vst1 = v_st(32 + sr, sc), kst0 = sr * KP_SB + sc * 2, kst1 = (32 + sr) * KP_SB + sc * 2;
    const bf16* vsrc = V + (tok0 + sr) * 1024 + hd * 128 + sc; const bf16* ksrc = K + (tok0 + sr) * 1024 + hd * 128 + sc;
    const int vb0 = (int)(uintptr_t)Vl + v_rd_base(lane);
    bf16x8 vs0, vs1, ks0, ks1;
#define SB_SLOAD(j) do { vs0 = *(const bf16x8*)(vsrc + (size_t)(j) * 65536); vs1 = *(const bf16x8*)(vsrc + (size_t)(j) * 65536 + 32 * 1024); \
        ks0 = *(const bf16x8*)(ksrc + (size_t)(j) * 65536); ks1 = *(const bf16x8*)(ksrc + (size_t)(j) * 65536 + 32 * 1024); } while (0)
#define SB_SWRITE(bf) do { *(ATT_LAS bf16x8*)(Vl + (bf) * 16384 + vst0) = vs0; *(ATT_LAS bf16x8*)(Vl + (bf) * 16384 + vst1) = vs1; \
        *(ATT_LAS bf16x8*)(Kl + (bf) * KT_SB + kst0) = ks0; *(ATT_LAS bf16x8*)(Kl + (bf) * KT_SB + kst1) = ks1; } while (0)
    SB_SLOAD(NT - 1); asm volatile("s_waitcnt vmcnt(0)" ::: "memory"); SB_SWRITE(0); __syncthreads();
    for (int it = 0; it < NT; ++it) {
        const int cur = it & 1, j = NT - 1 - it;
        if (it + 1 < NT) SB_SLOAD(j - 1);
        if (j <= jw && !wdone) {
            f32x16 p0, p1, r0, r1;
            qkt<8, KP_SB>(p0, p1, Kl + cur * KT_SB, qr, r32, hi);
#pragma unroll
            for (int r = 0; r < 16; ++r) { const float e0 = __builtin_amdgcn_exp2f(fminf(p0[r], 64.f)), e1 = __builtin_amdgcn_exp2f(fminf(p1[r], 64.f));
                r0[r] = __builtin_amdgcn_rcpf(1.0f + e0); r1[r] = __builtin_amdgcn_rcpf(1.0f + e1); p0[r] = e0 * r0[r]; p1[r] = e1 * r1[r]; }
            if (j == jw) {
#pragma unroll
                for (int r = 0; r < 16; ++r) { const int key = crow(r, hi); if (key >= lim) { r0[r] = 1.f; p0[r] = 0.f; } if (key + 32 >= lim) { r1[r] = 1.f; p1[r] = 0.f; } }
            }
            float T[8], U[8], Tp[8];
#pragma unroll
            for (int g = 0; g < 4; ++g) {
                { const float a0 = r0[4 * g], a1 = r0[4 * g + 1], a2 = r0[4 * g + 2], a3 = r0[4 * g + 3]; const float x2 = a3, x1 = x2 * a2, x0 = x1 * a1; T[g] = x0 * a0; r0[4 * g] = x0; r0[4 * g + 1] = x1; r0[4 * g + 2] = x2; r0[4 * g + 3] = 1.f; }
                { const float a0 = r1[4 * g], a1 = r1[4 * g + 1], a2 = r1[4 * g + 2], a3 = r1[4 * g + 3]; const float x2 = a3, x1 = x2 * a2, x0 = x1 * a1; T[4 + g] = x0 * a0; r1[4 * g] = x0; r1[4 * g + 1] = x1; r1[4 * g + 2] = x2; r1[4 * g + 3] = 1.f; }
            }
#pragma unroll
            for (int g = 0; g < 8; ++g) { auto rr = __builtin_amdgcn_permlane32_swap(__float_as_uint(T[g]), __float_as_uint(T[g]), false, false); const float ta = __uint_as_float(rr[0]), tb = __uint_as_float(rr[1]); U[g] = ta * tb; Tp[g] = hi ? 1.f : tb; }
            float W = carry;
#pragma unroll
            for (int g = 7; g >= 0; --g) { const float F = W * Tp[g];
                if (g >= 4) { const int q = g - 4;
#pragma unroll
                    for (int e = 0; e < 4; ++e) p1[4 * q + e] *= r1[4 * q + e] * F; }
                else {
#pragma unroll
                    for (int e = 0; e < 4; ++e) p0[4 * g + e] *= r0[4 * g + e] * F; }
                W *= U[g]; }
            carry = W;
            bf16x8 pa0, pa1, pa2, pa3; pack_p(p0, p1, pa0, pa1, pa2, pa3); SBAR();
            pv_d0(o, vb0 + cur * 16384, pa0, pa1, pa2, pa3);
            wdone = __all(carry == 0.f);
        }
        if (wdone && lane == 0) done[(it & 1) * 8 + wid] = seq;
        if (it + 1 < NT) { asm volatile("s_waitcnt vmcnt(0)" ::: "memory"); SB_SWRITE(cur ^ 1); }
        __syncthreads();
        { const unsigned dv = (lane < 8) ? done[(it & 1) * 8 + lane] : seq; if (__all(dv == seq)) break; }
    }
#undef SB_SLOAD
#undef SB_SWRITE
    __builtin_amdgcn_s_setprio(0);
    store_o_tile(lds + wid * 8704, o, nullptr, O + (tok0 + q0 + wid * 32) * 1024 + hd * 128, lane, r32, hi);
    __syncthreads();
}
__device__ __forceinline__ void unit_of(int u, int& b, int& hd, int& qb) { const int bh = (u & 255) >> 2, s = u & 3, k = u >> 8; b = bh >> 3; hd = bh & 7; qb = (k == 0) ? s : (k == 1) ? 7 - s : (k == 2) ? 8 + s : 15 - s; }
}

#define LAS __attribute__((address_space(3)))
#define GAS __attribute__((address_space(1)))
constexpr int NWAVES = 8;
constexpr int RING_BYTES = 131072, LDSCTL_OFF = RING_BYTES, LDS_BYTES = 147456; static_assert(pg8::TOUCH_SINK >= LDSCTL_OFF + 1024 && pg8::TOUCH_SINK + 256 <= LDS_BYTES, "touch sink");
constexpr int LC_PTR = 0, LC_BAR = 96, LC_SBDONE = 128;

#define XB_TMO      128
#define XB_XCNT(j)  (256  + 64 * (j))
#define XB_XSUB(j)  (1280 + 64 * (j))
#define XB_XGEN(j)  (2304 + 64 * (j))
#define XB_TOP      3328
#define XB_TOPGEN   3392
#define XCD_BAR_WORDS 3456
#define XB_SPIN_CAP (1u << 18)

__device__ __forceinline__ unsigned xb_ld(unsigned* p)              { return __hip_atomic_load(p, __ATOMIC_RELAXED, __HIP_MEMORY_SCOPE_AGENT); }
__device__ __forceinline__ unsigned xb_add(unsigned* p, unsigned v) { return __hip_atomic_fetch_add(p, v, __ATOMIC_RELAXED, __HIP_MEMORY_SCOPE_AGENT); }
__device__ __forceinline__ unsigned xb_xcc_id() { return (unsigned)__builtin_amdgcn_s_getreg((3 << 11) | 20) & 0xFu; }
#define XB_SPIN(cond, bar) do { unsigned _sp = 0; while (cond) { __builtin_amdgcn_s_sleep(1); \
    if ((++_sp & 255u) == 0u) { if (xb_ld(&(bar)[XB_TMO])) break; if (_sp > XB_SPIN_CAP) { atomicAdd(&(bar)[XB_TMO], 1u); break; } } } } while (0)

struct XcdBarrier {
    unsigned* bar; unsigned x;
    volatile LAS unsigned* st;
};

__device__ __forceinline__ XcdBarrier xcd_barrier_post(unsigned* bar, volatile LAS unsigned* st) {
    XcdBarrier b; b.bar = bar; b.x = xb_xcc_id(); b.st = st;
    if (threadIdx.x == 0) (void)xb_add(&bar[XB_XCNT(b.x)], 1u);
    return b;
}
__device__ __forceinline__ void xcd_barrier_complete(unsigned* bar, unsigned x, unsigned& nloc, unsigned& nx) {
    const unsigned G = gridDim.x * gridDim.y * gridDim.z;
    unsigned sum, cnt, mine, sp = 0u;
    for (;;) {
        sum = 0u; cnt = 0u; mine = 0u;
        unsigned cv[16];
        { const unsigned* mid = &bar[XB_XCNT(8)];
          asm volatile("global_load_dword %0, %16, off offset:-2048 sc1\n\tglobal_load_dword %1, %16, off offset:-1792 sc1\n\tglobal_load_dword %2, %16, off offset:-1536 sc1\n\tglobal_load_dword %3, %16, off offset:-1280 sc1\n\t"
                       "global_load_dword %4, %16, off offset:-1024 sc1\n\tglobal_load_dword %5, %16, off offset:-768 sc1\n\tglobal_load_dword %6, %16, off offset:-512 sc1\n\tglobal_load_dword %7, %16, off offset:-256 sc1\n\t"
                       "global_load_dword %8, %16, off sc1\n\tglobal_load_dword %9, %16, off offset:256 sc1\n\tglobal_load_dword %10, %16, off offset:512 sc1\n\tglobal_load_dword %11, %16, off offset:768 sc1\n\t"
                       "global_load_dword %12, %16, off offset:1024 sc1\n\tglobal_load_dword %13, %16, off offset:1280 sc1\n\tglobal_load_dword %14, %16, off offset:1536 sc1\n\tglobal_load_dword %15, %16, off offset:1792 sc1\n\ts_waitcnt vmcnt(0)"
                       : "=&v"(cv[0]), "=&v"(cv[1]), "=&v"(cv[2]), "=&v"(cv[3]), "=&v"(cv[4]), "=&v"(cv[5]), "=&v"(cv[6]), "=&v"(cv[7]), "=&v"(cv[8]), "=&v"(cv[9]), "=&v"(cv[10]), "=&v"(cv[11]), "=&v"(cv[12]), "=&v"(cv[13]), "=&v"(cv[14]), "=&v"(cv[15])
                       : "v"(mid) : "memory"); }
        static_assert(XB_XCNT(1) - XB_XCNT(0) == 64, "census words are 256 bytes apart");
#pragma unroll
        for (unsigned j = 0; j < 16; ++j) { const unsigned c = cv[j]; sum += c; cnt += (c > 0u) ? 1u : 0u; mine = (j == x) ? c : mine; }
        if (sum == G) break;
        __builtin_amdgcn_s_sleep(1);
        if ((++sp & 255u) == 0u) { if (xb_ld(&bar[XB_TMO])) break; if (sp > XB_SPIN_CAP) { atomicAdd(&bar[XB_TMO], 1u); break; } }
    }
    nloc = mine > 0u ? mine : 1u; nx = cnt > 0u ? cnt : 1u;
}

__device__ __forceinline__ void xcd_barrier(const XcdBarrier& b) {
    asm volatile("s_waitcnt vmcnt(0)" ::: "memory");
    __syncthreads();
    if (threadIdx.x == 0) {
        unsigned* bar = b.bar;
        __builtin_amdgcn_s_waitcnt(0);
        unsigned nloc = b.st[0], nx = b.st[1];
        if (nloc == 0u) { xcd_barrier_complete(bar, b.x, nloc, nx); b.st[0] = nloc; b.st[1] = nx; }
        const unsigned old = xb_add(&bar[XB_XSUB(b.x)], 1u);
        const unsigned gen = old / nloc;
        if (old + 1u == (gen + 1u) * nloc) {
            __builtin_amdgcn_fence(__ATOMIC_RELEASE, "agent");
            asm volatile("s_waitcnt vmcnt(0)" ::: "memory");
            const unsigned og = xb_add(&bar[XB_TOP], 1u);
            const unsigned tg = og / nx;
            if (og + 1u == (tg + 1u) * nx) xb_add(&bar[XB_TOPGEN], 1u);
            else XB_SPIN(xb_ld(&bar[XB_TOPGEN]) == tg, bar);
            __builtin_amdgcn_fence(__ATOMIC_ACQUIRE, "agent");
            xb_add(&bar[XB_XGEN(b.x)], 1u);
            asm volatile("s_waitcnt vmcnt(0)" ::: "memory");
        } else {
            XB_SPIN(xb_ld(&bar[XB_XGEN(b.x)]) == gen, bar);
            __builtin_amdgcn_fence(__ATOMIC_ACQUIRE, "agent");
            asm volatile("s_waitcnt vmcnt(0)" ::: "memory");
        }
    }
    __syncthreads();
}


constexpr int PH_PRO = 0;
__host__ __device__ constexpr int PH(int l, int k) { return 1 + l * 10 + k; }
constexpr int PH_END = PH(3, 8) + 1;

struct MatDesc { int in_idx, gain_idx, K, N, mode, rowoff; long long src_off; long long dst_off; };
constexpr long long WSM = (long long)WS_WSMALL, WMO = (long long)WS_WMOE;
constexpr long long OFF_WD0 = WSM, OFF_WUQ0 = OFF_WD0 + 768LL * 1024 * 2, OFF_WUKV0 = OFF_WUQ0 + 1536LL * 384 * 2, OFF_WO0 = OFF_WUKV0 + 2048LL * 256 * 2;
constexpr long long OFF_WD1 = OFF_WO0 + 1024LL * 1024 * 2, OFF_WUQ1 = OFF_WD1 + 768LL * 1024 * 2, OFF_WUKV1 = OFF_WUQ1 + 1536LL * 384 * 2, OFF_WO1 = OFF_WUKV1 + 2048LL * 256 * 2;
constexpr long long OFF_WGU0 = OFF_WO1 + 1024LL * 1024 * 2, OFF_WDN0 = OFF_WGU0 + 5632LL * 1024 * 2;
constexpr long long OFF_WGU2 = OFF_WDN0 + 1024LL * 2816 * 2, OFF_WDN2 = OFF_WGU2 + 5632LL * 1024 * 2;
constexpr long long OFF_WKVQ = OFF_WDN2 + 1024LL * 2816 * 2, OFF_WQ3 = OFF_WKVQ + 3072LL * 1024 * 2, OFF_WO2 = OFF_WQ3 + 1024LL * 1024 * 2, OFF_WO3 = OFF_WO2 + 1024LL * 1024 * 2;
constexpr long long OFF_WSM_END = OFF_WO3 + 1024LL * 1024 * 2;
static_assert(OFF_WSM_END <= (long long)WS_WMOE, "small weights fit");
constexpr long long MOE_GU_BYTES = 5632LL * 1024, MOE_DN_BYTES = 1024LL * 2816;
constexpr long long OFF_MGU = WMO, OFF_MDN = WMO + 8 * MOE_GU_BYTES;
constexpr int NMAT_SMALL = 18;
__device__ const MatDesc g_mats[NMAT_SMALL] = {
    {3, 2, 1024, 704, 1, 0, 0, OFF_WD0}, {5, 4, 384, 1536, 2, 0, 0, OFF_WUQ0}, {7, 6, 256, 2048, 4, 0, 0, OFF_WUKV0}, {8, -1, 1024, 1024, 0, 0, 0, OFF_WO0},
    {13, 12, 1024, 704, 1, 0, 0, OFF_WD1}, {15, 14, 384, 1536, 2, 0, 0, OFF_WUQ1}, {17, 16, 256, 2048, 4, 0, 0, OFF_WUKV1}, {18, -1, 1024, 1024, 0, 0, 0, OFF_WO1},
    {10, 9, 1024, 5632, 3, 0, 0, OFF_WGU0}, {11, -1, 2816, 1024, 0, 0, 0, OFF_WDN0},
    {29, 28, 1024, 5632, 3, 0, 0, OFF_WGU2}, {30, -1, 2816, 1024, 0, 0, 0, OFF_WDN2},
    {24, 23, 1024, 2048, 0, 0, 0, OFF_WKVQ}, {26, 25, 1024, 1024, 0, 2048, 0, OFF_WKVQ}, {32, 31, 1024, 1024, 0, 0, 0, OFF_WQ3},
    {27, -1, 1024, 1024, 0, 0, 0, OFF_WO2}, {33, -1, 1024, 1024, 0, 0, 0, OFF_WO3},
    {3, 2, 0, 0, 9, 0, 0, OFF_WD0}
};
__device__ __forceinline__ int map_row(int mode, int n) {
    if (mode == 1) { return n < 640 ? n : (n < 672 ? 640 + 2 * (n - 640) : 641 + 2 * (n - 672)); }
    if (mode == 2) { const int hd = n / 192, d = n - hd * 192; return d < 128 ? n : (d < 160 ? hd * 192 + 128 + 2 * (d - 128) : hd * 192 + 129 + 2 * (d - 160)); }
    if (mode == 4) { const int hd = n >> 8, d = n & 255; return d < 128 ? hd * 128 + d : 1024 + hd * 128 + (d - 128); }
    if (mode == 3) { if (n < 2816) return 256 * (n >> 7) + (n & 127); const int n2 = n - 2816; return 256 * (n2 >> 7) + 128 + (n2 & 127); }
    return n;
}
typedef unsigned v4u __attribute__((ext_vector_type(4)));
struct ConvJob { const float* W; const float* gain; bf16* WT; int K, N, mode, rowoff, k0, n0; int f8; float wscale; int tiled; int pad; };
constexpr int CONV_PITCH = 129, SMALL_ITEMS = 2 * (48 + 36 + 32 + 64) + 2 * (352 + 176) + 128 + 64 + 64 + 64 + 64, MOE_ITEMS_E = 352 + 176, MOE_ITEMS = NE * MOE_ITEMS_E;
__device__ __forceinline__ void conv_load(const ConvJob& J, int t, f32x4 (&v)[8], float (&gk)[8]) {
    const int lane = t & 63, wave = t >> 6, n = J.n0 + 4 * ((lane & 7) + 8 * (wave & 3)), r0 = (wave >> 2) * 8 + (lane >> 3);
#pragma unroll
    for (int i = 0; i < 8; ++i) { const int k = J.k0 + r0 + 16 * i;
        v[i] = (n < J.N) ? __builtin_nontemporal_load((const f32x4*)(J.W + (size_t)k * J.N + n)) : (f32x4){0.f, 0.f, 0.f, 0.f};
        gk[i] = (J.gain ? J.gain[k] : 1.0f) * J.wscale; }
}
__device__ __forceinline__ void conv_to_lds(LAS float* scr, int t, const f32x4 (&v)[8], const float (&gk)[8]) {
    const int lane = t & 63, wave = t >> 6, c = 4 * ((lane & 7) + 8 * (wave & 3)), r0 = (wave >> 2) * 8 + (lane >> 3);
#pragma unroll
    for (int i = 0; i < 8; ++i) { LAS float* p = scr + (r0 + 16 * i) * CONV_PITCH + c; const f32x4 x = v[i] * gk[i]; p[0] = x[0]; p[1] = x[1]; p[2] = x[2]; p[3] = x[3]; }
}
__device__ __forceinline__ void conv_store(const ConvJob& J, const LAS float* scr, int t) {
    if (J.f8) {
        const int c = t >> 6, n_l = t & 63;
#pragma unroll
        for (int jj = 0; jj < 2; ++jj) { const int n = n_l + 64 * jj;
            if (J.n0 + n < J.N) { const LAS float* sp = scr + (16 * c) * CONV_PITCH + n;
                v4u o;
                o.x = pg8::pk4_fp8_nc(sp[0 * CONV_PITCH], sp[1 * CONV_PITCH], sp[2 * CONV_PITCH], sp[3 * CONV_PITCH]); o.y = pg8::pk4_fp8_nc(sp[4 * CONV_PITCH], sp[5 * CONV_PITCH], sp[6 * CONV_PITCH], sp[7 * CONV_PITCH]);
                o.z = pg8::pk4_fp8_nc(sp[8 * CONV_PITCH], sp[9 * CONV_PITCH], sp[10 * CONV_PITCH], sp[11 * CONV_PITCH]); o.w = pg8::pk4_fp8_nc(sp[12 * CONV_PITCH], sp[13 * CONV_PITCH], sp[14 * CONV_PITCH], sp[15 * CONV_PITCH]);
                const int row = J.rowoff + map_row(J.mode, J.n0 + n), k = J.k0 + 16 * c;
                if (J.tiled) *(v4u*)((unsigned char*)J.WT + (((size_t)(row >> 8) * (J.K >> 7) + (k >> 7)) * 256 + (row & 255)) * 128 + (k & 127)) = o;
                else *(v4u*)((unsigned char*)J.WT + (size_t)row * J.K + k) = o; } }
        return;
    }
    const int c_lo = t & 7, n_l = t >> 3;
#pragma unroll
    for (int jj = 0; jj < 4; ++jj) { const int n = n_l + 64 * (jj >> 1), c = c_lo + 8 * (jj & 1);
        if (J.n0 + n < J.N) { const LAS float* sp = scr + (8 * c) * CONV_PITCH + n;
            v4u o; o.x = pk2(sp[0 * CONV_PITCH], sp[1 * CONV_PITCH]); o.y = pk2(sp[2 * CONV_PITCH], sp[3 * CONV_PITCH]); o.z = pk2(sp[4 * CONV_PITCH], sp[5 * CONV_PITCH]); o.w = pk2(sp[6 * CONV_PITCH], sp[7 * CONV_PITCH]);
            const int row = J.rowoff + map_row(J.mode, J.n0 + n), k = J.k0 + 8 * c;
            if (J.tiled) *(v4u*)(J.WT + (((size_t)(row >> 8) * (J.K >> 6) + (k >> 6)) * 256 + (row & 255)) * 64 + (k & 63)) = o;
            else *(v4u*)(J.WT + (size_t)row * J.K + k) = o; } }
}

#ifndef SITES
#define SITES 0xffff
#endif
#define SITE(n) (((SITES) >> (n)) & 1)
#ifndef REPEAT
#define REPEAT -1
#endif
#define DUMMY(k) ((REPEAT == (k)) && rep_ == 0)
#define REP(k) for (int rep_ = 0; rep_ < ((REPEAT == (k)) ? 2 : 1); ++rep_)

#define RLX_AGENT __ATOMIC_RELAXED, __HIP_MEMORY_SCOPE_AGENT
__device__ __forceinline__ void prep_row(const float* __restrict__ x, const int* __restrict__ pos, bf16* __restrict__ hb, float* __restrict__ ss, float2* __restrict__ cs, int m, int lane) {
    const f32x4* xr = (const f32x4*)(x + (size_t)m * D) + lane;
    float s = 0.f;
#pragma unroll
    for (int j = 0; j < 4; ++j) { const f32x4 v = __builtin_nontemporal_load(xr + 64 * j); s += (v.x * v.x + v.y * v.y) + (v.z * v.z + v.w * v.w);
        u32x2 o; o.x = pk2(v.x, v.y); o.y = pk2(v.z, v.w); *((u32x2*)(hb + (size_t)m * D) + lane + 64 * j) = o; }
    s = wave_sum(s);
    if (lane < 16) ss[(size_t)m * 16 + lane] = (lane == 0) ? s : 0.f;
    if (lane < 32) {
        const float inv_freq = 1.0f / powf(10000.0f, (float)(2 * lane) / 64.0f);
        const float ang = (float)pos[m] * inv_freq;
        double t = (double)ang * 0.15915494309189535; t -= floor(t);
        const float a = (float)(t * 6.283185307179586);
        cs[(size_t)m * 32 + lane] = make_float2(cosf(a), sinf(a));
    }
}
__device__ __forceinline__ void router_load(LAS float* T, const float* __restrict__ gain, const float* __restrict__ R, int tid) {
    for (int i = tid; i < 1024; i += NWAVES * 64) { const int jq = i >> 6, ln = i & 63, k = 4 * ln + 256 * (jq >> 2) + (jq & 3); const float g = gain[k];
        const f32x4 r0 = *(const f32x4*)(R + (size_t)k * NE), r1 = *(const f32x4*)(R + (size_t)k * NE + 4);
        *(LAS f32x4*)(T + (size_t)i * 8) = r0 * g; *(LAS f32x4*)(T + (size_t)i * 8 + 4) = r1 * g; }
}
__device__ __forceinline__ void route_dot4(const LAS float* T, const u32x2 (&hw)[4][4], int lane, float (&acc)[4][NE]) {
#pragma unroll
    for (int r = 0; r < 4; ++r)
#pragma unroll
        for (int e = 0; e < NE; ++e) acc[r][e] = 0.f;
#pragma unroll
    for (int j = 0; j < 4; ++j)
#pragma unroll
        for (int q = 0; q < 4; ++q) { const LAS float* tp = T + (size_t)((4 * j + q) * 64 + lane) * 8; const f32x4 w0 = *(const LAS f32x4*)tp, w1 = *(const LAS f32x4*)(tp + 4);
#pragma unroll
            for (int r = 0; r < 4; ++r) { const unsigned wd = (q < 2) ? hw[r][j].x : hw[r][j].y; const float h = (q & 1) ? bf2f(wd >> 16) : bf2f(wd);
                acc[r][0] += h * w0[0]; acc[r][1] += h * w0[1]; acc[r][2] += h * w0[2]; acc[r][3] += h * w0[3]; acc[r][4] += h * w1[0]; acc[r][5] += h * w1[1]; acc[r][6] += h * w1[2]; acc[r][7] += h * w1[3]; } }
}
__device__ __forceinline__ void route_row(const float (&acc)[NE], float rstd, int lane, int& i1, int& i2, float& g1, float& g2) {
    const bool b0 = lane & 1, b1 = lane & 2, b2 = lane & 4;
    float w4[4], x2[2], y;
#pragma unroll
    for (int i = 0; i < 4; ++i) { const float snd = b0 ? acc[i] : acc[4 + i], kp = b0 ? acc[4 + i] : acc[i]; w4[i] = kp + __shfl_xor(snd, 1); }
#pragma unroll
    for (int i = 0; i < 2; ++i) { const float snd = b1 ? w4[i] : w4[2 + i], kp = b1 ? w4[2 + i] : w4[i]; x2[i] = kp + __shfl_xor(snd, 2); }
    { const float snd = b2 ? x2[0] : x2[1], kp = b2 ? x2[1] : x2[0]; y = kp + __shfl_xor(snd, 4); }
    y += __shfl_xor(y, 8); y += __shfl_xor(y, 16); y += __shfl_xor(y, 32);
    y *= rstd;
    float lg[NE];
#pragma unroll
    for (int e = 0; e < NE; ++e) lg[e] = __uint_as_float(__builtin_amdgcn_readlane(__float_as_uint(y), (e >> 2) + 2 * ((e >> 1) & 1) + 4 * (e & 1)));
    i1 = 0; float v1 = lg[0];
#pragma unroll
    for (int e = 1; e < NE; ++e) if (lg[e] > v1) { v1 = lg[e]; i1 = e; }
    i2 = -1; float v2 = -3.0e38f;
#pragma unroll
    for (int e = 0; e < NE; ++e) if (e != i1 && lg[e] > v2) { v2 = lg[e]; i2 = e; }
    const float e2 = __expf(v2 - v1); g1 = 1.0f / (1.0f + e2); g2 = e2 / (1.0f + e2);
}
template <bool FINAL>
__device__ __forceinline__ bool combine_rows2(const bf16* hbin, bf16* hbout, float* __restrict__ outf, const bf16* __restrict__ y, const int2* __restrict__ tokslot, float* __restrict__ ss, const float* __restrict__ gfin, int m0, int m1, int lane, int thr, int pass, const int2 ta, const int2 tb) {
    { const int mx_ = max(max(ta.x, ta.y), max(tb.x, tb.y)); const bool touch = __builtin_amdgcn_readfirstlane(mx_) >= thr;
      if (touch != (pass != 0)) return false; }
    u32x2 ha[4], hc[4], ya1[4], ya2[4], yb1[4], yb2[4];
#pragma unroll
    for (int j = 0; j < 4; ++j) { ha[j] = *((const u32x2*)(hbin + (size_t)m0 * D) + lane + 64 * j); hc[j] = *((const u32x2*)(hbin + (size_t)m1 * D) + lane + 64 * j); }
#pragma unroll
    for (int j = 0; j < 4; ++j) { ya1[j] = *((const u32x2*)(y + (size_t)ta.x * D) + lane + 64 * j); ya2[j] = *((const u32x2*)(y + (size_t)ta.y * D) + lane + 64 * j);
                                  yb1[j] = *((const u32x2*)(y + (size_t)tb.x * D) + lane + 64 * j); yb2[j] = *((const u32x2*)(y + (size_t)tb.y * D) + lane + 64 * j); }
#pragma unroll
    for (int t = 0; t < 2; ++t) {
        const int m = t ? m1 : m0; f32x4 v[4]; float s = 0.f;
#pragma unroll
        for (int j = 0; j < 4; ++j) { const u32x2 hw = t ? hc[j] : ha[j], a = t ? yb1[j] : ya1[j], c = t ? yb2[j] : ya2[j];
            v[j].x = bf2f(hw.x) + (bf2f(a.x) + bf2f(c.x)); v[j].y = bf2f(hw.x >> 16) + (bf2f(a.x >> 16) + bf2f(c.x >> 16)); v[j].z = bf2f(hw.y) + (bf2f(a.y) + bf2f(c.y)); v[j].w = bf2f(hw.y >> 16) + (bf2f(a.y >> 16) + bf2f(c.y >> 16));
            s += (v[j].x * v[j].x + v[j].y * v[j].y) + (v[j].z * v[j].z + v[j].w * v[j].w); }
        s = wave_sum(s);
        if (!FINAL) {
#pragma unroll
            for (int j = 0; j < 4; ++j) { u32x2 o; o.x = pk2(v[j].x, v[j].y); o.y = pk2(v[j].z, v[j].w); *((u32x2*)(hbout + (size_t)m * D) + lane + 64 * j) = o; }
            if (lane < 16) ss[(size_t)m * 16 + lane] = (lane == 0) ? s : 0.f;
        } else {
            const float rstd = rsqrtf(s * (1.0f / D) + EPS);
#pragma unroll
            for (int j = 0; j < 4; ++j) { const f32x4 g = *((const f32x4*)gfin + lane + 64 * j); *((f32x4*)(outf + (size_t)m * D) + lane + 64 * j) = v[j] * rstd * g; }
        }
    }
    return true;
}

__device__ __forceinline__ const float* inp_ptr(volatile LAS unsigned* LC, int i) { return (const float*)(((unsigned long long)(unsigned)__builtin_amdgcn_readfirstlane(LC[LC_PTR + 2 * i + 1]) << 32) | (unsigned long long)(unsigned)__builtin_amdgcn_readfirstlane(LC[LC_PTR + 2 * i])); }
__device__ __forceinline__ ConvJob conv_job(volatile LAS unsigned* LC, unsigned char* wsl, int id, int nsmall, int moe_wg, int moe_wd, int moe_gain) {
    ConvJob J;
    if (id < nsmall) {
        int mi = 0, rem = id;
        for (; mi < NMAT_SMALL - 1; ++mi) { const int it = (g_mats[mi].K >> 7) * ((g_mats[mi].N + 127) >> 7); if (rem < it) break; rem -= it; }
        const MatDesc d = g_mats[mi]; const int nn = (d.N + 127) >> 7;
        J.W = inp_ptr(LC, d.in_idx); J.gain = d.gain_idx >= 0 ? inp_ptr(LC, d.gain_idx) : nullptr; J.WT = (bf16*)(wsl + d.dst_off); J.K = d.K; J.N = d.N; J.mode = d.mode; J.rowoff = d.rowoff; J.k0 = (rem / nn) * 128; J.n0 = (rem % nn) * 128; J.tiled = (d.K == 2816) ? 1 : 0; J.f8 = (DENSE_DN_FP8 && d.K == 2816) ? 1 : 0; J.wscale = J.f8 ? 64.0f : 1.0f; J.pad = 0;
    } else {
        const int r = id - nsmall, e = r / MOE_ITEMS_E, q = r - e * MOE_ITEMS_E;
        if (q < 352) { J.W = inp_ptr(LC, moe_wg) + (size_t)e * 1024 * 5632; J.gain = inp_ptr(LC, moe_gain); J.WT = (bf16*)(wsl + OFF_MGU + e * MOE_GU_BYTES); J.K = 1024; J.N = 5632; J.mode = 3; J.rowoff = 0; J.k0 = (q / 44) * 128; J.n0 = (q % 44) * 128; }
        else { const int q2 = q - 352; J.W = inp_ptr(LC, moe_wd) + (size_t)e * 2816 * 1024; J.gain = nullptr; J.WT = (bf16*)(wsl + OFF_MDN + e * MOE_DN_BYTES); J.K = 2816; J.N = 1024; J.mode = 0; J.rowoff = 0; J.k0 = (q2 / 8) * 128; J.n0 = (q2 % 8) * 128; }
        J.f8 = 1; J.wscale = 64.0f; J.tiled = (q >= 352) ? 1 : 0; J.pad = 0;
    }
    return J;
}
__device__ __forceinline__ void conv_run(volatile LAS unsigned* LC, LAS unsigned char* lds, unsigned char* wsl, int cb, int Gs, int t, int nsmall, int total, int moe_wg, int moe_wd, int moe_gain) {
    LAS float* scr = (LAS float*)lds;
    int id = cb; bool have = id < total; ConvJob J{}; f32x4 v[8]; float gk[8];
#pragma unroll
    for (int i = 0; i < 8; ++i) { v[i] = (f32x4){0.f, 0.f, 0.f, 0.f}; gk[i] = 0.f; }
    if (have) { J = conv_job(LC, wsl, id, nsmall, moe_wg, moe_wd, moe_gain); conv_load(J, t, v, gk); }
    while (have) {
        conv_to_lds(scr, t, v, gk);
        __syncthreads();
        const int idn = id + Gs; const bool hn = idn < total; ConvJob Jn{};
        if (hn) { Jn = conv_job(LC, wsl, idn, nsmall, moe_wg, moe_wd, moe_gain); conv_load(Jn, t, v, gk); }
        conv_store(J, scr, t);
        __syncthreads();
        J = Jn; id = idn; have = hn;
    }
}

struct Args { const void* in[39]; float* out; unsigned char* ws; int ph_lo, ph_hi; };

#define INP(i) ((const float*)(((unsigned long long)(unsigned)__builtin_amdgcn_readfirstlane(LC[LC_PTR + 2 * (i) + 1]) << 32) | (unsigned long long)(unsigned)__builtin_amdgcn_readfirstlane(LC[LC_PTR + 2 * (i)])))
#define IN(k) (lo <= (k) && (k) < hi)
#define SEAM(k) do { if ((k) + 1 < hi) xcd_barrier(bar); } while (0)
#define SITE_BEGIN() int zz_; asm volatile("s_mov_b32 %0, 0" : "=s"(zz_)); unsigned char* wsl = args.ws + zz_; float* outl = args.out + zz_; const int cb = (int)blockIdx.x + zz_, Gs = (int)gridDim.x + zz_; \
    unsigned char* R0 = wsl + WS_R0; (void)R0; (void)outl
#define SSA(i) ((float*)(wsl + WS_SS) + (size_t)(i) * M * 16)
#define CSP ((const float2*)(wsl + WS_CS))
#define HBP ((bf16*)(wsl + WS_HB))

template <int l>
__device__ __forceinline__ void layer_phases(const Args& args, LAS unsigned char* lds, volatile LAS unsigned* LC, const XcdBarrier& bar, const int lo, const int hi) {
        if (l < 2) {
            if (SITE(1) && IN(PH(l, 0))) REP(1) {
                SITE_BEGIN();
                pg8::Gemm g{HBP, (const bf16*)(wsl + (l ? OFF_WD1 : OFF_WD0)), M, 768, 1024}; pg8::StaticOrder S; S.init(M, 768, Gs, cb);
                pg8::EpiDown E{SSA(0), CSP, (bf16*)(R0 + R_CQ), (bf16*)(R0 + R_CKV), (bf16*)(R0 + R_KR), SSA(2), SSA(3), MLA_FP8 ? R0 + R_K8T : nullptr};
                pg8::gemm_phase<pg8::EpiDown, pg8::StaticOrder, true, true>(lds, g, S, E);
                SEAM(PH(l, 0));
            }
            if (SITE(2) && IN(PH(l, 1))) REP(1) {
                if (MLA_FP8) {
                    { SITE_BEGIN();
                      pg8::Gemm g{(const bf16*)(R0 + R_CQ), (const bf16*)(wsl + (l ? OFF_WUQ1 : OFF_WUQ0)), M, 1536, 384}; pg8::StaticOrder S; S.init(M, 1536, Gs, cb);
                      pg8::EpiUq8 E{SSA(2), CSP, R0 + R_Q8, C2_MLA * 16.0f, 0};
                      pg8::gemm_phase<pg8::EpiUq8, pg8::StaticOrder, true, true>(lds, g, S, E); }
                    { SITE_BEGIN();
                      pg8::Gemm g{(const bf16*)(R0 + R_CKV), (const bf16*)(wsl + (l ? OFF_WUKV1 : OFF_WUKV0)), M, 1024, 256}; pg8::StaticOrder S; S.init(M, 1024, Gs, cb);
                      pg8::EpiKn8 E{SSA(3), R0 + R_K8T};
                      pg8::gemm_phase<pg8::EpiKn8, pg8::StaticOrder, true, true>(lds, g, S, E); }
                    { SITE_BEGIN();
                      pg8::Gemm g{(const bf16*)(wsl + (l ? OFF_WUKV1 : OFF_WUKV0)) + (size_t)1024 * 256, (const bf16*)(R0 + R_CKV), 1024, M, 256}; pg8::StaticOrder S; S.init(1024, M, Gs, cb);
                      pg8::EpiVt8 E{SSA(3), R0 + R_VT8T};
                      pg8::gemm_phase<pg8::EpiVt8, pg8::StaticOrder, true, true>(lds, g, S, E); }
                } else {
                { SITE_BEGIN();
                  pg8::Gemm g{(const bf16*)(R0 + R_CQ), (const bf16*)(wsl + (l ? OFF_WUQ1 : OFF_WUQ0)), M, 1536, 384}; pg8::StaticOrder S; S.init(M, 1536, Gs, cb);
                  pg8::EpiUq E{SSA(2), CSP, (bf16*)(R0 + R_Q), C2_MLA, 0};
                  pg8::gemm_phase<pg8::EpiUq, pg8::StaticOrder, true, true>(lds, g, S, E); }
                { SITE_BEGIN();
                  pg8::Gemm g{(const bf16*)(R0 + R_CKV), (const bf16*)(wsl + (l ? OFF_WUKV1 : OFF_WUKV0)), M, 2048, 256}; pg8::StaticOrder S; S.init(M, 2048, Gs, cb);
                  pg8::EpiProj E{SSA(3), (bf16*)(R0 + R_KN), (size_t)(R_V - R_KN) / 2, 1.0f, -1, 2, 1.0f / 256.0f, 0};
                  pg8::gemm_phase<pg8::EpiProj, pg8::StaticOrder, true, true>(lds, g, S, E); }
                }
                SEAM(PH(l, 1));
            }
            if (SITE(9) && IN(PH(l, 2))) REP(2) {
                SITE_BEGIN();
                const int vcu = (Gs % 8 == 0) ? (cb % 8) * (Gs / 8) + cb / 8 : cb;
                for (int u = vcu; u < 1024; u += Gs) { int b, hd, qb; att::unit_of(u, b, hd, qb);
                    if (MLA_FP8) att::mla8_unit((ATT_LAS char*)lds, R0 + R_Q8, R0 + R_K8T, R0 + R_VT8T, (bf16*)(R0 + R_O), b, hd, qb);
                    else att::mla_unit((ATT_LAS char*)lds, (const bf16*)(R0 + R_Q), (const bf16*)(R0 + R_KN), (const bf16*)(R0 + R_KR), (const bf16*)(R0 + R_V), (bf16*)(R0 + R_O), b, hd, qb); }
                SEAM(PH(l, 2));
            }
        } else {
            static_assert(R_VS - R_KS == R_QS - R_VS, "Ks|Vs|Qs equally spaced");
            if (SITE(3) && IN(PH(l, 0))) REP(7) {
                SITE_BEGIN();
                const int N = (l == 2) ? 3072 : 1024;
                pg8::Gemm g{HBP, (const bf16*)(wsl + (l == 2 ? OFF_WKVQ : OFF_WQ3)), M, N, 1024}; pg8::StaticOrder S; S.init(M, N, Gs, cb);
                pg8::EpiProj E{SSA(0), (bf16*)(R0 + ((l == 2) ? R_KS : R_QS)), (size_t)(R_VS - R_KS) / 2, C2_SB, (l == 2) ? 2 : 0, 4, 1.0f / 1024.0f, 0};
                pg8::gemm_phase<pg8::EpiProj, pg8::StaticOrder, true, true>(lds, g, S, E);
                SEAM(PH(l, 0));
            }
            if (SITE(10) && IN(PH(l, 2))) REP(3) {
                SITE_BEGIN();
                const int vcu = (Gs % 8 == 0) ? (cb % 8) * (Gs / 8) + cb / 8 : cb;
                for (int u = vcu; u < 1024; u += Gs) { int b, hd, qb; att::unit_of(u, b, hd, qb);
                    att::sb_unit((ATT_LAS char*)lds, (volatile ATT_LAS unsigned*)(LC + LC_SBDONE), (unsigned)(u + 1 + l * 4096), (const bf16*)(R0 + R_QS), (const bf16*)(R0 + R_KS), (const bf16*)(R0 + R_VS), (bf16*)(R0 + R_OS), b, hd, qb); }
                SEAM(PH(l, 2));
            }
        }
        if (SITE(4) && IN(PH(l, 3))) REP(11) {
            SITE_BEGIN();
            const long long wo = (l == 0) ? OFF_WO0 : (l == 1 ? OFF_WO1 : (l == 2 ? OFF_WO2 : OFF_WO3));
            pg8::Gemm g{(const bf16*)(R0 + (l < 2 ? R_O : R_OS)), (const bf16*)(wsl + wo), M, 1024, 1024}; pg8::StaticOrder S; S.init(M, 1024, Gs, cb);
            pg8::EpiRes E{HBP, DUMMY(11) ? (bf16*)(R0 + R_ACT) : HBP, DUMMY(11) ? SSA(2) : SSA(1), 1.0f, 0};
            pg8::gemm_phase<pg8::EpiRes, pg8::StaticOrder, true, true>(lds, g, S, E);
            SEAM(PH(l, 3));
        }
        const bool moe = (l & 1) != 0;
        if (SITE(11) && moe && IN(PH(l, 4))) REP(9) {
            SITE_BEGIN();
            int tid_ = threadIdx.x; asm volatile("" : "+v"(tid_));
            const int tid = tid_, lane = tid & 63, wave = __builtin_amdgcn_readfirstlane(tid >> 6);
            LAS int* lcnt = (LAS int*)lds; LAS int* gb = lcnt + 8; LAS int* le = lcnt + 16; LAS int* lp = le + 256; LAS float* lg = (LAS float*)(lp + 256);
            unsigned* cnt = (unsigned*)(wsl + WS_CTL) + CW_CNT + (l == 3 ? 64 : 0) + (DUMMY(9) ? 128 : 0);
            RInfo* rinfo = (RInfo*)(wsl + WS_RINFO);
            LAS float* RT = (LAS float*)(lds + 8192); router_load(RT, INP(l == 1 ? 19 : 34), INP(l == 1 ? 20 : 35), tid);
            for (int chunk = cb; chunk < M / 128; chunk += Gs) {
                if (tid < NE) lcnt[tid] = 0;
                __syncthreads();
                u32x2 hw[4][4], hn[4][4]; float ssc[4], ssn_[4];
#define RT_LOAD(dst, sdst, m_) do { const u32x2* hp_ = (const u32x2*)(HBP + (size_t)(m_) * D) + lane; dst[0] = hp_[0]; dst[1] = hp_[64]; dst[2] = hp_[128]; dst[3] = hp_[192]; sdst = sum16(SSA(1) + (size_t)(m_) * 16); } while (0)
#pragma unroll
                for (int r = 0; r < 4; ++r) RT_LOAD(hw[r], ssc[r], chunk * 128 + r * 8 + wave);
                for (int it = 0; it < 4; ++it) {
                    if (it < 3) {
#pragma unroll
                        for (int r = 0; r < 4; ++r) RT_LOAD(hn[r], ssn_[r], chunk * 128 + (4 * (it + 1) + r) * 8 + wave); }
                    float acc4[4][NE]; route_dot4(RT, hw, lane, acc4);
#pragma unroll
                    for (int r = 0; r < 4; ++r) { const int rl = (4 * it + r) * 8 + wave; int i1, i2; float g1, g2;
                        route_row(acc4[r], rsqrtf(ssc[r] * (1.0f / D) + EPS), lane, i1, i2, g1, g2);
                        if (lane == 0) { le[2 * rl] = i1; le[2 * rl + 1] = i2; lg[2 * rl] = g1; lg[2 * rl + 1] = g2; lp[2 * rl] = __hip_atomic_fetch_add(lcnt + i1, 1, __ATOMIC_RELAXED, __HIP_MEMORY_SCOPE_WORKGROUP); lp[2 * rl + 1] = __hip_atomic_fetch_add(lcnt + i2, 1, __ATOMIC_RELAXED, __HIP_MEMORY_SCOPE_WORKGROUP); } }
#pragma unroll
                    for (int r = 0; r < 4; ++r) {
#pragma unroll
                        for (int j = 0; j < 4; ++j) hw[r][j] = hn[r][j];
                        ssc[r] = ssn_[r]; }
                }
#undef RT_LOAD
                __syncthreads();
                if (tid < NE) gb[tid] = (int)__hip_atomic_fetch_add(cnt + tid, (unsigned)lcnt[tid], RLX_AGENT);
                __syncthreads();
                if (tid < 128) { RInfo ri; ri.e1 = le[2 * tid]; ri.e2 = le[2 * tid + 1]; ri.p1 = gb[ri.e1] + lp[2 * tid]; ri.p2 = gb[ri.e2] + lp[2 * tid + 1]; ri.g1 = lg[2 * tid]; ri.g2 = lg[2 * tid + 1]; ri.s1 = 0; ri.s2 = 0; rinfo[chunk * 128 + tid] = ri; }
                __syncthreads();
            }
            SEAM(PH(l, 4));
        }
        if (SITE(12) && moe && IN(PH(l, 5))) REP(8) {
            SITE_BEGIN();
            int tid_ = threadIdx.x; asm volatile("" : "+v"(tid_));
            const int tid = tid_, lane = tid & 63, wave = __builtin_amdgcn_readfirstlane(tid >> 6);
            unsigned* cnt = (unsigned*)(wsl + WS_CTL) + CW_CNT + (l == 3 ? 64 : 0);
            int* base_out = (int*)(wsl + WS_CTL) + CW_BASE + (l == 3 ? 64 : 0);
            RInfo* rinfo = (RInfo*)(wsl + WS_RINFO);
            unsigned char* xg8 = R0 + R_XG; float* ssg = (float*)(wsl + WS_SLOT); float* sgate = ssg + TMAX;
            int cn[NE], base[NE + 1]; base[0] = 0;
            const unsigned cv_ = __hip_atomic_load(cnt + (lane & 7), RLX_AGENT);
#pragma unroll
            for (int e = 0; e < NE; ++e) { cn[e] = (int)__builtin_amdgcn_readlane(cv_, e); base[e + 1] = base[e] + ((cn[e] + 255) & ~255); }
            if (cb == 0 && tid <= NE) { int v = 0;
#pragma unroll
                for (int e = 0; e <= NE; ++e) if (tid == e) v = base[e];
                base_out[tid] = v; }
            const int gw = cb * NWAVES + wave, NGW = Gs * NWAVES;
            int2* tokslot = (int2*)(wsl + WS_TOKSLOT);
            for (int m0 = gw; m0 < M; m0 += 2 * NGW) {
                const int m1 = (m0 + NGW < M) ? m0 + NGW : m0;
                const RInfo ra = rinfo[m0], rb = rinfo[m1];
                const u32x4* sa = (const u32x4*)(HBP + (size_t)m0 * D) + 2 * lane; const u32x4* sb = (const u32x4*)(HBP + (size_t)m1 * D) + 2 * lane;
                const u32x4 a0 = sa[0], a1 = sa[1], c0 = sb[0], c1 = sb[1];
                float sva = 0.f, svb = 0.f; if (lane == 0) { sva = sum16(SSA(1) + (size_t)m0 * 16); svb = sum16(SSA(1) + (size_t)m1 * 16); }
                int ba1 = 0, ba2 = 0, bb1 = 0, bb2 = 0;
#pragma unroll
                for (int e = 0; e < NE; ++e) { if (ra.e1 == e) ba1 = base[e]; if (ra.e2 == e) ba2 = base[e]; if (rb.e1 == e) bb1 = base[e]; if (rb.e2 == e) bb2 = base[e]; }
                const int sa1 = ba1 + ra.p1, sa2 = ba2 + ra.p2, sb1 = bb1 + rb.p1, sb2 = bb2 + rb.p2;
                v4u oa, ob;
                oa.x = pg8::pk4_fp8(bf2f(a0.x), bf2f(a0.x >> 16), bf2f(a0.y), bf2f(a0.y >> 16)); oa.y = pg8::pk4_fp8(bf2f(a0.z), bf2f(a0.z >> 16), bf2f(a0.w), bf2f(a0.w >> 16));
                oa.z = pg8::pk4_fp8(bf2f(a1.x), bf2f(a1.x >> 16), bf2f(a1.y), bf2f(a1.y >> 16)); oa.w = pg8::pk4_fp8(bf2f(a1.z), bf2f(a1.z >> 16), bf2f(a1.w), bf2f(a1.w >> 16));
                ob.x = pg8::pk4_fp8(bf2f(c0.x), bf2f(c0.x >> 16), bf2f(c0.y), bf2f(c0.y >> 16)); ob.y = pg8::pk4_fp8(bf2f(c0.z), bf2f(c0.z >> 16), bf2f(c0.w), bf2f(c0.w >> 16));
                ob.z = pg8::pk4_fp8(bf2f(c1.x), bf2f(c1.x >> 16), bf2f(c1.y), bf2f(c1.y >> 16)); ob.w = pg8::pk4_fp8(bf2f(c1.z), bf2f(c1.z >> 16), bf2f(c1.w), bf2f(c1.w >> 16));
                *((v4u*)(xg8 + (size_t)sa1 * D) + lane) = oa; *((v4u*)(xg8 + (size_t)sa2 * D) + lane) = oa; *((v4u*)(xg8 + (size_t)sb1 * D) + lane) = ob; *((v4u*)(xg8 + (size_t)sb2 * D) + lane) = ob;
                if (lane == 0) { ssg[sa1] = sva; ssg[sa2] = sva; sgate[sa1] = ra.g1; sgate[sa2] = ra.g2; tokslot[m0] = make_int2(sa1, sa2);
                                 ssg[sb1] = svb; ssg[sb2] = svb; sgate[sb1] = rb.g1; sgate[sb2] = rb.g2; tokslot[m1] = make_int2(sb1, sb2); }
            }
            for (int e = cb; e < NE; e += Gs) {
                int plo = 0, phi = 0;
#pragma unroll
                for (int q = 0; q < NE; ++q) if (e == q) { plo = base[q] + cn[q]; phi = base[q + 1]; }
                for (int r = plo + wave; r < phi; r += NWAVES) { *((v4u*)(xg8 + (size_t)r * D) + lane) = (v4u){0u, 0u, 0u, 0u}; if (lane == 0) { ssg[r] = 1024.f; sgate[r] = 0.f; } }
            }
            SEAM(PH(l, 5));
        }
        if (SITE(5) && !moe && IN(PH(l, 6))) REP(4) {
            SITE_BEGIN();
            pg8::Gemm g{HBP, (const bf16*)(wsl + (l == 0 ? OFF_WGU0 : OFF_WGU2)), M, 5632, 1024}; pg8::StaticOrder S; S.init(M, 5632, Gs, cb);
            if (DENSE_DN_FP8) { pg8::EpiSwiglu8 E{SSA(1), R0 + R_ACT, 16, 1.0f};
                pg8::gemm_phase<pg8::EpiSwiglu8, pg8::StaticOrder, true, true>(lds, g, S, E); }
            else { pg8::EpiSwiglu E{SSA(1), (bf16*)(R0 + R_ACT), 16, 0};
                pg8::gemm_phase<pg8::EpiSwiglu, pg8::StaticOrder, true, true>(lds, g, S, E); }
            SEAM(PH(l, 6));
        }
        if (SITE(13) && moe && IN(PH(l, 6))) REP(5) {
            SITE_BEGIN();
            pg8::Gemm g{(const bf16*)(R0 + R_XG), (const bf16*)(wsl + OFF_MGU), TMAX, 5632, 512}; pg8::GroupedOrder S; S.initg((const int*)(wsl + WS_CTL) + CW_BASE + (l == 3 ? 64 : 0), 5632, Gs, cb, (size_t)MOE_GU_BYTES);
            pg8::EpiSwiglu8 E{(const float*)(wsl + WS_SLOT), R0 + R_ACTG, 1, 1.0f / 64.0f};
            pg8::gemm_phase<pg8::EpiSwiglu8, pg8::GroupedOrder, true, true, true>(lds, g, S, E);
            SEAM(PH(l, 6));
        }
        if (!moe) {
            if (SITE(6) && IN(PH(l, 7))) REP(12) {
                SITE_BEGIN();
                pg8::Gemm g{(const bf16*)(R0 + R_ACT), (const bf16*)(wsl + (l == 0 ? OFF_WDN0 : OFF_WDN2)), M, 1024, DENSE_DN_FP8 ? 1408 : 2816}; pg8::StaticOrder S; S.init(M, 1024, Gs, cb);
                pg8::EpiRes E{HBP, DUMMY(12) ? (bf16*)(R0 + R_QS) : HBP, DUMMY(12) ? SSA(2) : SSA(0), DENSE_DN_FP8 ? 1.0f / 512.0f : 1.0f, 0};
                if (DENSE_DN_FP8) pg8::gemm_phase<pg8::EpiRes, pg8::StaticOrder, true, true, true, true>(lds, g, S, E);
                else pg8::gemm_phase<pg8::EpiRes, pg8::StaticOrder, true, true, false, true>(lds, g, S, E);
                SEAM(PH(l, 7));
            }
        } else {
            if (SITE(7) && IN(PH(l, 7))) REP(6) {
                SITE_BEGIN();
                pg8::Gemm g{(const bf16*)(R0 + R_ACTG), (const bf16*)(wsl + OFF_MDN), TMAX, 1024, 1408}; pg8::GroupedOrder S;   S.initg((const int*)(wsl + WS_CTL) + CW_BASE + (l == 3 ? 64 : 0), 1024, Gs, cb, (size_t)MOE_DN_BYTES);
                pg8::MoeSplit sp; sp.init(S.nM, 4, Gs); S.nM = sp.nM_main; S.nwg = sp.nM_main * 4;
                pg8::EpiMdn E{(const float*)(wsl + WS_SLOT) + TMAX, (bf16*)(R0 + R_XG), 1.0f / 512.0f, 0};
                pg8::gemm_phase<pg8::EpiMdn, pg8::GroupedOrder, true, true, true, true>(lds, g, S, E);
                SEAM(PH(l, 7));
            }
            if (SITE(8) && IN(PH(l, 8))) REP(10) {
                SITE_BEGIN();
                int tid_ = threadIdx.x; asm volatile("" : "+v"(tid_));
                const int lane = tid_ & 63, wave = __builtin_amdgcn_readfirstlane(tid_ >> 6);
                pg8::MoeSplit sp; sp.init(__builtin_amdgcn_readfirstlane(((const int*)(wsl + WS_CTL) + CW_BASE + (l == 3 ? 64 : 0))[8]) / 256, 4, Gs);
                const int ntail = sp.ntail, thr = ntail ? sp.nM_main * 256 : 0x7fffffff;
                const bool tailcu = cb < ntail;
                const int gw = (cb - ntail) * NWAVES + wave, NGW = (Gs - ntail) * NWAVES;
                const int2* tokslot = (const int2*)(wsl + WS_TOKSLOT);
                const float* gf = (l == 3) ? INP(38) : nullptr;
                if (tailcu) {
                    pg8::Gemm g{(const bf16*)(R0 + R_ACTG), (const bf16*)(wsl + OFF_MDN), TMAX, 1024, 1408}; pg8::TailOrder S; S.initg((const int*)(wsl + WS_CTL) + CW_BASE + (l == 3 ? 64 : 0), 1024, Gs, cb, (size_t)MOE_DN_BYTES);
                    S.tpm = sp.nM_main + (cb >> 2); S.tpn = cb & 3;
                    pg8::EpiMdn E{(const float*)(wsl + WS_SLOT) + TMAX, (bf16*)(R0 + R_XG), 1.0f / 512.0f, 0};
                    pg8::gemm_phase<pg8::EpiMdn, pg8::TailOrder, true, true, true, true>(lds, g, S, E);
                }
                unsigned pend = 0u;
#pragma nounroll
                for (int pass = 0; pass < 2; ++pass) {
                    if (pass == 1) { if (ntail == 0) break; if (hi - lo > 1) xcd_barrier(bar); }
                    if (!tailcu) { int k = 0;
                        int2 ta = make_int2(0, 0), tb = make_int2(0, 0);
                        if (pass == 0 && gw < M) { ta = tokslot[gw]; tb = tokslot[(gw + NGW < M) ? gw + NGW : gw]; }
                        for (int m = gw; m < M; m += 2 * NGW, ++k) {
                            if (pass == 1) { if (k < 32 && !((pend >> k) & 1u)) continue; ta = tokslot[m]; tb = tokslot[(m + NGW < M) ? m + NGW : m]; }
                            int2 tna = ta, tnb = tb; const int mn = m + 2 * NGW;
                            if (pass == 0 && mn < M) { tna = tokslot[mn]; tnb = tokslot[(mn + NGW < M) ? mn + NGW : mn]; }
                            bool did;
                            if (l == 1) did = combine_rows2<false>(HBP, DUMMY(10) ? (bf16*)(R0 + R_ACTG) : HBP, nullptr, (const bf16*)(R0 + R_XG), tokslot, DUMMY(10) ? SSA(2) : SSA(0), nullptr, m, (m + NGW < M) ? m + NGW : m, lane, thr, pass, ta, tb);
                            else did = combine_rows2<true>(HBP, nullptr, DUMMY(10) ? (float*)(R0 + R_ACTG) : outl, (const bf16*)(R0 + R_XG), tokslot, nullptr, gf, m, (m + NGW < M) ? m + NGW : m, lane, thr, pass, ta, tb);
                            if (pass == 0 && !did && k < 32) pend |= 1u << k;
                            ta = tna; tb = tnb;
                        }
                    }
                }
                if (l == 1) conv_run(LC, lds, wsl, cb, Gs, tid_, 0, MOE_ITEMS, 36, 37, 34);
                SEAM(PH(l, 8));
            }
        }
    }

__global__ void __launch_bounds__(NWAVES * 64, 2) mega(Args args) {
    extern __shared__ __attribute__((aligned(16))) unsigned char lds_raw[];
    LAS unsigned char* lds = (LAS unsigned char*)lds_raw;
    volatile LAS unsigned* LC = (volatile LAS unsigned*)(lds + LDSCTL_OFF);
    for (int u = threadIdx.x; u < (LDS_BYTES - LDSCTL_OFF) / 4; u += NWAVES * 64) LC[u] = 0u;
    __syncthreads();
    if (threadIdx.x == 0) {
#pragma unroll
        for (int i = 0; i < 39; ++i) { const unsigned long long p = (unsigned long long)args.in[i]; LC[LC_PTR + 2 * i] = (unsigned)p; LC[LC_PTR + 2 * i + 1] = (unsigned)(p >> 32); }
    }
    __syncthreads();
#ifdef MK_PER_PHASE
    const int lo = args.ph_lo, hi = args.ph_hi;
#else
    constexpr int lo = 0, hi = PH_END;
#endif
    XcdBarrier bar; bar.bar = (unsigned*)(args.ws + WS_CTL) + CW_BAR; bar.x = 0; bar.st = nullptr;
    if (hi - lo > 1) bar = xcd_barrier_post((unsigned*)(args.ws + WS_CTL) + CW_BAR, LC + LC_BAR);
    if (SITE(0) && IN(PH_PRO)) REP(0) {
        SITE_BEGIN();
        int tid_ = threadIdx.x; asm volatile("" : "+v"(tid_));
        const int lane = tid_ & 63, wave = __builtin_amdgcn_readfirstlane(tid_ >> 6);
        const int gw = cb * NWAVES + wave, NGW = Gs * NWAVES;
        for (int l = 0; l < 2; ++l) { bf16* wd = (bf16*)(wsl + (l ? OFF_WD1 : OFF_WD0)) + (size_t)704 * 1024;
            for (int i = cb * 512 + tid_; i < 64 * 1024 / 8; i += Gs * 512) ((v4u*)wd)[i] = (v4u){0u, 0u, 0u, 0u}; }
        conv_run(LC, lds, wsl, cb, Gs, tid_, SMALL_ITEMS, SMALL_ITEMS + MOE_ITEMS, 21, 22, 19);
        for (int m = gw; m < M; m += NGW) prep_row(INP(0), (const int*)INP(1), HBP, SSA(0), (float2*)(wsl + WS_CS), m, lane);
        SEAM(PH_PRO);
    }

    layer_phases<0>(args, lds, LC, bar, lo, hi);
    layer_phases<1>(args, lds, LC, bar, lo, hi);
    layer_phases<2>(args, lds, LC, bar, lo, hi);
    layer_phases<3>(args, lds, LC, bar, lo, hi);
#undef IN
#undef SEAM
#undef INP
#undef SSA
}


extern "C" void kernel_launch(void* const* d_in, const int* in_sizes, int n_in, void* d_out, int out_size, void* d_ws, size_t ws_size, hipStream_t stream) {
    if (n_in != 39 || out_size != M * D || ws_size < WS_END) { fprintf(stderr, "kernel_launch: unexpected shapes (n_in %d out %d ws %zu need %zu)\n", n_in, out_size, ws_size, (size_t)WS_END); return; }
    static int once = 0, grid = 256;
    if (!once) { once = 1;
        { int dev = 0, cus = 0; if (hipGetDevice(&dev) == hipSuccess && hipDeviceGetAttribute(&cus, hipDeviceAttributeMultiprocessorCount, dev) == hipSuccess && cus > 0) grid = cus; }
        (void)hipFuncSetAttribute((const void*)mega, hipFuncAttributeMaxDynamicSharedMemorySize, LDS_BYTES); }
    unsigned char* ws = (unsigned char*)d_ws;
    float* out = (float*)d_out;
    Args a{};
    for (int i = 0; i < 39; ++i) a.in[i] = d_in[i];
    a.out = out; a.ws = ws;
    auto phase = [&](int p) { a.ph_lo = p; a.ph_hi = p + 1; hipLaunchKernelGGL(mega, dim3(grid), dim3(NWAVES * 64), LDS_BYTES, stream, a); }; (void)phase;

    (void)hipMemsetAsync(ws + WS_CTL, 0, CTL_BYTES, stream);
#ifdef MK_PER_PHASE
    for (int p = 0; p < PH_END; ++p) phase(p);
#else
    a.ph_lo = 0; a.ph_hi = PH_END;
    hipLaunchKernelGGL(mega, dim3(grid), dim3(NWAVES * 64), LDS_BYTES, stream, a);
#endif
}
```

```cpp
#include <hip/hip_runtime.h>
#include <cstdio>
#include <cstdint>

#ifndef REPEAT
#define REPEAT -1
#endif
#ifndef DENSE_DN_FP8
#define DENSE_DN_FP8 1
#endif
#ifndef MLA_FP8
#define MLA_FP8 1
#endif
typedef unsigned short bf16;
typedef float f32x4 __attribute__((ext_vector_type(4)));
typedef float f32x16 __attribute__((ext_vector_type(16)));
typedef unsigned u32x4 __attribute__((ext_vector_type(4)));
typedef unsigned u32x2 __attribute__((ext_vector_type(2)));

constexpr int NB = 8, S = 4096, D = 1024, M = NB * S;
constexpr int NH = 8, QKN = 128, QKR = 64, QKD = QKN + QKR, VH = 128, QL = 384, KVL = 256;
constexpr int NDOWN = QL + KVL + QKR;
constexpr int FF = 2816, NE = 8;
constexpr float EPS = 1e-6f;
constexpr float LOG2E = 1.4426950408889634f, LN2 = 0.6931471805599453f;
constexpr float C2_MLA = 0.07216878364870322f * LOG2E;
constexpr float C2_SB = 0.08838834764831845f * LOG2E;
constexpr int TMAX = 2 * M + NE * 256;

constexpr size_t MiB = 1u << 20;
constexpr size_t WS_CTL = 0, CTL_BYTES = 1 * MiB;
constexpr size_t WS_SS = 1 * MiB;
constexpr size_t WS_CS = 9 * MiB;
constexpr size_t WS_RINFO = 17 * MiB;
constexpr size_t WS_SLOT = 18 * MiB;
constexpr size_t WS_TOKSLOT = WS_SLOT + 768 * 1024;
constexpr size_t WS_HB = 19 * MiB;
constexpr size_t WS_R0 = 83 * MiB;
constexpr size_t R_CQ = 0, R_CKV = 24 * MiB, R_KR = 40 * MiB, R_Q = 44 * MiB, R_KN = 140 * MiB, R_V = 204 * MiB, R_O = 268 * MiB;
constexpr size_t R_Q8 = 44 * MiB, R_K8T = 92 * MiB, R_VT8T = 144 * MiB;
constexpr int K8_PITCH = 208, K8_TILE = 64 * K8_PITCH, VT8_PITCH = 80, VT8_TILE = 128 * VT8_PITCH;
static_assert(R_Q8 + (size_t)M * 1536 <= R_K8T && R_K8T + (size_t)4096 * K8_TILE <= R_VT8T && R_VT8T + (size_t)4096 * VT8_TILE <= R_O, "fp8 MLA buffers");
constexpr size_t R_ACT = 0;
constexpr size_t R_KS = 176 * MiB, R_VS = 240 * MiB, R_QS = 304 * MiB, R_OS = 368 * MiB;
constexpr size_t R_XG = 0, R_ACTG = 132 * MiB;
constexpr size_t WS_WSMALL = 578 * MiB, WS_WMOE = 635 * MiB;
constexpr size_t WS_END = 767 * MiB;
constexpr int CW_CNT = 64;
constexpr int CW_BAR = 4096;
constexpr int CW_BASE = 256;

__device__ __forceinline__ unsigned f2bf(float f) { unsigned u = __builtin_bit_cast(unsigned, f); return (u + 0x7fffu + ((u >> 16) & 1u)) >> 16; }
__device__ __forceinline__ float bf2f(unsigned b) { return __builtin_bit_cast(float, (b & 0xffffu) << 16); }
__device__ __forceinline__ unsigned pk2(float lo, float hi) { return f2bf(lo) | (f2bf(hi) << 16); }
__device__ __forceinline__ float wave_sum(float v) {
#pragma unroll
    for (int o = 1; o < 64; o <<= 1) v += __shfl_xor(v, o);
    return v;
}
__device__ __forceinline__ float wave_max(float v) {
#pragma unroll
    for (int o = 1; o < 64; o <<= 1) v = fmaxf(v, __shfl_xor(v, o));
    return v;
}
__device__ __forceinline__ int crow(int r, int hi) { return (r & 3) + 8 * (r >> 2) + 4 * hi; }

__device__ __forceinline__ float sum16(const float* p) { const f32x4 a = *(const f32x4*)p, b = *(const f32x4*)(p + 4), c = *(const f32x4*)(p + 8), d = *(const f32x4*)(p + 12);
    return (((a.x + a.y) + (a.z + a.w)) + ((b.x + b.y) + (b.z + b.w))) + (((c.x + c.y) + (c.z + c.w)) + ((d.x + d.y) + (d.z + d.w))); }
struct RInfo { int e1, e2, p1, p2; float g1, g2; int s1, s2; };

namespace pg8 {
#define PG8_LAS __attribute__((address_space(3)))
typedef unsigned short bf16_t;
typedef short bf16x8 __attribute__((ext_vector_type(8)));
typedef float f32x4 __attribute__((ext_vector_type(4)));
typedef unsigned u32x4 __attribute__((ext_vector_type(4)));
constexpr int BM = 256, BK = 64, HALF = 128, HTB = HALF * BK * 2  , STAGE_BYTES = 8 * HTB, NXCD = 8, WGM = 8;

__host__ __device__ __forceinline__ int lds_byte(int r, int c) { const int st = (r >> 4) * 2 + (c >> 5), rr = r & 15, cc = c & 31, ob = rr * 64 + cc * 2; return st * 1024 + (ob ^ (((ob >> 9) & 1) << 5)); }
__host__ __device__ __forceinline__ void stage_rc(int b, int& R, int& C) { const int st = b / 1024, sb = b % 1024, swz = sb ^ (((sb >> 9) & 1) << 5); R = (st >> 1) * 16 + swz / 64; C = (st & 1) * 32 + (swz % 64) / 2; }
__host__ __device__ __forceinline__ int perm32(int rho) { const int n = rho >> 4, i = rho & 15; return 8 * (i >> 2) + 4 * n + (i & 3); }

struct Unit { int pm, pn; };
struct Gemm { const bf16_t* A; const bf16_t* Bt; int M, N, K; };

struct StaticOrder {
    int nM, nN, nwg, G, c;
    __host__ __device__ void init(int M, int N, int G_, int c_) { nM = M / BM; nN = N / BM; nwg = nM * nN; G = G_; c = c_; }
    __host__ __device__ bool next(int i, Unit& u) const {
        const long L = (long)i * G + c; if (L >= nwg) return false;
        int wgid = (int)L; { const int q = nwg / NXCD, r = nwg % NXCD, xcd = wgid % NXCD, off = wgid / NXCD; wgid = (xcd < r ? xcd * (q + 1) : r * (q + 1) + (xcd - r) * q) + off; }
        const int nig = WGM * nN, gid = wgid / nig, fm = gid * WGM, gsz = (nM - fm) < WGM ? (nM - fm) : WGM;
        u.pm = fm + ((wgid % nig) % gsz); u.pn = (wgid % nig) / gsz; return true;
    }
    __device__ __forceinline__ void a_ready(const Unit&) const {}
    __device__ __forceinline__ void done(const Unit&) const {}
    __device__ __forceinline__ size_t boff(const Unit&) const { return 0; }
};

__device__ __forceinline__ unsigned cvt_pk_bf16(float lo, float hi) { unsigned r; asm volatile("v_cvt_pk_bf16_f32 %0, %1, %2" : "=v"(r) : "v"(lo), "v"(hi)); return r; }
typedef unsigned u32x2 __attribute__((ext_vector_type(2)));
__device__ __forceinline__ u32x4 pack8(const f32x4 a, const f32x4 b) { u32x4 w; w.x = cvt_pk_bf16(a[0], a[1]); w.y = cvt_pk_bf16(a[2], a[3]); w.z = cvt_pk_bf16(b[0], b[1]); w.w = cvt_pk_bf16(b[2], b[3]); return w; }
__device__ __forceinline__ float sumsq8(const f32x4 a, const f32x4 b) { return ((a[0] * a[0] + a[1] * a[1]) + (a[2] * a[2] + a[3] * a[3])) + ((b[0] * b[0] + b[1] * b[1]) + (b[2] * b[2] + b[3] * b[3])); }
__device__ __forceinline__ float red_fq(float q) {
    q += __uint_as_float((unsigned)__builtin_amdgcn_ds_swizzle((int)__float_as_uint(q), 0x401F));
    { auto rr = __builtin_amdgcn_permlane32_swap(__float_as_uint(q), __float_as_uint(q), false, false); q = __uint_as_float(rr[0]) + __uint_as_float(rr[1]); }
    return q; }
__device__ __forceinline__ float row_ss(const float* ss, int stride, int nq, int r, int fq) { if (stride == 1) return ss[r]; float q = 0.f; if (fq < nq) { const f32x4 v = *(const f32x4*)(ss + (size_t)r * 16 + fq * 4); q = (v[0] + v[1]) + (v[2] + v[3]); } return red_fq(q); }
constexpr float EPSN = 1e-6f;
__device__ __forceinline__ void row_sums(float (&q)[8], const float* ss, int stride, int nq, int row0, int fq) {
    if (stride == 1) {
#pragma unroll
        for (int g = 0; g < 8; ++g) q[g] = ss[row0 + (g >> 2) * HALF + (g & 3) * 16];
        asm volatile("" :: "v"(q[0]), "v"(q[1]), "v"(q[2]), "v"(q[3]), "v"(q[4]), "v"(q[5]), "v"(q[6]), "v"(q[7]));
        return;
    }
    f32x4 raw[8]; const int fqc = (fq < nq) ? fq : 0;
#pragma unroll
    for (int g = 0; g < 8; ++g) raw[g] = *(const f32x4*)(ss + (size_t)(row0 + (g >> 2) * HALF + (g & 3) * 16) * 16 + fqc * 4);
    asm volatile("" :: "v"(raw[0]), "v"(raw[1]), "v"(raw[2]), "v"(raw[3]), "v"(raw[4]), "v"(raw[5]), "v"(raw[6]), "v"(raw[7]));
    float t[8];
#pragma unroll
    for (int g = 0; g < 8; ++g) { const float sm = (raw[g][0] + raw[g][1]) + (raw[g][2] + raw[g][3]); q[g] = (fq < nq) ? sm : 0.f; }
#pragma unroll
    for (int g = 0; g < 8; ++g) t[g] = __uint_as_float((unsigned)__builtin_amdgcn_ds_swizzle((int)__float_as_uint(q[g]), 0x401F));
#pragma unroll
    for (int g = 0; g < 8; ++g) q[g] += t[g];
#pragma unroll
    for (int g = 0; g < 8; ++g) { auto rr = __builtin_amdgcn_permlane32_swap(__float_as_uint(q[g]), __float_as_uint(q[g]), false, false); q[g] = __uint_as_float(rr[0]) + __uint_as_float(rr[1]); }
}
#define EPI_ROW_SCALES(rs_, ss_, stride_, nq_, expr) float rs_[8]; { float q_[8]; row_sums(q_, ss_, stride_, nq_, u.pm * BM + wr * 64 + fr, fq); _Pragma("unroll") for (int g_ = 0; g_ < 8; ++g_) { const float q = q_[g_]; rs_[g_] = (expr); } }
__device__ __forceinline__ float rsq_(float x) { return __builtin_amdgcn_rsqf(x); }
constexpr int TOUCH_SINK = STAGE_BYTES + 4096;
__device__ __forceinline__ void touch_line(PG8_LAS unsigned char* lds, const void* p) { __builtin_amdgcn_global_load_lds((const unsigned*)p, (PG8_LAS unsigned*)(lds + TOUCH_SINK), 4, 0, 0); }
__device__ __forceinline__ void touch_rows16(PG8_LAS unsigned char* lds, const float* ss, int row0, int tid) { if (tid < 128) touch_line(lds, (const char*)(ss + (size_t)row0 * 16) + tid * 128); }
__device__ __forceinline__ void touch_rows1(PG8_LAS unsigned char* lds, const float* ss, int row0, int tid) { if (tid < 8) touch_line(lds, (const char*)(ss + row0) + tid * 128); }
__device__ __forceinline__ unsigned pk4_fp8(float a, float b, float c, float d) {
    a = __builtin_amdgcn_fmed3f(a, -448.f, 448.f); b = __builtin_amdgcn_fmed3f(b, -448.f, 448.f); c = __builtin_amdgcn_fmed3f(c, -448.f, 448.f); d = __builtin_amdgcn_fmed3f(d, -448.f, 448.f);
    int w = __builtin_amdgcn_cvt_pk_fp8_f32(a, b, 0, false); w = __builtin_amdgcn_cvt_pk_fp8_f32(c, d, w, true); return (unsigned)w; }

struct EpiDown { static constexpr bool PERM = true, AFTER_DRAIN = false, PROBE2 = false;
    const float* ss; const float2* cs; bf16_t* cq; bf16_t* ckv; bf16_t* kr; float* ssq; float* sskv; unsigned char* k8t;
    __device__ __forceinline__ void touch(PG8_LAS unsigned char* lds, const Unit& u, int tid) const { touch_rows16(lds, ss, u.pm * BM, tid); }
    __device__ __forceinline__ void operator()(const f32x4 (&acc)[2][2][4][2], const Unit& u0, int wr, int wc, int fr, int fq) const {
        Unit u = u0; asm volatile("" : "+s"(u.pm), "+s"(u.pn));
        EPI_ROW_SCALES(rs, ss, 16, 4, rsq_(q * (1.0f / 1024.0f) + EPSN))
#pragma unroll
        for (int ai = 0; ai < 2; ++ai)
#pragma unroll
            for (int m = 0; m < 4; ++m) { const int r = u.pm * BM + ai * HALF + wr * 64 + m * 16 + fr; const float rstd = rs[ai * 4 + m];
#pragma unroll
                for (int bj = 0; bj < 2; ++bj) { const int c = u.pn * BM + bj * HALF + wc * 32, cl = c + fq * 8;
                    const f32x4 v0 = acc[ai][bj][m][0] * rstd, v1 = acc[ai][bj][m][1] * rstd;
                    if (c < 384) { *(u32x4*)(cq + (size_t)r * 384 + cl) = pack8(v0, v1); const float q = red_fq(sumsq8(v0, v1)); if (fq == 0) ssq[(size_t)r * 16 + (c >> 5)] = q; }
                    else if (c < 640) { *(u32x4*)(ckv + (size_t)r * 256 + (cl - 384)) = pack8(v0, v1); const float q = red_fq(sumsq8(v0, v1)); if (fq == 0) sskv[(size_t)r * 16 + ((c - 384) >> 5)] = q; }
                    else if (c < 704) { const int i0 = (cl - 640) >> 1; const f32x4 t01 = *(const f32x4*)(cs + (size_t)r * 32 + i0), t23 = *(const f32x4*)(cs + (size_t)r * 32 + i0 + 2);
                        const f32x4 o0 = {v0[0] * t01[0] - v0[1] * t01[1], v0[0] * t01[1] + v0[1] * t01[0], v0[2] * t01[2] - v0[3] * t01[3], v0[2] * t01[3] + v0[3] * t01[2]};
                        const f32x4 o1 = {v1[0] * t23[0] - v1[1] * t23[1], v1[0] * t23[1] + v1[1] * t23[0], v1[2] * t23[2] - v1[3] * t23[3], v1[2] * t23[3] + v1[3] * t23[2]};
                        if (k8t) { u32x2 w; w.x = pk4_fp8(o0[0], o0[1], o0[2], o0[3]); w.y = pk4_fp8(o1[0], o1[1], o1[2], o1[3]); const int b = r >> 12, key = r & 4095, j = key >> 6, kk = key & 63;
#pragma unroll
                            for (int h2 = 0; h2 < 8; ++h2) *(u32x2*)(k8t + (size_t)((b * 8 + h2) * 64 + j) * 13312 + kk * 208 + 128 + (cl - 640)) = w; }
                        else *(u32x4*)(kr + (size_t)r * 64 + (cl - 640)) = pack8(o0, o1); }
                } }
    }
};
struct EpiUq { static constexpr bool PERM = true, AFTER_DRAIN = false, PROBE2 = false;
    const float* ssq; const float2* cs; bf16_t* Q; float c2; int pad;
    __device__ __forceinline__ void touch(PG8_LAS unsigned char* lds, const Unit& u, int tid) const { touch_rows16(lds, ssq, u.pm * BM, tid); }
    __device__ __forceinline__ void operator()(const f32x4 (&acc)[2][2][4][2], const Unit& u0, int wr, int wc, int fr, int fq) const {
        Unit u = u0; asm volatile("" : "+s"(u.pm), "+s"(u.pn));
        EPI_ROW_SCALES(rs, ssq, 16, 3, rsq_(q * (1.0f / 384.0f) + EPSN) * c2)
#pragma unroll
        for (int ai = 0; ai < 2; ++ai)
#pragma unroll
            for (int m = 0; m < 4; ++m) { const int r = u.pm * BM + ai * HALF + wr * 64 + m * 16 + fr; const float rstd = rs[ai * 4 + m];
#pragma unroll
                for (int bj = 0; bj < 2; ++bj) { const int c = u.pn * BM + bj * HALF + wc * 32, cl = c + fq * 8, d = c % 192;
                    const f32x4 v0 = acc[ai][bj][m][0] * rstd, v1 = acc[ai][bj][m][1] * rstd;
                    if (d < 128) { *(u32x4*)(Q + (size_t)r * 1536 + cl) = pack8(v0, v1); }
                    else { const int i0 = ((d - 128) >> 1) + fq * 4; const f32x4 t01 = *(const f32x4*)(cs + (size_t)r * 32 + i0), t23 = *(const f32x4*)(cs + (size_t)r * 32 + i0 + 2);
                        const f32x4 o0 = {v0[0] * t01[0] - v0[1] * t01[1], v0[0] * t01[1] + v0[1] * t01[0], v0[2] * t01[2] - v0[3] * t01[3], v0[2] * t01[3] + v0[3] * t01[2]};
                        const f32x4 o1 = {v1[0] * t23[0] - v1[1] * t23[1], v1[0] * t23[1] + v1[1] * t23[0], v1[2] * t23[2] - v1[3] * t23[3], v1[2] * t23[3] + v1[3] * t23[2]};
                        *(u32x4*)(Q + (size_t)r * 1536 + cl) = pack8(o0, o1); }
                } }
    }
};
struct EpiUq8 { static constexpr bool PERM = true, AFTER_DRAIN = false, PROBE2 = false;
    const float* ssq; const float2* cs; unsigned char* Q8; float c2; int pad;
    __device__ __forceinline__ void touch(PG8_LAS unsigned char* lds, const Unit& u, int tid) const { touch_rows16(lds, ssq, u.pm * BM, tid); }
    __device__ __forceinline__ void operator()(const f32x4 (&acc)[2][2][4][2], const Unit& u0, int wr, int wc, int fr, int fq) const {
        Unit u = u0; asm volatile("" : "+s"(u.pm), "+s"(u.pn));
        EPI_ROW_SCALES(rs, ssq, 16, 3, rsq_(q * (1.0f / 384.0f) + EPSN) * c2)
#pragma unroll
        for (int ai = 0; ai < 2; ++ai)
#pragma unroll
            for (int m = 0; m < 4; ++m) { const int r = u.pm * BM + ai * HALF + wr * 64 + m * 16 + fr; const float rstd = rs[ai * 4 + m];
#pragma unroll
                for (int bj = 0; bj < 2; ++bj) { const int c = u.pn * BM + bj * HALF + wc * 32, cl = c + fq * 8, d = c % 192;
                    f32x4 v0 = acc[ai][bj][m][0] * rstd, v1 = acc[ai][bj][m][1] * rstd;
                    if (d >= 128) { const int i0 = ((d - 128) >> 1) + fq * 4; const f32x4 t01 = *(const f32x4*)(cs + (size_t)r * 32 + i0), t23 = *(const f32x4*)(cs + (size_t)r * 32 + i0 + 2);
                        const f32x4 o0 = {v0[0] * t01[0] - v0[1] * t01[1], v0[0] * t01[1] + v0[1] * t01[0], v0[2] * t01[2] - v0[3] * t01[3], v0[2] * t01[3] + v0[3] * t01[2]};
                        const f32x4 o1 = {v1[0] * t23[0] - v1[1] * t23[1], v1[0] * t23[1] + v1[1] * t23[0], v1[2] * t23[2] - v1[3] * t23[3], v1[2] * t23[3] + v1[3] * t23[2]};
                        v0 = o0; v1 = o1; }
                    u32x2 w; w.x = pk4_fp8(v0[0], v0[1], v0[2], v0[3]); w.y = pk4_fp8(v1[0], v1[1], v1[2], v1[3]);
                    *(u32x2*)(Q8 + (size_t)r * 1536 + cl) = w; } }
    }
};
struct EpiKn8 { static constexpr bool PERM = true, AFTER_DRAIN = false, PROBE2 = false;
    const float* sskv; unsigned char* K8T;
    __device__ __forceinline__ void touch(PG8_LAS unsigned char* lds, const Unit& u, int tid) const { touch_rows16(lds, sskv, u.pm * BM, tid); }
    __device__ __forceinline__ void operator()(const f32x4 (&acc)[2][2][4][2], const Unit& u0, int wr, int wc, int fr, int fq) const {
        Unit u = u0; asm volatile("" : "+s"(u.pm), "+s"(u.pn));
        EPI_ROW_SCALES(rs, sskv, 16, 2, rsq_(q * (1.0f / 256.0f) + EPSN))
#pragma unroll
        for (int ai = 0; ai < 2; ++ai)
#pragma unroll
            for (int m = 0; m < 4; ++m) { const int r = u.pm * BM + ai * HALF + wr * 64 + m * 16 + fr; const float rstd = rs[ai * 4 + m];
                const int b = r >> 12, key = r & 4095, j = key >> 6, kk = key & 63;
#pragma unroll
                for (int bj = 0; bj < 2; ++bj) { const int head = 2 * u.pn + bj; const f32x4 v0 = acc[ai][bj][m][0] * rstd, v1 = acc[ai][bj][m][1] * rstd;
                    u32x2 w; w.x = pk4_fp8(v0[0], v0[1], v0[2], v0[3]); w.y = pk4_fp8(v1[0], v1[1], v1[2], v1[3]);
                    *(u32x2*)(K8T + (size_t)((b * 8 + head) * 64 + j) * 13312 + kk * 208 + wc * 32 + fq * 8) = w; } }
    }
};
struct EpiVt8 { static constexpr bool PERM = true, AFTER_DRAIN = false, PROBE2 = false;
    const float* sskv; unsigned char* VT8T;
    __device__ __forceinline__ void touch(PG8_LAS unsigned char* lds, const Unit& u, int tid) const { touch_rows16(lds, sskv, u.pn * BM, tid); }
    __device__ __forceinline__ void operator()(const f32x4 (&acc)[2][2][4][2], const Unit& u0, int wr, int wc, int fr, int fq) const {
        Unit u = u0; asm volatile("" : "+s"(u.pm), "+s"(u.pn));
        float sc[2][8];
#pragma unroll
        for (int bj = 0; bj < 2; ++bj) { const int c = u.pn * BM + bj * HALF + wc * 32 + fq * 8;
            f32x4 s0[8], s1[8];
#pragma unroll
            for (int i = 0; i < 8; ++i) { s0[i] = *(const f32x4*)(sskv + (size_t)(c + i) * 16); s1[i] = *(const f32x4*)(sskv + (size_t)(c + i) * 16 + 4); }
            asm volatile("" :: "v"(s0[0]), "v"(s0[1]), "v"(s0[2]), "v"(s0[3]), "v"(s0[4]), "v"(s0[5]), "v"(s0[6]), "v"(s0[7]), "v"(s1[0]), "v"(s1[1]), "v"(s1[2]), "v"(s1[3]), "v"(s1[4]), "v"(s1[5]), "v"(s1[6]), "v"(s1[7]));
#pragma unroll
            for (int i = 0; i < 8; ++i) sc[bj][i] = rsq_((((s0[i][0] + s0[i][1]) + (s0[i][2] + s0[i][3])) + ((s1[i][0] + s1[i][1]) + (s1[i][2] + s1[i][3]))) * (1.0f / 256.0f) + EPSN); }
#pragma unroll
        for (int ai = 0; ai < 2; ++ai)
#pragma unroll
            for (int m = 0; m < 4; ++m) { const int rr = u.pm * BM + ai * HALF + wr * 64 + m * 16 + fr, head = rr >> 7, d = rr & 127;
#pragma unroll
                for (int bj = 0; bj < 2; ++bj) { const int c = u.pn * BM + bj * HALF + wc * 32 + fq * 8, b = c >> 12, key = c & 4095, j = key >> 6, kk = key & 63;
                    const f32x4 v0 = acc[ai][bj][m][0], v1 = acc[ai][bj][m][1];
                    u32x2 w; w.x = pk4_fp8(v0[0] * sc[bj][0], v0[1] * sc[bj][1], v0[2] * sc[bj][2], v0[3] * sc[bj][3]); w.y = pk4_fp8(v1[0] * sc[bj][4], v1[1] * sc[bj][5], v1[2] * sc[bj][6], v1[3] * sc[bj][7]);
                    *(u32x2*)(VT8T + (size_t)((b * 8 + head) * 64 + j) * 10240 + d * 80 + kk) = w; } }
    }
};
struct EpiUkv { static constexpr bool PERM = true, AFTER_DRAIN = false, PROBE2 = false;
    const float* sskv; bf16_t* KN; bf16_t* V;
    __device__ __forceinline__ void touch(PG8_LAS unsigned char* lds, const Unit& u, int tid) const { touch_rows16(lds, sskv, u.pm * BM, tid); }
    __device__ __forceinline__ void operator()(const f32x4 (&acc)[2][2][4][2], const Unit& u0, int wr, int wc, int fr, int fq) const {
        Unit u = u0; asm volatile("" : "+s"(u.pm), "+s"(u.pn));
        EPI_ROW_SCALES(rs, sskv, 16, 2, rsq_(q * (1.0f / 256.0f) + EPSN))
#pragma unroll
        for (int ai = 0; ai < 2; ++ai)
#pragma unroll
            for (int m = 0; m < 4; ++m) { const int r = u.pm * BM + ai * HALF + wr * 64 + m * 16 + fr; const float rstd = rs[ai * 4 + m];
                const size_t o = (size_t)r * 1024 + u.pn * 128 + wc * 32 + fq * 8;
                *(u32x4*)(KN + o) = pack8(acc[ai][0][m][0] * rstd, acc[ai][0][m][1] * rstd);
                *(u32x4*)(V + o) = pack8(acc[ai][1][m][0] * rstd, acc[ai][1][m][1] * rstd); }
    }
};
__device__ __forceinline__ f32x4 bf4_lo(const u32x4 w) { return (f32x4){__uint_as_float(w.x << 16), __uint_as_float(w.x & 0xffff0000u), __uint_as_float(w.y << 16), __uint_as_float(w.y & 0xffff0000u)}; }
__device__ __forceinline__ f32x4 bf4_hi(const u32x4 w) { return (f32x4){__uint_as_float(w.z << 16), __uint_as_float(w.z & 0xffff0000u), __uint_as_float(w.w << 16), __uint_as_float(w.w & 0xffff0000u)}; }
struct EpiRes { static constexpr bool PERM = true, AFTER_DRAIN = false, PROBE2 = false;
    const bf16_t* hin; bf16_t* hb; float* ssn; float ascale; int pad;
    __device__ __forceinline__ void touch(PG8_LAS unsigned char* lds, const Unit& u, int tid) const { _Pragma("unroll") for (int i = 0; i < 2; ++i) { const int li = tid + 512 * i; touch_line(lds, (const char*)(hin + (size_t)(u.pm * BM + (li >> 2)) * 1024 + u.pn * BM) + (li & 3) * 128); } }
    __device__ __forceinline__ void operator()(const f32x4 (&acc)[2][2][4][2], const Unit& u0, int wr, int wc, int fr, int fq) const {
        Unit u = u0; asm volatile("" : "+s"(u.pm), "+s"(u.pn));
        const size_t o00 = (size_t)(u.pm * BM + wr * 64 + fr) * 1024 + u.pn * BM + wc * 32 + fq * 8;
        u32x4 h0[8], h1[8];
#pragma unroll
        for (int g = 0; g < 8; ++g) { const size_t og = o00 + (size_t)((g >> 2) * HALF + (g & 3) * 16) * 1024; h0[g] = *(const u32x4*)(hin + og); h1[g] = *(const u32x4*)(hin + og + HALF); }
        asm volatile("" :: "v"(h0[0]), "v"(h0[1]), "v"(h0[2]), "v"(h0[3]), "v"(h0[4]), "v"(h0[5]), "v"(h0[6]), "v"(h0[7]), "v"(h1[0]), "v"(h1[1]), "v"(h1[2]), "v"(h1[3]), "v"(h1[4]), "v"(h1[5]), "v"(h1[6]), "v"(h1[7]));
#pragma unroll
        for (int g = 0; g < 8; ++g) { const int ai = g >> 2, m = g & 3; const int r = u.pm * BM + ai * HALF + wr * 64 + m * 16 + fr;
            float q = 0.f;
#pragma unroll
            for (int bj = 0; bj < 2; ++bj) { const size_t o = o00 + (size_t)(ai * HALF + m * 16) * 1024 + bj * HALF; const u32x4 hv = bj ? h1[g] : h0[g];
                const f32x4 o0 = bf4_lo(hv) + acc[ai][bj][m][0] * ascale, o1 = bf4_hi(hv) + acc[ai][bj][m][1] * ascale;
                *(u32x4*)(hb + o) = pack8(o0, o1); q += sumsq8(o0, o1); }
            q = red_fq(q); if (fq == 0) ssn[(size_t)r * 16 + u.pn * 4 + wc] = q; }
    }
};
struct EpiSwiglu { static constexpr bool PERM = true, AFTER_DRAIN = false, PROBE2 = true;
    const float* ss; bf16_t* act; int ss_stride; int pad;
    __device__ __forceinline__ void touch(PG8_LAS unsigned char* lds, const Unit& u, int tid) const { if (ss_stride == 1) touch_rows1(lds, ss, u.pm * BM, tid); else touch_rows16(lds, ss, u.pm * BM, tid); }
    __device__ __forceinline__ void operator()(const f32x4 (&acc)[2][2][4][2], const Unit& u0, int wr, int wc, int fr, int fq) const {
        Unit u = u0; asm volatile("" : "+s"(u.pm), "+s"(u.pn));
        bf16_t* abase = act + ((size_t)(u.pm * 44 + 2 * u.pn + (wc >> 1)) * 256 + wr * 64 + fr) * 64 + (wc & 1) * 32 + fq * 8;
        EPI_ROW_SCALES(rs, ss, ss_stride, 4, rsq_(q * (1.0f / 1024.0f) + EPSN))
#pragma unroll
        for (int ai = 0; ai < 2; ++ai)
#pragma unroll
            for (int m = 0; m < 4; ++m) { const float rstd = rs[ai * 4 + m];
                f32x4 a[2];
                const float c1 = -1.4426950408889634f * rstd, ic2 = __builtin_amdgcn_rcpf(rstd * rstd);
#pragma unroll
                for (int n = 0; n < 2; ++n) { const f32x4 ag = acc[ai][0][m][n], t = ag * acc[ai][1][m][n];
#pragma unroll
                    for (int j = 0; j < 4; ++j) a[n][j] = t[j] * __builtin_amdgcn_rcpf(__builtin_fmaf(__builtin_amdgcn_exp2f(ag[j] * c1), ic2, ic2)); }
                *(u32x4*)(abase + (ai * HALF + m * 16) * 64) = pack8(a[0], a[1]); }
    }
};
__device__ __forceinline__ unsigned pk4_fp8_nc(float a, float b, float c, float d) { int w = __builtin_amdgcn_cvt_pk_fp8_f32(a, b, 0, false); w = __builtin_amdgcn_cvt_pk_fp8_f32(c, d, w, true); return (unsigned)w; }
struct EpiSwiglu8 { static constexpr bool PERM = true, AFTER_DRAIN = false, PROBE2 = false;
    const float* ss; unsigned char* act; int ss_stride; float ascale;
    __device__ __forceinline__ void touch(PG8_LAS unsigned char* lds, const Unit& u, int tid) const { if (ss_stride == 1) touch_rows1(lds, ss, u.pm * BM, tid); else touch_rows16(lds, ss, u.pm * BM, tid); }
    __device__ __forceinline__ void operator()(const f32x4 (&acc)[2][2][4][2], const Unit& u0, int wr, int wc, int fr, int fq) const {
        Unit u = u0; asm volatile("" : "+s"(u.pm), "+s"(u.pn));
        unsigned char* abase = act + (size_t)(u.pm * 22 + u.pn) * 32768 + (wr * 64 + fr) * 128 + wc * 32 + fq * 8;
        EPI_ROW_SCALES(rs, ss, ss_stride, 4, rsq_(q * (1.0f / 1024.0f) + EPSN) * ascale)
#pragma unroll
        for (int ai = 0; ai < 2; ++ai)
#pragma unroll
            for (int m = 0; m < 4; ++m) { const float rstd = rs[ai * 4 + m];
                f32x4 a[2];
                const float c1 = -1.4426950408889634f * rstd, ic2 = __builtin_amdgcn_rcpf(rstd * rstd * 8.0f);
#pragma unroll
                for (int n = 0; n < 2; ++n) { const f32x4 ag = acc[ai][0][m][n], t = ag * acc[ai][1][m][n];
#pragma unroll
                    for (int j = 0; j < 4; ++j) a[n][j] = t[j] * __builtin_amdgcn_rcpf(__builtin_fmaf(__builtin_amdgcn_exp2f(ag[j] * c1), ic2, ic2)); }
                u32x2 w; w.x = pk4_fp8(a[0][0], a[0][1], a[0][2], a[0][3]); w.y = pk4_fp8(a[1][0], a[1][1], a[1][2], a[1][3]);
                *(u32x2*)(abase + (ai * HALF + m * 16) * 128) = w; }
    }
};
struct EpiProj { static constexpr bool PERM = true, AFTER_DRAIN = false, PROBE2 = false;
    const float* ss; bf16_t* o0; size_t tstride; float qs; int qt; int nq; float invd; int pad;
    __device__ __forceinline__ void touch(PG8_LAS unsigned char* lds, const Unit& u, int tid) const { touch_rows16(lds, ss, u.pm * BM, tid); }
    __device__ __forceinline__ void operator()(const f32x4 (&acc)[2][2][4][2], const Unit& u0, int wr, int wc, int fr, int fq) const {
        Unit u = u0; asm volatile("" : "+s"(u.pm), "+s"(u.pn));
        const int t = u.pn >> 2; bf16_t* dst = o0 + (size_t)t * tstride; const float sc = (t == qt) ? qs : 1.0f;
        EPI_ROW_SCALES(rs, ss, 16, nq, rsq_(q * invd + EPSN) * sc)
#pragma unroll
        for (int ai = 0; ai < 2; ++ai)
#pragma unroll
            for (int m = 0; m < 4; ++m) { const int r = u.pm * BM + ai * HALF + wr * 64 + m * 16 + fr; const float rstd = rs[ai * 4 + m];
#pragma unroll
                for (int bj = 0; bj < 2; ++bj) *(u32x4*)(dst + (size_t)r * 1024 + (u.pn & 3) * BM + bj * HALF + wc * 32 + fq * 8) = pack8(acc[ai][bj][m][0] * rstd, acc[ai][bj][m][1] * rstd); }
    }
};
struct EpiMdn { static constexpr bool PERM = true, AFTER_DRAIN = false, PROBE2 = false;
    const float* sgate; bf16_t* y; float scale; int pad;
    __device__ __forceinline__ void touch(PG8_LAS unsigned char* lds, const Unit& u, int tid) const { touch_rows1(lds, sgate, u.pm * BM, tid); }
    __device__ __forceinline__ void operator()(const f32x4 (&acc)[2][2][4][2], const Unit& u0, int wr, int wc, int fr, int fq) const {
        Unit u = u0; asm volatile("" : "+s"(u.pm), "+s"(u.pn));
        EPI_ROW_SCALES(rs, sgate, 1, 0, q * scale)
#pragma unroll
        for (int ai = 0; ai < 2; ++ai)
#pragma unroll
            for (int m = 0; m < 4; ++m) { const int r = u.pm * BM + ai * HALF + wr * 64 + m * 16 + fr; const float g = rs[ai * 4 + m];
#pragma unroll
                for (int bj = 0; bj < 2; ++bj) *(u32x4*)(y + (size_t)r * 1024 + u.pn * BM + bj * HALF + wc * 32 + fq * 8) = pack8(acc[ai][bj][m][0] * g, acc[ai][bj][m][1] * g); }
    }
};
struct GroupedOrder : StaticOrder {
    int b1, b2, b3, b4, b5, b6, b7; size_t estride;
    __device__ __forceinline__ void initg(const int* base, int N, int G_, int c_, size_t estride_) { init(__builtin_amdgcn_readfirstlane(base[8]), N, G_, c_); b1 = __builtin_amdgcn_readfirstlane(base[1]); b2 = __builtin_amdgcn_readfirstlane(base[2]); b3 = __builtin_amdgcn_readfirstlane(base[3]); b4 = __builtin_amdgcn_readfirstlane(base[4]); b5 = __builtin_amdgcn_readfirstlane(base[5]); b6 = __builtin_amdgcn_readfirstlane(base[6]); b7 = __builtin_amdgcn_readfirstlane(base[7]); estride = estride_; }
    __device__ __forceinline__ void initd(int M, int N, int G_, int c_) { init(M, N, G_, c_); b1 = b2 = b3 = b4 = b5 = b6 = b7 = 0x7fffffff; estride = 0; }
    __device__ __forceinline__ size_t boff(const Unit& u) const { const int r = u.pm * BM; const int e = (r >= b1) + (r >= b2) + (r >= b3) + (r >= b4) + (r >= b5) + (r >= b6) + (r >= b7); return (size_t)e * estride; }
};
struct MoeSplit { int nM_main, ntail;
    __device__ __forceinline__ void init(int nM, int nN, int G) { const int nwg = nM * nN, t = nwg % G; const bool on = (G % nN == 0) && t != 0 && t * 4 <= G && nwg > G; ntail = on ? t : 0; nM_main = (nwg - ntail) / nN; } };
struct TailOrder : GroupedOrder { int tpm, tpn;
    __device__ __forceinline__ bool next(int i, Unit& u) const { if (i != 0) return false; u.pm = tpm; u.pn = tpn; return true; } };
typedef int v8i_t __attribute__((ext_vector_type(8)));
typedef int v4i_t __attribute__((ext_vector_type(4)));
__device__ __forceinline__ v8i_t cat8(const bf16x8 lo, const bf16x8 hi) { const v4i_t a = __builtin_bit_cast(v4i_t, lo), b = __builtin_bit_cast(v4i_t, hi); return __builtin_shufflevector(a, b, 0, 1, 2, 3, 4, 5, 6, 7); }
template <class Epi, class Sched, bool ALIGN_EPI = false, bool SP2 = false, bool F8 = false, bool TILED = false>
__device__ __forceinline__ void gemm_phase(PG8_LAS unsigned char* lds, const Gemm g, const Sched& S, const Epi& E) {
    int tid_ = threadIdx.x; asm volatile("" : "+v"(tid_));
    const int tid = tid_, wid = __builtin_amdgcn_readfirstlane(tid >> 6), lane = tid & 63, wr = wid >> 2, wc = wid & 3, fr = lane & 15, fq = lane >> 4;
    int K_ = g.K; asm volatile("" : "+s"(K_));
    const int K = K_, nt = K / BK;
    unsigned voffA[2], voffB[2];
#pragma unroll
    for (int i = 0; i < 2; ++i) { int R, C; stage_rc(tid * 16 + i * 8192, R, C); const int Rb = Epi::PERM ? ((R & ~31) + perm32(R & 31)) : R;
        voffA[i] = TILED ? (unsigned)(R * 128 + C * 2) : (unsigned)(R * K + C) * 2u; voffB[i] = TILED ? (unsigned)(Rb * 128 + C * 2) : (unsigned)(Rb * K + C) * 2u; }
    const size_t kstep = TILED ? (size_t)32768 : (size_t)(BK * 2);
    const size_t hstep = TILED ? (size_t)16384 : (size_t)HALF * K * 2;
    const size_t tstep = (size_t)BM * K * 2;
    const unsigned ldsw = (unsigned)wid * 1024u;
    const int aoff = lds_byte(wr * 64 + fr, fq * 8), boff = lds_byte(wc * 32 + fr, fq * 8);
#define PG8_SA(b, h) (((b) * 2 + (h)) * HTB)
#define PG8_SB(b, h) ((4 + (b) * 2 + (h)) * HTB)
#define PG8_STAGE(bufoff, gbase, voff) do { _Pragma("unroll") for (int _i = 0; _i < 2; ++_i) \
        __builtin_amdgcn_global_load_lds((const unsigned*)((const char*)(gbase) + (voff)[_i]), (PG8_LAS unsigned*)(lds + (bufoff) + ldsw + _i * 8192), 16, 0, 0); } while (0)
#define PG8_LD16(off) (*(const PG8_LAS v4i_t*)(lds + (off)))
#define PG8_LDA(dst, b, h) do { if constexpr (F8) { _Pragma("unroll") for (int m = 0; m < 4; ++m) dst##8[m] = __builtin_shufflevector(PG8_LD16(PG8_SA(b, h) + aoff + m * 2048), PG8_LD16(PG8_SA(b, h) + aoff + m * 2048 + 1024), 0, 1, 2, 3, 4, 5, 6, 7); } \
        else { _Pragma("unroll") for (int m = 0; m < 4; ++m) _Pragma("unroll") for (int k = 0; k < 2; ++k) dst[m][k] = *(const PG8_LAS bf16x8*)(lds + PG8_SA(b, h) + aoff + m * 2048 + k * 1024); } } while (0)
#define PG8_LDB(dst, b, h) do { if constexpr (F8) { _Pragma("unroll") for (int n = 0; n < 2; ++n) dst##8[n] = __builtin_shufflevector(PG8_LD16(PG8_SB(b, h) + boff + n * 2048), PG8_LD16(PG8_SB(b, h) + boff + n * 2048 + 1024), 0, 1, 2, 3, 4, 5, 6, 7); } \
        else { _Pragma("unroll") for (int n = 0; n < 2; ++n) _Pragma("unroll") for (int k = 0; k < 2; ++k) dst[n][k] = *(const PG8_LAS bf16x8*)(lds + PG8_SB(b, h) + boff + n * 2048 + k * 1024); } } while (0)
#define PG8_MMA(ai, bj, At, Bt) do { __builtin_amdgcn_s_setprio(1); \
        if constexpr (F8) { asm volatile("s_nop 1"); _Pragma("unroll") for (int m = 0; m < 4; ++m) _Pragma("unroll") for (int n = 0; n < 2; ++n) \
            asm volatile("v_mfma_scale_f32_16x16x128_f8f6f4 %0, %1, %2, %0, %3, %3 op_sel_hi:[0,0,0]" : "+v"(acc[ai][bj][m][n]) : "v"(Bt##8[n]), "v"(At##8[m]), "v"(one_scale)); } \
        else { _Pragma("unroll") for (int m = 0; m < 4; ++m) _Pragma("unroll") for (int n = 0; n < 2; ++n) _Pragma("unroll") for (int k = 0; k < 2; ++k) \
            acc[ai][bj][m][n] = __builtin_amdgcn_mfma_f32_16x16x32_bf16(Bt[n][k], At[m][k], acc[ai][bj][m][n], 0, 0, 0); } \
        __builtin_amdgcn_s_setprio(0); } while (0)
#define PG8_WAIT_V(n) asm volatile("s_waitcnt vmcnt(" #n ")" ::: "memory")
#define PG8_WAIT_L(n) asm volatile("s_waitcnt lgkmcnt(" #n ")" ::: "memory")
#define PG8_BAR __builtin_amdgcn_s_barrier()
#define PG8_SCHED __builtin_amdgcn_sched_barrier(0)
    Unit cur, nxt; int ui = 0;
    if (!S.next(0, cur)) return;
    float zero_; asm volatile("v_mov_b32 %0, 0" : "=v"(zero_));
    f32x4 acc[2][2][4][2];
#pragma unroll
    for (int a = 0; a < 2; ++a)
#pragma unroll
        for (int b = 0; b < 2; ++b)
#pragma unroll
            for (int m = 0; m < 4; ++m)
#pragma unroll
                for (int n = 0; n < 2; ++n) acc[a][b][m][n] = (f32x4){0.f, 0.f, 0.f, 0.f};
    const int one_scale = 0x7F7F7F7F; (void)one_scale;
    const char* cA = (const char*)g.A + (size_t)cur.pm * tstep; const char* cB = (const char*)g.Bt + S.boff(cur) + (size_t)cur.pn * tstep;
    S.a_ready(cur);
    if constexpr (SP2) {
        PG8_STAGE(PG8_SB(0, 0), cB, voffB); PG8_STAGE(PG8_SB(0, 1), cB + hstep, voffB); PG8_STAGE(PG8_SA(0, 0), cA, voffA); PG8_STAGE(PG8_SA(0, 1), cA + hstep, voffA);
        if (wr == 1) PG8_BAR;
        PG8_WAIT_V(2); PG8_BAR;
        PG8_STAGE(PG8_SB(1, 0), cB + kstep, voffB); PG8_STAGE(PG8_SA(1, 0), cA + kstep, voffA); PG8_STAGE(PG8_SB(1, 1), cB + hstep + kstep, voffB);
        PG8_WAIT_V(6); PG8_BAR;
    } else {
        PG8_STAGE(PG8_SB(0, 0), cB, voffB); PG8_STAGE(PG8_SA(0, 0), cA, voffA); PG8_STAGE(PG8_SB(0, 1), cB + hstep, voffB); PG8_STAGE(PG8_SA(0, 1), cA + hstep, voffA);
        if (wr == 1) PG8_BAR;
        PG8_WAIT_V(4); PG8_BAR;
        PG8_STAGE(PG8_SB(1, 0), cB + kstep, voffB); PG8_STAGE(PG8_SA(1, 0), cA + kstep, voffA); PG8_STAGE(PG8_SB(1, 1), cB + hstep + kstep, voffB);
        PG8_WAIT_V(6); PG8_BAR;
    }
    for (;;) {
        const bool has_next = S.next(ui + 1, nxt);
        const char* nA = has_next ? (const char*)g.A + (size_t)nxt.pm * tstep : cA; const char* nB = has_next ? (const char*)g.Bt + S.boff(nxt) + (size_t)nxt.pn * tstep : cB;
#pragma nounroll
        for (int t = 0; t < nt; t += 2) {
            bf16x8 At[4][2], B0[2][2], B1[2][2]; v8i_t At8[4], B08[2], B18[2];
            const bool last = (t == nt - 2);
            const char* a1 = cA + (size_t)(t + 1) * kstep;
            const char* a2 = last ? nA : cA + (size_t)(t + 2) * kstep; const char* b2 = last ? nB : cB + (size_t)(t + 2) * kstep;
            const char* a3 = a2 + kstep; const char* b3 = b2 + kstep;
            if (last && has_next) S.a_ready(nxt);
            if (last) { const int tl_ = wid * 64 + (int)__builtin_amdgcn_mbcnt_hi(~0u, __builtin_amdgcn_mbcnt_lo(~0u, 0u)); E.touch(lds, cur, tl_); PG8_SCHED; }
            if constexpr (SP2) {
            PG8_LDB(B0, 0, 0); PG8_LDB(B1, 0, 1); PG8_SCHED; PG8_LDA(At, 0, 0); PG8_STAGE(PG8_SA(1, 1), a1 + hstep, voffA);
            PG8_WAIT_V(8); PG8_WAIT_L(0); PG8_BAR; PG8_MMA(0, 0, At, B0); PG8_MMA(0, 1, At, B1); PG8_BAR; PG8_SCHED;
            PG8_LDA(At, 0, 1); PG8_STAGE(PG8_SB(0, 0), b2, voffB); PG8_STAGE(PG8_SB(0, 1), b2 + hstep, voffB); PG8_STAGE(PG8_SA(0, 0), a2, voffA);
            PG8_WAIT_V(8); PG8_WAIT_L(0); PG8_BAR; PG8_MMA(1, 0, At, B0); PG8_MMA(1, 1, At, B1); PG8_BAR; PG8_SCHED;
            PG8_LDB(B0, 1, 0); PG8_LDB(B1, 1, 1); PG8_SCHED; PG8_LDA(At, 1, 0); PG8_STAGE(PG8_SA(0, 1), a2 + hstep, voffA);
            PG8_WAIT_V(8); PG8_WAIT_L(0); PG8_BAR; PG8_MMA(0, 0, At, B0); PG8_MMA(0, 1, At, B1); PG8_BAR; PG8_SCHED;
            PG8_LDA(At, 1, 1); PG8_STAGE(PG8_SB(1, 0), b3, voffB); PG8_STAGE(PG8_SB(1, 1), b3 + hstep, voffB); PG8_STAGE(PG8_SA(1, 0), a3, voffA);
            PG8_WAIT_V(8); PG8_WAIT_L(0); PG8_BAR; PG8_MMA(1, 0, At, B0); PG8_MMA(1, 1, At, B1); PG8_BAR; PG8_SCHED;
            } else {
            PG8_LDB(B0, 0, 0); PG8_SCHED; PG8_LDA(At, 0, 0); PG8_STAGE(PG8_SA(1, 1), a1 + hstep, voffA);
            PG8_WAIT_L(8); PG8_BAR; PG8_WAIT_L(0); PG8_MMA(0, 0, At, B0); PG8_BAR; PG8_SCHED;
            PG8_LDB(B1, 0, 1); PG8_STAGE(PG8_SB(0, 0), b2, voffB);
            PG8_BAR; PG8_WAIT_L(0); PG8_MMA(0, 1, At, B1); PG8_BAR;
            PG8_LDA(At, 0, 1); PG8_STAGE(PG8_SA(0, 0), a2, voffA);
            PG8_BAR; PG8_WAIT_L(0); PG8_MMA(1, 0, At, B0); PG8_BAR; PG8_SCHED;
            PG8_STAGE(PG8_SB(0, 1), b2 + hstep, voffB);
            PG8_WAIT_V(6); PG8_BAR; PG8_MMA(1, 1, At, B1); PG8_BAR;
            PG8_LDB(B0, 1, 0); PG8_SCHED; PG8_LDA(At, 1, 0); PG8_STAGE(PG8_SA(0, 1), a2 + hstep, voffA);
            PG8_WAIT_L(8); PG8_BAR; PG8_WAIT_L(0); PG8_MMA(0, 0, At, B0); PG8_BAR; PG8_SCHED;
            PG8_LDB(B1, 1, 1); PG8_STAGE(PG8_SB(1, 0), b3, voffB);
            PG8_BAR; PG8_WAIT_L(0); PG8_MMA(0, 1, At, B1); PG8_BAR;
            PG8_LDA(At, 1, 1); PG8_STAGE(PG8_SA(1, 0), a3, voffA);
            PG8_BAR; PG8_WAIT_L(0); PG8_MMA(1, 0, At, B0); PG8_BAR; PG8_SCHED;
            PG8_STAGE(PG8_SB(1, 1), b3 + hstep, voffB);
            PG8_WAIT_V(6); PG8_BAR; PG8_MMA(1, 1, At, B1); PG8_BAR;
            }
        }
        if constexpr (F8) {
            asm volatile("s_nop 7\n\ts_nop 7" ::: "memory");
#pragma unroll
            for (int a_ = 0; a_ < 2; ++a_)
#pragma unroll
                for (int b_ = 0; b_ < 2; ++b_) asm volatile("" : "+v"(acc[a_][b_][0][0]), "+v"(acc[a_][b_][0][1]), "+v"(acc[a_][b_][1][0]), "+v"(acc[a_][b_][1][1]), "+v"(acc[a_][b_][2][0]), "+v"(acc[a_][b_][2][1]), "+v"(acc[a_][b_][3][0]), "+v"(acc[a_][b_][3][1]));
        }
        if constexpr (ALIGN_EPI) { if (wr == 0) PG8_BAR; }
        if constexpr (!Epi::AFTER_DRAIN) { E(acc, cur, wr, wc, fr, fq); if (REPEAT == 13 && Epi::PROBE2) { asm volatile("" ::: "memory"); E(acc, cur, wr, wc, fr, fq); } S.done(cur); }
        if (!has_next) break;
#pragma unroll
        for (int a = 0; a < 2; ++a)
#pragma unroll
            for (int b = 0; b < 2; ++b)
#pragma unroll
                for (int m = 0; m < 4; ++m)
#pragma unroll
                    for (int n = 0; n < 2; ++n) acc[a][b][m][n] = (f32x4){0.f, 0.f, 0.f, 0.f};
        cur = nxt; cA = nA; cB = nB; ++ui;
        if constexpr (ALIGN_EPI) { if (wr == 1) PG8_BAR; }
    }
    PG8_WAIT_V(0);
    if constexpr (!ALIGN_EPI) { if (wr == 0) PG8_BAR; }
    PG8_BAR;
    if constexpr (Epi::AFTER_DRAIN) { E.fused(acc, cur, wr, wc, fr, fq, lds, wid, lane); S.done(cur); }
#undef PG8_SA
#undef PG8_SB
#undef PG8_STAGE
#undef PG8_LDA
#undef PG8_LD16
#undef PG8_LDB
#undef PG8_MMA
#undef PG8_WAIT_V
#undef PG8_WAIT_L
#undef PG8_BAR
#undef PG8_SCHED
}
}


namespace att {
typedef short bf16x8 __attribute__((ext_vector_type(8)));
typedef short s16x4 __attribute__((ext_vector_type(4)));
typedef float f32x16 __attribute__((ext_vector_type(16)));
typedef unsigned u32x4 __attribute__((ext_vector_type(4)));
#define ATT_LAS __attribute__((address_space(3)))
#define SBAR() __builtin_amdgcn_sched_barrier(0)
constexpr int L_V = 0, L_K = 32768, L_KM = 49152, L_WS = 102400;
constexpr int KP_MLA = 400, KT_MLA = 64 * KP_MLA;
constexpr int KP_SB = 272, KT_SB = 64 * KP_SB;
static_assert(L_KM + 2 * KT_MLA <= L_WS && L_K + 2 * KT_SB <= L_WS && L_WS + 8 * 256 <= 131072, "attention LDS map");
constexpr float THR2 = 11.5f;

__device__ __forceinline__ int crow(int r, int hi) { return (r & 3) + 8 * (r >> 2) + 4 * hi; }
__device__ __forceinline__ unsigned cvtpk(float lo, float hi) { unsigned r; asm volatile("v_cvt_pk_bf16_f32 %0, %1, %2" : "=v"(r) : "v"(lo), "v"(hi)); return r; }
__device__ __forceinline__ int v_st(int k, int c) { const int kk = (k & ~0xC) | ((k & 4) << 1) | ((k & 8) >> 1); return ((kk >> 3) * 4 + (c >> 5)) * 512 + ((kk & 7) * 32 + (c & 31)) * 2; }
__device__ __forceinline__ int v_rd_base(int lane) { return ((lane & 3) << 3) | (((lane >> 2) & 3) << 6) | (((lane >> 4) & 1) << 5) | (((lane >> 5) & 1) << 8); }
constexpr int v_rd_off(int d0, int ks, int half) { return d0 * 512 + ks * 4096 + half * 2048; }
template <int OFF> __device__ __forceinline__ s16x4 tr_read(int vb) { s16x4 r; asm volatile("ds_read_b64_tr_b16 %0, %1 offset:%2" : "=&v"(r) : "v"(vb), "i"(OFF) : "memory"); return r; }
template <int D0> __device__ __forceinline__ void pv_one(f32x16& od, int vb, bf16x8 pa0, bf16x8 pa1, bf16x8 pa2, bf16x8 pa3) {
    const s16x4 l0 = tr_read<v_rd_off(D0, 0, 0)>(vb), h0 = tr_read<v_rd_off(D0, 0, 1)>(vb), l1 = tr_read<v_rd_off(D0, 1, 0)>(vb), h1 = tr_read<v_rd_off(D0, 1, 1)>(vb);
    const s16x4 l2 = tr_read<v_rd_off(D0, 2, 0)>(vb), h2 = tr_read<v_rd_off(D0, 2, 1)>(vb), l3 = tr_read<v_rd_off(D0, 3, 0)>(vb), h3 = tr_read<v_rd_off(D0, 3, 1)>(vb);
    asm volatile("s_waitcnt lgkmcnt(0)" ::: "memory"); SBAR();
#define ATT_PK(L, H) (bf16x8){L[0], L[1], L[2], L[3], H[0], H[1], H[2], H[3]}
    od = __builtin_amdgcn_mfma_f32_32x32x16_bf16(pa0, ATT_PK(l0, h0), od, 0, 0, 0);
    od = __builtin_amdgcn_mfma_f32_32x32x16_bf16(pa1, ATT_PK(l1, h1), od, 0, 0, 0);
    od = __builtin_amdgcn_mfma_f32_32x32x16_bf16(pa2, ATT_PK(l2, h2), od, 0, 0, 0);
    od = __builtin_amdgcn_mfma_f32_32x32x16_bf16(pa3, ATT_PK(l3, h3), od, 0, 0, 0);
#undef ATT_PK
}
__device__ __forceinline__ void pv_d0(f32x16* o, int vb, bf16x8 pa0, bf16x8 pa1, bf16x8 pa2, bf16x8 pa3) {
    pv_one<0>(o[0], vb, pa0, pa1, pa2, pa3); pv_one<1>(o[1], vb, pa0, pa1, pa2, pa3); pv_one<2>(o[2], vb, pa0, pa1, pa2, pa3); pv_one<3>(o[3], vb, pa0, pa1, pa2, pa3);
}
template <int ND0, int PITCH> __device__ __forceinline__ void qkt(f32x16& p0, f32x16& p1, const ATT_LAS char* Kt, const bf16x8* qr, int r32, int hi) {
    p0 = f32x16{}; p1 = f32x16{};
    const ATT_LAS char* kb = Kt + r32 * PITCH + hi * 16;
#pragma unroll
    for (int d0 = 0; d0 < ND0; ++d0) {
        const bf16x8 b0 = *(const ATT_LAS bf16x8*)(kb + d0 * 32), b1 = *(const ATT_LAS bf16x8*)(kb + 32 * PITCH + d0 * 32);
        p0 = __builtin_amdgcn_mfma_f32_32x32x16_bf16(b0, qr[d0], p0, 0, 0, 0);
        p1 = __builtin_amdgcn_mfma_f32_32x32x16_bf16(b1, qr[d0], p1, 0, 0, 0); }
}
__device__ __forceinline__ void pack_p(const f32x16& p0, const f32x16& p1, bf16x8& pa0, bf16x8& pa1, bf16x8& pa2, bf16x8& pa3) {
#define ATT_PK4(P, BASE, OUT) do { unsigned a0 = cvtpk(P[BASE + 0], P[BASE + 1]), a1 = cvtpk(P[BASE + 2], P[BASE + 3]);   \
    unsigned b0 = cvtpk(P[BASE + 4], P[BASE + 5]), b1 = cvtpk(P[BASE + 6], P[BASE + 7]);                              \
    auto r0 = __builtin_amdgcn_permlane32_swap(a0, b0, false, false); auto r1 = __builtin_amdgcn_permlane32_swap(a1, b1, false, false); \
    u32x4 w = {r0[0], r1[0], r0[1], r1[1]}; OUT = *reinterpret_cast<bf16x8*>(&w); } while (0)
    ATT_PK4(p0, 0, pa0); ATT_PK4(p0, 8, pa1); ATT_PK4(p1, 0, pa2); ATT_PK4(p1, 8, pa3);
#undef ATT_PK4
}
__device__ __forceinline__ void softmax_tile(f32x16& p0, f32x16& p1, float& m_reg, float& l_reg, float& alpha) {
    float pmax = p0[0];
#pragma unroll
    for (int r = 1; r < 16; ++r) pmax = fmaxf(pmax, p0[r]);
#pragma unroll
    for (int r = 0; r < 16; ++r) pmax = fmaxf(pmax, p1[r]);
    { auto rr = __builtin_amdgcn_permlane32_swap(__float_as_uint(pmax), __float_as_uint(pmax), false, false); pmax = fmaxf(__uint_as_float(rr[0]), __uint_as_float(rr[1])); }
    float mn;
    if (__builtin_expect(__all(pmax - m_reg <= THR2), 1)) { mn = m_reg; alpha = 1.f; }
    else { mn = fmaxf(m_reg, pmax); alpha = __builtin_amdgcn_exp2f(m_reg - mn); m_reg = mn; }
    float ps = 0.f;
#pragma unroll
    for (int r = 0; r < 16; ++r) { p0[r] = __builtin_amdgcn_exp2f(p0[r] - mn); ps += p0[r]; }
#pragma unroll
    for (int r = 0; r < 16; ++r) { p1[r] = __builtin_amdgcn_exp2f(p1[r] - mn); ps += p1[r]; }
    { auto rr = __builtin_amdgcn_permlane32_swap(__float_as_uint(ps), __float_as_uint(ps), false, false); ps = __uint_as_float(rr[0]) + __uint_as_float(rr[1]); }
    l_reg = l_reg * alpha + ps;
}

__device__ __forceinline__ void mla_smpv(f32x16& p0, f32x16& p1, float& m_reg, float& l_reg, f32x16 (&o)[4], ATT_LAS float* al_l, int r32, int hi, int vb) {
    float alpha; softmax_tile(p0, p1, m_reg, l_reg, alpha);
    if (__any(alpha < 1.f)) { if (hi == 0) al_l[r32] = alpha; asm volatile("s_waitcnt lgkmcnt(0)" ::: "memory");
#pragma unroll
        for (int d = 0; d < 4; ++d)
#pragma unroll
            for (int r = 0; r < 16; ++r) o[d][r] *= al_l[crow(r, hi)]; }
    bf16x8 pa0, pa1, pa2, pa3; pack_p(p0, p1, pa0, pa1, pa2, pa3); SBAR();
    pv_d0(o, vb, pa0, pa1, pa2, pa3);
}
__device__ __forceinline__ void store_o_tile(ATT_LAS char* stg, const f32x16 (&o)[4], const float* rl, bf16* Orow0, int lane, int r32, int hi) {
#pragma unroll
    for (int r = 0; r < 16; ++r) { const float sc = rl ? rl[r] : 1.0f; ATT_LAS char* rp = stg + crow(r, hi) * 272 + r32 * 2;
#pragma unroll
        for (int d0 = 0; d0 < 4; ++d0) *(ATT_LAS unsigned short*)(rp + d0 * 64) = (unsigned short)(cvtpk(o[d0][r] * sc, 0.f) & 0xffffu); }
    asm volatile("s_waitcnt lgkmcnt(0)" ::: "memory");
#pragma unroll
    for (int i = 0; i < 8; ++i) { const int q = lane + 64 * i, row = q >> 4, c16 = q & 15;
        const u32x4 v = *(const ATT_LAS u32x4*)(stg + row * 272 + c16 * 16);
        *(u32x4*)(Orow0 + (size_t)row * 1024 + c16 * 8) = v; }
    asm volatile("s_waitcnt lgkmcnt(0)" ::: "memory");
}
__device__ __forceinline__ void mla_unit(ATT_LAS char* lds, const bf16* __restrict__ Q, const bf16* __restrict__ KN, const bf16* __restrict__ KR, const bf16* __restrict__ V, bf16* __restrict__ O, int b, int hd, int qb) {
    int tid_ = threadIdx.x; asm volatile("" : "+v"(tid_));
    const int tid = tid_, wid = __builtin_amdgcn_readfirstlane(tid >> 6), lane = tid & 63, r32 = lane & 31, hi = lane >> 5;
    ATT_LAS char* Vl = lds + L_V; ATT_LAS char* Kl = lds + L_KM; ATT_LAS float* li_l = (ATT_LAS float*)(lds + L_WS) + wid * 64; ATT_LAS float* al_l = li_l + 32;
    const size_t tok0 = (size_t)b * S; const int q0 = qb * 256;
    bf16x8 qr[12];
    { const bf16* Qw = Q + (tok0 + q0 + wid * 32 + r32) * 1536 + hd * 192 + hi * 8;
#pragma unroll
      for (int d0 = 0; d0 < 12; ++d0) qr[d0] = *(const bf16x8*)(Qw + d0 * 16); }
    float m_reg = -1e30f, l_reg = 0.f; f32x16 o[4] = {};
    const int NT = 4 * qb + 4, jw = 4 * qb + (wid >> 1);
    const int sr = tid >> 4, sc = (tid & 15) * 8, vst0 = v_st(sr, sc), vst1 = v_st(32 + sr, sc);
    const bf16* vsrc = V + (tok0 + sr) * 1024 + hd * 128 + sc;
    const bf16* ksrc[3]; int kstr[3], kdst[3];
#pragma unroll
    for (int i = 0; i < 3; ++i) { const int q = tid + 512 * i, krow = q / 24, kc = q - krow * 24;
        ksrc[i] = (kc < 16) ? KN + (tok0 + krow) * 1024 + hd * 128 + kc * 8 : KR + (tok0 + krow) * 64 + (kc - 16) * 8;
        kstr[i] = (kc < 16) ? 64 * 1024 : 64 * 64; kdst[i] = krow * KP_MLA + kc * 16; }
    const int vb0 = (int)(uintptr_t)Vl + v_rd_base(lane);
    bf16x8 vs0, vs1, ks0, ks1, ks2;
#define MLA_SLOAD(j) do { vs0 = *(const bf16x8*)(vsrc + (size_t)(j) * 65536); vs1 = *(const bf16x8*)(vsrc + (size_t)(j) * 65536 + 32 * 1024); \
        ks0 = *(const bf16x8*)(ksrc[0] + (size_t)(j) * kstr[0]); ks1 = *(const bf16x8*)(ksrc[1] + (size_t)(j) * kstr[1]); ks2 = *(const bf16x8*)(ksrc[2] + (size_t)(j) * kstr[2]); } while (0)
#define MLA_SWRITE(kb, vbf) do { *(ATT_LAS bf16x8*)(Vl + (vbf) * 16384 + vst0) = vs0; *(ATT_LAS bf16x8*)(Vl + (vbf) * 16384 + vst1) = vs1; \
        *(ATT_LAS bf16x8*)(Kl + (kb) * KT_MLA + kdst[0]) = ks0; *(ATT_LAS bf16x8*)(Kl + (kb) * KT_MLA + kdst[1]) = ks1; *(ATT_LAS bf16x8*)(Kl + (kb) * KT_MLA + kdst[2]) = ks2; } while (0)
    const bool late = wid >= 4;
    f32x16 p0 = {}, p1 = {};
#define MLA_SMPV(vbuf) mla_smpv(p0, p1, m_reg, l_reg, o, al_l, r32, hi, vb0 + (vbuf) * 16384)
    MLA_SLOAD(0); asm volatile("s_waitcnt vmcnt(0)" ::: "memory"); MLA_SWRITE(0, 0); __syncthreads();
    int vcur = 0;
    for (int j = 0; j < NT; ++j) {
        const int cur = j & 1, vprev = (vcur == 0) ? 2 : vcur - 1, vnext = (vcur == 2) ? 0 : vcur + 1;
        if (j + 1 < NT) MLA_SLOAD(j + 1);
        if (!late && j <= jw) qkt<12, KP_MLA>(p0, p1, Kl + cur * KT_MLA, qr, r32, hi);
        SBAR();
        if (late ? (j >= 1 && j - 1 <= jw) : (j <= jw)) MLA_SMPV(late ? vprev : vcur);
        SBAR();
        if (late && j <= jw) { int r32b = r32; asm volatile("" : "+v"(r32b)); qkt<12, KP_MLA>(p0, p1, Kl + cur * KT_MLA, qr, r32b, hi); }
        if (j + 1 < NT) { asm volatile("s_waitcnt vmcnt(0)" ::: "memory"); MLA_SWRITE(cur ^ 1, vnext); }
        __syncthreads();
        vcur = vnext;
    }
    if (late && NT - 1 <= jw) { const int vlast = (vcur == 0) ? 2 : vcur - 1; MLA_SMPV(vlast); }
    __syncthreads();
#undef MLA_SMPV
#undef MLA_SLOAD
#undef MLA_SWRITE
    if (hi == 0) li_l[r32] = l_reg; asm volatile("s_waitcnt lgkmcnt(0)" ::: "memory");
    bf16* Ow = O + (tok0 + q0 + wid * 32) * 1024 + hd * 128 + r32;
#pragma unroll
    for (int r = 0; r < 16; ++r) { const float rl = __builtin_amdgcn_rcpf(li_l[crow(r, hi)]); const int orow = crow(r, hi);
#pragma unroll
        for (int d0 = 0; d0 < 4; ++d0) Ow[(size_t)orow * 1024 + d0 * 32] = (bf16)(cvtpk(o[d0][r] * rl, 0.f) & 0xffffu); }
}

typedef int v8i __attribute__((ext_vector_type(8)));
typedef int v4i __attribute__((ext_vector_type(4)));
constexpr int L8_K = 0, L8_V = 3 * 13312;
static_assert(L8_V + 3 * 10240 <= L_WS, "fp8 MLA LDS map");
#define MFMA8_32(accv, A, B) asm volatile("s_nop 4\n\tv_mfma_scale_f32_32x32x64_f8f6f4 %0, %1, %2, %0, %3, %3 op_sel_hi:[0,0,0]" : "+v"(accv) : "v"(A), "v"(B), "v"(one_scale))
#define MFMA8_32_Z(accv, A, B) asm volatile("s_nop 4\n\tv_mfma_scale_f32_32x32x64_f8f6f4 %0, %1, %2, 0, %3, %3 op_sel_hi:[0,0,0]" : "=&v"(accv) : "v"(A), "v"(B), "v"(one_scale))
#define MFMA8_32_LAST(accv, A, B) asm volatile("s_nop 1\n\tv_mfma_scale_f32_32x32x64_f8f6f4 %0, %1, %2, %0, %3, %3 op_sel_hi:[0,0,0]\n\ts_nop 15\n\ts_nop 15" : "+v"(accv) : "v"(A), "v"(B), "v"(one_scale))
__device__ __forceinline__ v8i ld32(const ATT_LAS char* p) { const v4i a = *(const ATT_LAS v4i*)p, b = *(const ATT_LAS v4i*)(p + 16); return __builtin_shufflevector(a, b, 0, 1, 2, 3, 4, 5, 6, 7); }
__device__ __forceinline__ unsigned pk4f8(float a, float b, float c, float d) { int w = __builtin_amdgcn_cvt_pk_fp8_f32(a, b, 0, false); w = __builtin_amdgcn_cvt_pk_fp8_f32(c, d, w, true); return (unsigned)w; }
__device__ __forceinline__ void softmax_tile8(f32x16& p0, f32x16& p1, float& m_reg, float& l_reg, float& alpha) {
    float pmax = p0[0];
#pragma unroll
    for (int r = 1; r < 16; ++r) pmax = fmaxf(pmax, p0[r]);
#pragma unroll
    for (int r = 0; r < 16; ++r) pmax = fmaxf(pmax, p1[r]);
    { auto rr = __builtin_amdgcn_permlane32_swap(__float_as_uint(pmax), __float_as_uint(pmax), false, false); pmax = fmaxf(__uint_as_float(rr[0]), __uint_as_float(rr[1])); }
    float mn;
    if (__builtin_expect(__all(pmax - m_reg <= 128.f), 1)) { mn = m_reg; alpha = 1.f; }
    else { mn = fmaxf(m_reg, pmax); alpha = __builtin_amdgcn_exp2f((m_reg - mn) * 0.0625f); m_reg = mn; }
    float ps = 0.f; const float mb = mn * 0.0625f;
#pragma unroll
    for (int r = 0; r < 16; ++r) { p0[r] = __builtin_amdgcn_exp2f(p0[r] * 0.0625f - mb); ps += p0[r]; }
#pragma unroll
    for (int r = 0; r < 16; ++r) { p1[r] = __builtin_amdgcn_exp2f(p1[r] * 0.0625f - mb); ps += p1[r]; }
    { auto rr = __builtin_amdgcn_permlane32_swap(__float_as_uint(ps), __float_as_uint(ps), false, false); ps = __uint_as_float(rr[0]) + __uint_as_float(rr[1]); }
    l_reg = l_reg * alpha + ps;
}
__device__ __forceinline__ void mla8_unit(ATT_LAS char* lds, const unsigned char* __restrict__ Q8, const unsigned char* __restrict__ K8T, const unsigned char* __restrict__ VT8T, bf16* __restrict__ O, int b, int hd, int qb) {
    int tid_ = threadIdx.x; asm volatile("" : "+v"(tid_));
    const int tid = tid_, wid = __builtin_amdgcn_readfirstlane(tid >> 6), lane = tid & 63, r32 = lane & 31, hi = lane >> 5;
    ATT_LAS char* Kl = lds + L8_K; ATT_LAS char* Vl = lds + L8_V; ATT_LAS float* li_l = (ATT_LAS float*)(lds + L_WS) + wid * 64; ATT_LAS float* al_l = li_l + 32;
    const size_t tok0 = (size_t)b * S; const int q0 = qb * 256;
    const int one_scale = 0x7F7F7F7F;
    v8i qr[3];
    { const unsigned char* Qw = Q8 + (tok0 + q0 + wid * 32 + r32) * 1536 + hd * 192 + hi * 32;
#pragma unroll
      for (int d = 0; d < 3; ++d) { const v4i a = *(const v4i*)(Qw + 64 * d), c = *(const v4i*)(Qw + 64 * d + 16); qr[d] = __builtin_shufflevector(a, c, 0, 1, 2, 3, 4, 5, 6, 7); } }
    float m_reg = -1e30f, l_reg = 0.f; f32x16 o[4] = {};
    const int NT = 4 * qb + 4, jw = 4 * qb + (wid >> 1);
    if (wid >= 4) __builtin_amdgcn_s_setprio(1);
    const unsigned char* kt = K8T + (size_t)((b * 8 + hd) * 64) * 13312 + lane * 16;
    const unsigned char* vt = VT8T + (size_t)((b * 8 + hd) * 64) * 10240 + lane * 16;
#define M8_DMA(j, slot) do { _Pragma("unroll") for (int i_ = 0; i_ < 3; ++i_) { int p_ = wid + 8 * i_; p_ = p_ > 22 ? 22 : p_; \
        if (p_ < 13) __builtin_amdgcn_global_load_lds((const unsigned*)(kt + (size_t)(j) * 13312 + p_ * 1024), (ATT_LAS unsigned*)(Kl + (slot) * 13312 + p_ * 1024), 16, 0, 0); \
        else __builtin_amdgcn_global_load_lds((const unsigned*)(vt + (size_t)(j) * 10240 + (p_ - 13) * 1024), (ATT_LAS unsigned*)(Vl + (slot) * 10240 + (p_ - 13) * 1024), 16, 0, 0); } } while (0)
    M8_DMA(0, 0); M8_DMA(1, 1);
    int slot = 0;
    for (int j = 0; j < NT; ++j) {
        if (j + 1 < NT) asm volatile("s_waitcnt vmcnt(3)" ::: "memory"); else asm volatile("s_waitcnt vmcnt(0)" ::: "memory");
        __builtin_amdgcn_s_barrier(); asm volatile("" ::: "memory");
        const int s2 = (slot == 0) ? 2 : slot - 1;
        if (j + 2 < NT) M8_DMA(j + 2, s2);
        if (j <= jw) {
            f32x16 p0, p1;
            const ATT_LAS char* kb = Kl + slot * 13312 + r32 * 208 + hi * 32;
            const ATT_LAS char* vbp = Vl + slot * 10240 + r32 * 80 + hi * 32;
            v8i ka[3], kc[3], vf[4];
#pragma unroll
            for (int d = 0; d < 3; ++d) { ka[d] = ld32(kb + 64 * d); kc[d] = ld32(kb + 32 * 208 + 64 * d); }
            MFMA8_32_Z(p0, ka[0], qr[0]); MFMA8_32_Z(p1, kc[0], qr[0]);
#pragma unroll
            for (int d = 1; d < 3; ++d) { MFMA8_32(p0, ka[d], qr[d]); MFMA8_32(p1, kc[d], qr[d]); }
#pragma unroll
            for (int d0 = 0; d0 < 4; ++d0) vf[d0] = ld32(vbp + d0 * 32 * 80);
            asm volatile("s_nop 15\n\ts_nop 15" : "+v"(p0), "+v"(p1));
            float alpha; softmax_tile8(p0, p1, m_reg, l_reg, alpha);
            if (__any(alpha < 1.f)) { if (hi == 0) al_l[r32] = alpha; asm volatile("s_waitcnt lgkmcnt(0)" ::: "memory");
#pragma unroll
                for (int d = 0; d < 4; ++d)
#pragma unroll
                    for (int r = 0; r < 16; ++r) o[d][r] *= al_l[crow(r, hi)]; }
            v8i pf;
#pragma unroll
            for (int g = 0; g < 4; ++g) { const unsigned ag = pk4f8(p0[4 * g], p0[4 * g + 1], p0[4 * g + 2], p0[4 * g + 3]), bg = pk4f8(p1[4 * g], p1[4 * g + 1], p1[4 * g + 2], p1[4 * g + 3]);
                auto rr = __builtin_amdgcn_permlane32_swap(ag, bg, false, false); pf[2 * g] = (int)rr[0]; pf[2 * g + 1] = (int)rr[1]; }
#pragma unroll
            for (int d0 = 0; d0 < 4; ++d0) MFMA8_32(o[d0], pf, vf[d0]);
            asm volatile("s_nop 15\n\ts_nop 15" : "+v"(o[0]), "+v"(o[1]), "+v"(o[2]), "+v"(o[3]));
        }
        slot = (slot == 2) ? 0 : slot + 1;
    }
#undef M8_DMA
    __builtin_amdgcn_s_setprio(0);
    __builtin_amdgcn_s_barrier(); asm volatile("" ::: "memory");
    if (hi == 0) li_l[r32] = l_reg; asm volatile("s_waitcnt lgkmcnt(0)" ::: "memory");
    float rl[16];
#pragma unroll
    for (int r = 0; r < 16; ++r) rl[r] = __builtin_amdgcn_rcpf(li_l[crow(r, hi)]);
    store_o_tile(lds + wid * 8704, o, rl, O + (tok0 + q0 + wid * 32) * 1024 + hd * 128, lane, r32, hi);
    __builtin_amdgcn_s_barrier(); asm volatile("" ::: "memory");
}

__device__ __forceinline__ void sb_unit(ATT_LAS char* lds, volatile ATT_LAS unsigned* done, unsigned seq, const bf16* __restrict__ Q, const bf16* __restrict__ K, const bf16* __restrict__ V, bf16* __restrict__ O, int b, int hd, int qb) {
    int tid_ = threadIdx.x; asm volatile("" : "+v"(tid_));
    const int tid = tid_, wid = __builtin_amdgcn_readfirstlane(tid >> 6), lane = tid & 63, r32 = lane & 31, hi = lane >> 5;
    ATT_LAS char* Vl = lds + L_V; ATT_LAS char* Kl = lds + L_K;
    const size_t tok0 = (size_t)b * S; const int q0 = qb * 256;
    bf16x8 qr[8];
    { const bf16* Qw = Q + (tok0 + q0 + wid * 32 + r32) * 1024 + hd * 128 + hi * 8;
#pragma unroll
      for (int d0 = 0; d0 < 8; ++d0) qr[d0] = *(const bf16x8*)(Qw + d0 * 16); }
    float carry = 1.f; f32x16 o[4] = {}; bool wdone = false;
    if (wid >= 4) __builtin_amdgcn_s_setprio(1);
    const int NT = 4 * qb + 4, jw = 4 * qb + (wid >> 1), lim = 32 * (wid & 1) + r32;
    const int sr = tid >> 4, sc = (tid & 15) * 8, vst0 = v_st(sr, sc), vst1 = v_st(32 + sr, sc), kst0 = sr * KP_SB + sc * 2, kst1 = (32 + sr) * KP_SB + sc * 2;
    const bf16* vsrc = V + (tok0 + sr) * 1024 + hd * 128 + sc; const bf16* ksrc = K + (tok0 + sr) * 1024 + hd * 128 + sc;
    const int vb0 = (int)(uintptr_t)Vl + v_rd_base(lane);
    bf16x8 vs0, vs1, ks0, ks1;
#define SB_SLOAD(j) do { vs0 = *(const bf16x8*)(vsrc + (size_t)(j) * 65536); vs1 = *(const bf16x8*)(vsrc + (size_t)(j) * 65536 + 32 * 1024); \
        ks0 = *(const bf16x8*)(ksrc + (size_t)(j) * 65536); ks1 = *(const bf16x8*)(ksrc + (size_t)(j) * 65536 + 32 * 1024); } while (0)
#define SB_SWRITE(bf) do { *(ATT_LAS bf16x8*)(Vl + (bf) * 16384 + vst0) = vs0; *(ATT_LAS bf16x8*)(Vl + (bf) * 16384 + vst1) = vs1; \
        *(ATT_LAS bf16x8*)(Kl + (bf) * KT_SB + kst0) = ks0; *(ATT_LAS bf16x8*)(Kl + (bf) * KT_SB + kst1) = ks1; } while (0)
    SB_SLOAD(NT - 1); asm volatile("s_waitcnt vmcnt(0)" ::: "memory"); SB_SWRITE(0); __syncthreads();
    for (int it = 0; it < NT; ++it) {
        const int cur = it & 1, j = NT - 1 - it;
        if (it + 1 < NT) SB_SLOAD(j - 1);
        if (j <= jw && !wdone) {
            f32x16 p0, p1, r0, r1;
            qkt<8, KP_SB>(p0, p1, Kl + cur * KT_SB, qr, r32, hi);
#pragma unroll
            for (int r = 0; r < 16; ++r) { const float e0 = __builtin_amdgcn_exp2f(fminf(p0[r], 64.f)), e1 = __builtin_amdgcn_exp2f(fminf(p1[r], 64.f));
                r0[r] = __builtin_amdgcn_rcpf(1.0f + e0); r1[r] = __builtin_amdgcn_rcpf(1.0f + e1); p0[r] = e0 * r0[r]; p1[r] = e1 * r1[r]; }
            if (j == jw) {
#pragma unroll
                for (int r = 0; r < 16; ++r) { const int key = crow(r, hi); if (key >= lim) { r0[r] = 1.f; p0[r] = 0.f; } if (key + 32 >= lim) { r1[r] = 1.f; p1[r] = 0.f; } }
            }
            float T[8], U[8], Tp[8];
#pragma unroll
            for (int g = 0; g < 4; ++g) {
                { const float a0 = r0[4 * g], a1 = r0[4 * g + 1], a2 = r0[4 * g + 2], a3 = r0[4 * g + 3]; const float x2 = a3, x1 = x2 * a2, x0 = x1 * a1; T[g] = x0 * a0; r0[4 * g] = x0; r0[4 * g + 1] = x1; r0[4 * g + 2] = x2; r0[4 * g + 3] = 1.f; }
                { const float a0 = r1[4 * g], a1 = r1[4 * g + 1], a2 = r1[4 * g + 2], a3 = r1[4 * g + 3]; const float x2 = a3, x1 = x2 * a2, x0 = x1 * a1; T[4 + g] = x0 * a0; r1[4 * g] = x0; r1[4 * g + 1] = x1; r1[4 * g + 2] = x2; r1[4 * g + 3] = 1.f; }
            }
#pragma unroll
            for (int g = 0; g < 8; ++g) { auto rr = __builtin_amdgcn_permlane32_swap(__float_as_uint(T[g]), __float_as_uint(T[g]), false, false); const float ta = __uint_as_float(rr[0]), tb = __uint_as_float(rr[1]); U[g] = ta * tb; Tp[g] = hi ? 1.f : tb; }
            float W = carry;
#pragma unroll
            for (int g = 7; g >= 0; --g) { const float F = W * Tp[g];
                if (g >= 4) { const int q = g - 4;
#pragma unroll
                    for (int e = 0; e < 4; ++e) p1[4 * q + e] *= r1[4 * q + e] * F; }
                else {
#pragma unroll
                    for (int e = 0; e < 4; ++e) p0[4 * g + e] *= r0[4 * g + e] * F; }
                W *= U[g]; }
            carry = W;
            bf16x8 pa0, pa1, pa2, pa3; pack_p(p0, p1, pa0, pa1, pa2, pa3); SBAR();
            pv_d0(o, vb0 + cur * 16384, pa0, pa1, pa2, pa3);
            wdone = __all(carry == 0.f);
        }
        if (wdone && lane == 0) done[(it & 1) * 8 + wid] = seq;
        if (it + 1 < NT) { asm volatile("s_waitcnt vmcnt(0)" ::: "memory"); SB_SWRITE(cur ^ 1); }
        __syncthreads();
        { const unsigned dv = (lane < 8) ? done[(it & 1) * 8 + lane] : seq; if (__all(dv == seq)) break; }
    }
#undef SB_SLOAD
#undef SB_SWRITE
    __builtin_amdgcn_s_setprio(0);
    store_o_tile(lds + wid * 8704, o, nullptr, O + (tok0 + q0 + wid * 32) * 1024 + hd * 128, lane, r32, hi);
    __syncthreads();
}
__device__ __forceinline__ void unit_of(int u, int& b, int& hd, int& qb) { const int bh = (u & 255) >> 2, s = u & 3, k = u >> 8; b = bh >> 3; hd = bh & 7; qb = (k == 0) ? s : (k == 1) ? 7 - s : (k == 2) ? 8 + s : 15 - s; }
}

#define LAS __attribute__((address_space(3)))
#define GAS __attribute__((address_space(1)))
constexpr int NWAVES = 8;
constexpr int RING_BYTES = 131072, LDSCTL_OFF = RING_BYTES, LDS_BYTES = 147456; static_assert(pg8::TOUCH_SINK >= LDSCTL_OFF + 1024 && pg8::TOUCH_SINK + 256 <= LDS_BYTES, "touch sink");
constexpr int LC_PTR = 0, LC_BAR = 96, LC_SBDONE = 128;

#define XB_TMO      128
#define XB_XCNT(j)  (256  + 64 * (j))
#define XB_XSUB(j)  (1280 + 64 * (j))
#define XB_XGEN(j)  (2304 + 64 * (j))
#define XB_TOP      3328
#define XB_TOPGEN   3392
#define XCD_BAR_WORDS 3456
#define XB_SPIN_CAP (1u << 18)

__device__ __forceinline__ unsigned xb_ld(unsigned* p)              { return __hip_atomic_load(p, __ATOMIC_RELAXED, __HIP_MEMORY_SCOPE_AGENT); }
__device__ __forceinline__ unsigned xb_add(unsigned* p, unsigned v) { return __hip_atomic_fetch_add(p, v, __ATOMIC_RELAXED, __HIP_MEMORY_SCOPE_AGENT); }
__device__ __forceinline__ unsigned xb_xcc_id() { return (unsigned)__builtin_amdgcn_s_getreg((3 << 11) | 20) & 0xFu; }
#define XB_SPIN(cond, bar) do { unsigned _sp = 0; while (cond) { __builtin_amdgcn_s_sleep(1); \
    if ((++_sp & 255u) == 0u) { if (xb_ld(&(bar)[XB_TMO])) break; if (_sp > XB_SPIN_CAP) { atomicAdd(&(bar)[XB_TMO], 1u); break; } } } } while (0)

struct XcdBarrier {
    unsigned* bar; unsigned x;
    volatile LAS unsigned* st;
};

__device__ __forceinline__ XcdBarrier xcd_barrier_post(unsigned* bar, volatile LAS unsigned* st) {
    XcdBarrier b; b.bar = bar; b.x = xb_xcc_id(); b.st = st;
    if (threadIdx.x == 0) (void)xb_add(&bar[XB_XCNT(b.x)], 1u);
    return b;
}
__device__ __forceinline__ void xcd_barrier_complete(unsigned* bar, unsigned x, unsigned& nloc, unsigned& nx) {
    const unsigned G = gridDim.x * gridDim.y * gridDim.z;
    unsigned sum, cnt, mine, sp = 0u;
    for (;;) {
        sum = 0u; cnt = 0u; mine = 0u;
        unsigned cv[16];
        { const unsigned* mid = &bar[XB_XCNT(8)];
          asm volatile("global_load_dword %0, %16, off offset:-2048 sc1\n\tglobal_load_dword %1, %16, off offset:-1792 sc1\n\tglobal_load_dword %2, %16, off offset:-1536 sc1\n\tglobal_load_dword %3, %16, off offset:-1280 sc1\n\t"
                       "global_load_dword %4, %16, off offset:-1024 sc1\n\tglobal_load_dword %5, %16, off offset:-768 sc1\n\tglobal_load_dword %6, %16, off offset:-512 sc1\n\tglobal_load_dword %7, %16, off offset:-256 sc1\n\t"
                       "global_load_dword %8, %16, off sc1\n\tglobal_load_dword %9, %16, off offset:256 sc1\n\tglobal_load_dword %10, %16, off offset:512 sc1\n\tglobal_load_dword %11, %16, off offset:768 sc1\n\t"
                       "global_load_dword %12, %16, off offset:1024 sc1\n\tglobal_load_dword %13, %16, off offset:1280 sc1\n\tglobal_load_dword %14, %16, off offset:1536 sc1\n\tglobal_load_dword %15, %16, off offset:1792 sc1\n\ts_waitcnt vmcnt(0)"
                       : "=&v"(cv[0]), "=&v"(cv[1]), "=&v"(cv[2]), "=&v"(cv[3]), "=&v"(cv[4]), "=&v"(cv[5]), "=&v"(cv[6]), "=&v"(cv[7]), "=&v"(cv[8]), "=&v"(cv[9]), "=&v"(cv[10]), "=&v"(cv[11]), "=&v"(cv[12]), "=&v"(cv[13]), "=&v"(cv[14]), "=&v"(cv[15])
                       : "v"(mid) : "memory"); }
        static_assert(XB_XCNT(1) - XB_XCNT(0) == 64, "census words are 256 bytes apart");
#pragma unroll
        for (unsigned j = 0; j < 16; ++j) { const unsigned c = cv[j]; sum += c; cnt += (c > 0u) ? 1u : 0u; mine = (j == x) ? c : mine; }
        if (sum == G) break;
        __builtin_amdgcn_s_sleep(1);
        if ((++sp & 255u) == 0u) { if (xb_ld(&bar[XB_TMO])) break; if (sp > XB_SPIN_CAP) { atomicAdd(&bar[XB_TMO], 1u); break; } }
    }
    nloc = mine > 0u ? mine : 1u; nx = cnt > 0u ? cnt : 1u;
}

__device__ __forceinline__ void xcd_barrier(const XcdBarrier& b) {
    asm volatile("s_waitcnt vmcnt(0)" ::: "memory");
    __syncthreads();
    if (threadIdx.x == 0) {
        unsigned* bar = b.bar;
        __builtin_amdgcn_s_waitcnt(0);
        unsigned nloc = b.st[0], nx = b.st[1];
        if (nloc == 0u) { xcd_barrier_complete(bar, b.x, nloc, nx); b.st[0] = nloc; b.st[1] = nx; }
        const unsigned old = xb_add(&bar[XB_XSUB(b.x)], 1u);
        const unsigned gen = old / nloc;
        if (old + 1u == (gen + 1u) * nloc) {
            __builtin_amdgcn_fence(__ATOMIC_RELEASE, "agent");
            asm volatile("s_waitcnt vmcnt(0)" ::: "memory");
            const unsigned og = xb_add(&bar[XB_TOP], 1u);
            const unsigned tg = og / nx;
            if (og + 1u == (tg + 1u) * nx) xb_add(&bar[XB_TOPGEN], 1u);
            else XB_SPIN(xb_ld(&bar[XB_TOPGEN]) == tg, bar);
            __builtin_amdgcn_fence(__ATOMIC_ACQUIRE, "agent");
            xb_add(&bar[XB_XGEN(b.x)], 1u);
            asm volatile("s_waitcnt vmcnt(0)" ::: "memory");
        } else {
            XB_SPIN(xb_ld(&bar[XB_XGEN(b.x)]) == gen, bar);
            __builtin_amdgcn_fence(__ATOMIC_ACQUIRE, "agent");
            asm volatile("s_waitcnt vmcnt(0)" ::: "memory");
        }
    }
    __syncthreads();
}


constexpr int PH_PRO = 0;
__host__ __device__ constexpr int PH(int l, int k) { return 1 + l * 10 + k; }
constexpr int PH_END = PH(3, 8) + 1;

struct MatDesc { int in_idx, gain_idx, K, N, mode, rowoff; long long src_off; long long dst_off; };
constexpr long long WSM = (long long)WS_WSMALL, WMO = (long long)WS_WMOE;
constexpr long long OFF_WD0 = WSM, OFF_WUQ0 = OFF_WD0 + 768LL * 1024 * 2, OFF_WUKV0 = OFF_WUQ0 + 1536LL * 384 * 2, OFF_WO0 = OFF_WUKV0 + 2048LL * 256 * 2;
constexpr long long OFF_WD1 = OFF_WO0 + 1024LL * 1024 * 2, OFF_WUQ1 = OFF_WD1 + 768LL * 1024 * 2, OFF_WUKV1 = OFF_WUQ1 + 1536LL * 384 * 2, OFF_WO1 = OFF_WUKV1 + 2048LL * 256 * 2;
constexpr long long OFF_WGU0 = OFF_WO1 + 1024LL * 1024 * 2, OFF_WDN0 = OFF_WGU0 + 5632LL * 1024 * 2;
constexpr long long OFF_WGU2 = OFF_WDN0 + 1024LL * 2816 * 2, OFF_WDN2 = OFF_WGU2 + 5632LL * 1024 * 2;
constexpr long long OFF_WKVQ = OFF_WDN2 + 1024LL * 2816 * 2, OFF_WQ3 = OFF_WKVQ + 3072LL * 1024 * 2, OFF_WO2 = OFF_WQ3 + 1024LL * 1024 * 2, OFF_WO3 = OFF_WO2 + 1024LL * 1024 * 2;
constexpr long long OFF_WSM_END = OFF_WO3 + 1024LL * 1024 * 2;
static_assert(OFF_WSM_END <= (long long)WS_WMOE, "small weights fit");
constexpr long long MOE_GU_BYTES = 5632LL * 1024, MOE_DN_BYTES = 1024LL * 2816;
constexpr long long OFF_MGU = WMO, OFF_MDN = WMO + 8 * MOE_GU_BYTES;
constexpr int NMAT_SMALL = 18;
__device__ const MatDesc g_mats[NMAT_SMALL] = {
    {3, 2, 1024, 704, 1, 0, 0, OFF_WD0}, {5, 4, 384, 1536, 2, 0, 0, OFF_WUQ0}, {7, 6, 256, 2048, 4, 0, 0, OFF_WUKV0}, {8, -1, 1024, 1024, 0, 0, 0, OFF_WO0},
    {13, 12, 1024, 704, 1, 0, 0, OFF_WD1}, {15, 14, 384, 1536, 2, 0, 0, OFF_WUQ1}, {17, 16, 256, 2048, 4, 0, 0, OFF_WUKV1}, {18, -1, 1024, 1024, 0, 0, 0, OFF_WO1},
    {10, 9, 1024, 5632, 3, 0, 0, OFF_WGU0}, {11, -1, 2816, 1024, 0, 0, 0, OFF_WDN0},
    {29, 28, 1024, 5632, 3, 0, 0, OFF_WGU2}, {30, -1, 2816, 1024, 0, 0, 0, OFF_WDN2},
    {24, 23, 1024, 2048, 0, 0, 0, OFF_WKVQ}, {26, 25, 1024, 1024, 0, 2048, 0, OFF_WKVQ}, {32, 31, 1024, 1024, 0, 0, 0, OFF_WQ3},
    {27, -1, 1024, 1024, 0, 0, 0, OFF_WO2}, {33, -1, 1024, 1024, 0, 0, 0, OFF_WO3},
    {3, 2, 0, 0, 9, 0, 0, OFF_WD0}
};
__device__ __forceinline__ int map_row(int mode, int n) {
    if (mode == 1) { return n < 640 ? n : (n < 672 ? 640 + 2 * (n - 640) : 641 + 2 * (n - 672)); }
    if (mode == 2) { const int hd = n / 192, d = n - hd * 192; return d < 128 ? n : (d < 160 ? hd * 192 + 128 + 2 * (d - 128) : hd * 192 + 129 + 2 * (d - 160)); }
    if (mode == 4) { const int hd = n >> 8, d = n & 255; return d < 128 ? hd * 128 + d : 1024 + hd * 128 + (d - 128); }
    if (mode == 3) { if (n < 2816) return 256 * (n >> 7) + (n & 127); const int n2 = n - 2816; return 256 * (n2 >> 7) + 128 + (n2 & 127); }
    return n;
}
typedef unsigned v4u __attribute__((ext_vector_type(4)));
struct ConvJob { const float* W; const float* gain; bf16* WT; int K, N, mode, rowoff, k0, n0; int f8; float wscale; int tiled; int pad; };
constexpr int CONV_PITCH = 129, SMALL_ITEMS = 2 * (48 + 36 + 32 + 64) + 2 * (352 + 176) + 128 + 64 + 64 + 64 + 64, MOE_ITEMS_E = 352 + 176, MOE_ITEMS = NE * MOE_ITEMS_E;
__device__ __forceinline__ void conv_load(const ConvJob& J, int t, f32x4 (&v)[8], float (&gk)[8]) {
    const int lane = t & 63, wave = t >> 6, n = J.n0 + 4 * ((lane & 7) + 8 * (wave & 3)), r0 = (wave >> 2) * 8 + (lane >> 3);
#pragma unroll
    for (int i = 0; i < 8; ++i) { const int k = J.k0 + r0 + 16 * i;
        v[i] = (n < J.N) ? __builtin_nontemporal_load((const f32x4*)(J.W + (size_t)k * J.N + n)) : (f32x4){0.f, 0.f, 0.f, 0.f};
        gk[i] = (J.gain ? J.gain[k] : 1.0f) * J.wscale; }
}
__device__ __forceinline__ void conv_to_lds(LAS float* scr, int t, const f32x4 (&v)[8], const float (&gk)[8]) {
    const int lane = t & 63, wave = t >> 6, c = 4 * ((lane & 7) + 8 * (wave & 3)), r0 = (wave >> 2) * 8 + (lane >> 3);
#pragma unroll
    for (int i = 0; i < 8; ++i) { LAS float* p = scr + (r0 + 16 * i) * CONV_PITCH + c; const f32x4 x = v[i] * gk[i]; p[0] = x[0]; p[1] = x[1]; p[2] = x[2]; p[3] = x[3]; }
}
__device__ __forceinline__ void conv_store(const ConvJob& J, const LAS float* scr, int t) {
    if (J.f8) {
        const int c = t >> 6, n_l = t & 63;
#pragma unroll
        for (int jj = 0; jj < 2; ++jj) { const int n = n_l + 64 * jj;
            if (J.n0 + n < J.N) { const LAS float* sp = scr + (16 * c) * CONV_PITCH + n;
                v4u o;
                o.x = pg8::pk4_fp8_nc(sp[0 * CONV_PITCH], sp[1 * CONV_PITCH], sp[2 * CONV_PITCH], sp[3 * CONV_PITCH]); o.y = pg8::pk4_fp8_nc(sp[4 * CONV_PITCH], sp[5 * CONV_PITCH], sp[6 * CONV_PITCH], sp[7 * CONV_PITCH]);
                o.z = pg8::pk4_fp8_nc(sp[8 * CONV_PITCH], sp[9 * CONV_PITCH], sp[10 * CONV_PITCH], sp[11 * CONV_PITCH]); o.w = pg8::pk4_fp8_nc(sp[12 * CONV_PITCH], sp[13 * CONV_PITCH], sp[14 * CONV_PITCH], sp[15 * CONV_PITCH]);
                const int row = J.rowoff + map_row(J.mode, J.n0 + n), k = J.k0 + 16 * c;
                if (J.tiled) *(v4u*)((unsigned char*)J.WT + (((size_t)(row >> 8) * (J.K >> 7) + (k >> 7)) * 256 + (row & 255)) * 128 + (k & 127)) = o;
                else *(v4u*)((unsigned char*)J.WT + (size_t)row * J.K + k) = o; } }
        return;
    }
    const int c_lo = t & 7, n_l = t >> 3;
#pragma unroll
    for (int jj = 0; jj < 4; ++jj) { const int n = n_l + 64 * (jj >> 1), c = c_lo + 8 * (jj & 1);
        if (J.n0 + n < J.N) { const LAS float* sp = scr + (8 * c) * CONV_PITCH + n;
            v4u o; o.x = pk2(sp[0 * CONV_PITCH], sp[1 * CONV_PITCH]); o.y = pk2(sp[2 * CONV_PITCH], sp[3 * CONV_PITCH]); o.z = pk2(sp[4 * CONV_PITCH], sp[5 * CONV_PITCH]); o.w = pk2(sp[6 * CONV_PITCH], sp[7 * CONV_PITCH]);
            const int row = J.rowoff + map_row(J.mode, J.n0 + n), k = J.k0 + 8 * c;
            if (J.tiled) *(v4u*)(J.WT + (((size_t)(row >> 8) * (J.K >> 6) + (k >> 6)) * 256 + (row & 255)) * 64 + (k & 63)) = o;
            else *(v4u*)(J.WT + (size_t)row * J.K + k) = o; } }
}

#ifndef SITES
#define SITES 0xffff
#endif
#define SITE(n) (((SITES) >> (n)) & 1)
#ifndef REPEAT
#define REPEAT -1
#endif
#define DUMMY(k) ((REPEAT == (k)) && rep_ == 0)
#define REP(k) for (int rep_ = 0; rep_ < ((REPEAT == (k)) ? 2 : 1); ++rep_)

#define RLX_AGENT __ATOMIC_RELAXED, __HIP_MEMORY_SCOPE_AGENT
__device__ __forceinline__ void prep_rows2(const float* __restrict__ x, const int* __restrict__ pos, bf16* __restrict__ hb, float* __restrict__ ss, float2* __restrict__ cs, int m0, int m1, int lane) {
    const f32x4* xa = (const f32x4*)(x + (size_t)m0 * D) + lane; const f32x4* xb = (const f32x4*)(x + (size_t)m1 * D) + lane;
    f32x4 va[4], vb[4];
#pragma unroll
    for (int j = 0; j < 4; ++j) { va[j] = __builtin_nontemporal_load(xa + 64 * j); vb[j] = __builtin_nontemporal_load(xb + 64 * j); }
    const int pa = pos[m0], pb = pos[m1];
#pragma unroll
    for (int t = 0; t < 2; ++t) { const int m = t ? m1 : m0; float s = 0.f;
#pragma unroll
        for (int j = 0; j < 4; ++j) { const f32x4 v = t ? vb[j] : va[j]; s += (v.x * v.x + v.y * v.y) + (v.z * v.z + v.w * v.w);
            u32x2 o; o.x = pk2(v.x, v.y); o.y = pk2(v.z, v.w); *((u32x2*)(hb + (size_t)m * D) + lane + 64 * j) = o; }
        s = wave_sum(s);
        if (lane < 16) ss[(size_t)m * 16 + lane] = (lane == 0) ? s : 0.f;
        if (lane < 32) {
            const float inv_freq = 1.0f / powf(10000.0f, (float)(2 * lane) / 64.0f);
            const float ang = (float)(t ? pb : pa) * inv_freq;
            double tt = (double)ang * 0.15915494309189535; tt -= floor(tt);
            const float a = (float)(tt * 6.283185307179586);
            cs[(size_t)m * 32 + lane] = make_float2(cosf(a), sinf(a));
        }
    }
}
__device__ __forceinline__ void router_load(LAS float* T, const float* __restrict__ gain, const float* __restrict__ R, int tid) {
    for (int i = tid; i < 1024; i += NWAVES * 64) { const int jq = i >> 6, ln = i & 63, k = 4 * ln + 256 * (jq >> 2) + (jq & 3); const float g = gain[k];
        const f32x4 r0 = *(const f32x4*)(R + (size_t)k * NE), r1 = *(const f32x4*)(R + (size_t)k * NE + 4);
        *(LAS f32x4*)(T + (size_t)i * 8) = r0 * g; *(LAS f32x4*)(T + (size_t)i * 8 + 4) = r1 * g; }
}
__device__ __forceinline__ void route_dot4(const LAS float* T, const u32x2 (&hw)[4][4], int lane, float (&acc)[4][NE]) {
#pragma unroll
    for (int r = 0; r < 4; ++r)
#pragma unroll
        for (int e = 0; e < NE; ++e) acc[r][e] = 0.f;
#pragma unroll
    for (int j = 0; j < 4; ++j)
#pragma unroll
        for (int q = 0; q < 4; ++q) { const LAS float* tp = T + (size_t)((4 * j + q) * 64 + lane) * 8; const f32x4 w0 = *(const LAS f32x4*)tp, w1 = *(const LAS f32x4*)(tp + 4);
#pragma unroll
            for (int r = 0; r < 4; ++r) { const unsigned wd = (q < 2) ? hw[r][j].x : hw[r][j].y; const float h = (q & 1) ? bf2f(wd >> 16) : bf2f(wd);
                acc[r][0] += h * w0[0]; acc[r][1] += h * w0[1]; acc[r][2] += h * w0[2]; acc[r][3] += h * w0[3]; acc[r][4] += h * w1[0]; acc[r][5] += h * w1[1]; acc[r][6] += h * w1[2]; acc[r][7] += h * w1[3]; } }
}
__device__ __forceinline__ void route_row(const float (&acc)[NE], float rstd, int lane, int& i1, int& i2, float& g1, float& g2) {
    const bool b0 = lane & 1, b1 = lane & 2, b2 = lane & 4;
    float w4[4], x2[2], y;
#pragma unroll
    for (int i = 0; i < 4; ++i) { const float snd = b0 ? acc[i] : acc[4 + i], kp = b0 ? acc[4 + i] : acc[i]; w4[i] = kp + __shfl_xor(snd, 1); }
#pragma unroll
    for (int i = 0; i < 2; ++i) { const float snd = b1 ? w4[i] : w4[2 + i], kp = b1 ? w4[2 + i] : w4[i]; x2[i] = kp + __shfl_xor(snd, 2); }
    { const float snd = b2 ? x2[0] : x2[1], kp = b2 ? x2[1] : x2[0]; y = kp + __shfl_xor(snd, 4); }
    y += __shfl_xor(y, 8); y += __shfl_xor(y, 16); y += __shfl_xor(y, 32);
    y *= rstd;
    float lg[NE];
#pragma unroll
    for (int e = 0; e < NE; ++e) lg[e] = __uint_as_float(__builtin_amdgcn_readlane(__float_as_uint(y), (e >> 2) + 2 * ((e >> 1) & 1) + 4 * (e & 1)));
    i1 = 0; float v1 = lg[0];
#pragma unroll
    for (int e = 1; e < NE; ++e) if (lg[e] > v1) { v1 = lg[e]; i1 = e; }
    i2 = -1; float v2 = -3.0e38f;
#pragma unroll
    for (int e = 0; e < NE; ++e) if (e != i1 && lg[e] > v2) { v2 = lg[e]; i2 = e; }
    const float e2 = __expf(v2 - v1); g1 = 1.0f / (1.0f + e2); g2 = e2 / (1.0f + e2);
}
template <bool FINAL>
__device__ __forceinline__ bool combine_rows2(const bf16* hbin, bf16* hbout, float* __restrict__ outf, const bf16* __restrict__ y, const int2* __restrict__ tokslot, float* __restrict__ ss, const float* __restrict__ gfin, int m0, int m1, int lane, int thr, int pass, const int2 ta, const int2 tb) {
    { const int mx_ = max(max(ta.x, ta.y), max(tb.x, tb.y)); const bool touch = __builtin_amdgcn_readfirstlane(mx_) >= thr;
      if (touch != (pass != 0)) return false; }
    u32x2 ha[4], hc[4], ya1[4], ya2[4], yb1[4], yb2[4];
#pragma unroll
    for (int j = 0; j < 4; ++j) { ha[j] = *((const u32x2*)(hbin + (size_t)m0 * D) + lane + 64 * j); hc[j] = *((const u32x2*)(hbin + (size_t)m1 * D) + lane + 64 * j); }
#pragma unroll
    for (int j = 0; j < 4; ++j) { ya1[j] = *((const u32x2*)(y + (size_t)ta.x * D) + lane + 64 * j); ya2[j] = *((const u32x2*)(y + (size_t)ta.y * D) + lane + 64 * j);
                                  yb1[j] = *((const u32x2*)(y + (size_t)tb.x * D) + lane + 64 * j); yb2[j] = *((const u32x2*)(y + (size_t)tb.y * D) + lane + 64 * j); }
#pragma unroll
    for (int t = 0; t < 2; ++t) {
        const int m = t ? m1 : m0; f32x4 v[4]; float s = 0.f;
#pragma unroll
        for (int j = 0; j < 4; ++j) { const u32x2 hw = t ? hc[j] : ha[j], a = t ? yb1[j] : ya1[j], c = t ? yb2[j] : ya2[j];
            v[j].x = bf2f(hw.x) + (bf2f(a.x) + bf2f(c.x)); v[j].y = bf2f(hw.x >> 16) + (bf2f(a.x >> 16) + bf2f(c.x >> 16)); v[j].z = bf2f(hw.y) + (bf2f(a.y) + bf2f(c.y)); v[j].w = bf2f(hw.y >> 16) + (bf2f(a.y >> 16) + bf2f(c.y >> 16));
            s += (v[j].x * v[j].x + v[j].y * v[j].y) + (v[j].z * v[j].z + v[j].w * v[j].w); }
        s = wave_sum(s);
        if (!FINAL) {
#pragma unroll
            for (int j = 0; j < 4; ++j) { u32x2 o; o.x = pk2(v[j].x, v[j].y); o.y = pk2(v[j].z, v[j].w); *((u32x2*)(hbout + (size_t)m * D) + lane + 64 * j) = o; }
            if (lane < 16) ss[(size_t)m * 16 + lane] = (lane == 0) ? s : 0.f;
        } else {
            const float rstd = rsqrtf(s * (1.0f / D) + EPS);
#pragma unroll
            for (int j = 0; j < 4; ++j) { const f32x4 g = *((const f32x4*)gfin + lane + 64 * j); *((f32x4*)(outf + (size_t)m * D) + lane + 64 * j) = v[j] * rstd * g; }
        }
    }
    return true;
}

__device__ __forceinline__ const float* inp_ptr(volatile LAS unsigned* LC, int i) { return (const float*)(((unsigned long long)(unsigned)__builtin_amdgcn_readfirstlane(LC[LC_PTR + 2 * i + 1]) << 32) | (unsigned long long)(unsigned)__builtin_amdgcn_readfirstlane(LC[LC_PTR + 2 * i])); }
__device__ __forceinline__ ConvJob conv_job(volatile LAS unsigned* LC, unsigned char* wsl, int id, int nsmall, int moe_wg, int moe_wd, int moe_gain) {
    ConvJob J;
    if (id < nsmall) {
        int mi = 0, rem = id;
        for (; mi < NMAT_SMALL - 1; ++mi) { const int it = (g_mats[mi].K >> 7) * ((g_mats[mi].N + 127) >> 7); if (rem < it) break; rem -= it; }
        const MatDesc d = g_mats[mi]; const int nn = (d.N + 127) >> 7;
        J.W = inp_ptr(LC, d.in_idx); J.gain = d.gain_idx >= 0 ? inp_ptr(LC, d.gain_idx) : nullptr; J.WT = (bf16*)(wsl + d.dst_off); J.K = d.K; J.N = d.N; J.mode = d.mode; J.rowoff = d.rowoff; J.k0 = (rem / nn) * 128; J.n0 = (rem % nn) * 128; J.tiled = (d.K == 2816) ? 1 : 0; J.f8 = (DENSE_DN_FP8 && d.K == 2816) ? 1 : 0; J.wscale = J.f8 ? 64.0f : 1.0f; J.pad = 0;
    } else {
        const int r = id - nsmall, e = r / MOE_ITEMS_E, q = r - e * MOE_ITEMS_E;
        if (q < 352) { J.W = inp_ptr(LC, moe_wg) + (size_t)e * 1024 * 5632; J.gain = inp_ptr(LC, moe_gain); J.WT = (bf16*)(wsl + OFF_MGU + e * MOE_GU_BYTES); J.K = 1024; J.N = 5632; J.mode = 3; J.rowoff = 0; J.k0 = (q / 44) * 128; J.n0 = (q % 44) * 128; }
        else { const int q2 = q - 352; J.W = inp_ptr(LC, moe_wd) + (size_t)e * 2816 * 1024; J.gain = nullptr; J.WT = (bf16*)(wsl + OFF_MDN + e * MOE_DN_BYTES); J.K = 2816; J.N = 1024; J.mode = 0; J.rowoff = 0; J.k0 = (q2 / 8) * 128; J.n0 = (q2 % 8) * 128; }
        J.f8 = 1; J.wscale = 64.0f; J.tiled = (q >= 352) ? 1 : 0; J.pad = 0;
    }
    return J;
}
__device__ __forceinline__ void conv_run(volatile LAS unsigned* LC, LAS unsigned char* lds, unsigned char* wsl, int cb, int Gs, int t, int nsmall, int total, int moe_wg, int moe_wd, int moe_gain) {
    LAS float* scr = (LAS float*)lds;
    int id = cb; bool have = id < total; ConvJob J{}; f32x4 v[8]; float gk[8];
#pragma unroll
    for (int i = 0; i < 8; ++i) { v[i] = (f32x4){0.f, 0.f, 0.f, 0.f}; gk[i] = 0.f; }
    if (have) { J = conv_job(LC, wsl, id, nsmall, moe_wg, moe_wd, moe_gain); conv_load(J, t, v, gk); }
    while (have) {
        conv_to_lds(scr, t, v, gk);
        __syncthreads();
        const int idn = id + Gs; const bool hn = idn < total; ConvJob Jn{};
        if (hn) { Jn = conv_job(LC, wsl, idn, nsmall, moe_wg, moe_wd, moe_gain); conv_load(Jn, t, v, gk); }
        conv_store(J, scr, t);
        __syncthreads();
        J = Jn; id = idn; have = hn;
    }
}

struct Args { const void* in[39]; float* out; unsigned char* ws; int ph_lo, ph_hi; };

#define INP(i) ((const float*)(((unsigned long long)(unsigned)__builtin_amdgcn_readfirstlane(LC[LC_PTR + 2 * (i) + 1]) << 32) | (unsigned long long)(unsigned)__builtin_amdgcn_readfirstlane(LC[LC_PTR + 2 * (i)])))
#define IN(k) (lo <= (k) && (k) < hi)
#define SEAM(k) do { if ((k) + 1 < hi) xcd_barrier(bar); } while (0)
#define SITE_BEGIN() int zz_; asm volatile("s_mov_b32 %0, 0" : "=s"(zz_)); unsigned char* wsl = args.ws + zz_; float* outl = args.out + zz_; const int cb = (int)blockIdx.x + zz_, Gs = (int)gridDim.x + zz_; \
    unsigned char* R0 = wsl + WS_R0; (void)R0; (void)outl
#define SSA(i) ((float*)(wsl + WS_SS) + (size_t)(i) * M * 16)
#define CSP ((const float2*)(wsl + WS_CS))
#define HBP ((bf16*)(wsl + WS_HB))

template <int l>
__device__ __forceinline__ void layer_phases(const Args& args, LAS unsigned char* lds, volatile LAS unsigned* LC, const XcdBarrier& bar, const int lo, const int hi) {
        if (l < 2) {
            if (SITE(1) && IN(PH(l, 0))) REP(1) {
                SITE_BEGIN();
                pg8::Gemm g{HBP, (const bf16*)(wsl + (l ? OFF_WD1 : OFF_WD0)), M, 768, 1024}; pg8::StaticOrder S; S.init(M, 768, Gs, cb);
                pg8::EpiDown E{SSA(0), CSP, (bf16*)(R0 + R_CQ), (bf16*)(R0 + R_CKV), (bf16*)(R0 + R_KR), SSA(2), SSA(3), MLA_FP8 ? R0 + R_K8T : nullptr};
                pg8::gemm_phase<pg8::EpiDown, pg8::StaticOrder, true, true>(lds, g, S, E);
                SEAM(PH(l, 0));
            }
            if (SITE(2) && IN(PH(l, 1))) REP(1) {
                if (MLA_FP8) {
                    { SITE_BEGIN();
                      pg8::Gemm g{(const bf16*)(R0 + R_CQ), (const bf16*)(wsl + (l ? OFF_WUQ1 : OFF_WUQ0)), M, 1536, 384}; pg8::StaticOrder S; S.init(M, 1536, Gs, cb);
                      pg8::EpiUq8 E{SSA(2), CSP, R0 + R_Q8, C2_MLA * 16.0f, 0};
                      pg8::gemm_phase<pg8::EpiUq8, pg8::StaticOrder, true, true>(lds, g, S, E); }
                    { SITE_BEGIN();
                      pg8::Gemm g{(const bf16*)(R0 + R_CKV), (const bf16*)(wsl + (l ? OFF_WUKV1 : OFF_WUKV0)), M, 1024, 256}; pg8::StaticOrder S; S.init(M, 1024, Gs, cb);
                      pg8::EpiKn8 E{SSA(3), R0 + R_K8T};
                      pg8::gemm_phase<pg8::EpiKn8, pg8::StaticOrder, true, true>(lds, g, S, E); }
                    { SITE_BEGIN();
                      pg8::Gemm g{(const bf16*)(wsl + (l ? OFF_WUKV1 : OFF_WUKV0)) + (size_t)1024 * 256, (const bf16*)(R0 + R_CKV), 1024, M, 256}; pg8::StaticOrder S; S.init(1024, M, Gs, cb);
                      pg8::EpiVt8 E{SSA(3), R0 + R_VT8T};
                      pg8::gemm_phase<pg8::EpiVt8, pg8::StaticOrder, true, true>(lds, g, S, E); }
                } else {
                { SITE_BEGIN();
                  pg8::Gemm g{(const bf16*)(R0 + R_CQ), (const bf16*)(wsl + (l ? OFF_WUQ1 : OFF_WUQ0)), M, 1536, 384}; pg8::StaticOrder S; S.init(M, 1536, Gs, cb);
                  pg8::EpiUq E{SSA(2), CSP, (bf16*)(R0 + R_Q), C2_MLA, 0};
                  pg8::gemm_phase<pg8::EpiUq, pg8::StaticOrder, true, true>(lds, g, S, E); }
                { SITE_BEGIN();
                  pg8::Gemm g{(const bf16*)(R0 + R_CKV), (const bf16*)(wsl + (l ? OFF_WUKV1 : OFF_WUKV0)), M, 2048, 256}; pg8::StaticOrder S; S.init(M, 2048, Gs, cb);
                  pg8::EpiProj E{SSA(3), (bf16*)(R0 + R_KN), (size_t)(R_V - R_KN) / 2, 1.0f, -1, 2, 1.0f / 256.0f, 0};
                  pg8::gemm_phase<pg8::EpiProj, pg8::StaticOrder, true, true>(lds, g, S, E); }
                }
                SEAM(PH(l, 1));
            }
            if (SITE(9) && IN(PH(l, 2))) REP(2) {
                SITE_BEGIN();
                const int vcu = (Gs % 8 == 0) ? (cb % 8) * (Gs / 8) + cb / 8 : cb;
                for (int u = vcu; u < 1024; u += Gs) { int b, hd, qb; att::unit_of(u, b, hd, qb);
                    if (MLA_FP8) att::mla8_unit((ATT_LAS char*)lds, R0 + R_Q8, R0 + R_K8T, R0 + R_VT8T, (bf16*)(R0 + R_O), b, hd, qb);
                    else att::mla_unit((ATT_LAS char*)lds, (const bf16*)(R0 + R_Q), (const bf16*)(R0 + R_KN), (const bf16*)(R0 + R_KR), (const bf16*)(R0 + R_V), (bf16*)(R0 + R_O), b, hd, qb); }
                SEAM(PH(l, 2));
            }
        } else {
            static_assert(R_VS - R_KS == R_QS - R_VS, "Ks|Vs|Qs equally spaced");
            if (SITE(3) && IN(PH(l, 0))) REP(7) {
                SITE_BEGIN();
                const int N = (l == 2) ? 3072 : 1024;
                pg8::Gemm g{HBP, (const bf16*)(wsl + (l == 2 ? OFF_WKVQ : OFF_WQ3)), M, N, 1024}; pg8::StaticOrder S; S.init(M, N, Gs, cb);
                pg8::EpiProj E{SSA(0), (bf16*)(R0 + ((l == 2) ? R_KS : R_QS)), (size_t)(R_VS - R_KS) / 2, C2_SB, (l == 2) ? 2 : 0, 4, 1.0f / 1024.0f, 0};
                pg8::gemm_phase<pg8::EpiProj, pg8::StaticOrder, true, true>(lds, g, S, E);
                SEAM(PH(l, 0));
            }
            if (SITE(10) && IN(PH(l, 2))) REP(3) {
                SITE_BEGIN();
                const int vcu = (Gs % 8 == 0) ? (cb % 8) * (Gs / 8) + cb / 8 : cb;
                for (int u = vcu; u < 1024; u += Gs) { int b, hd, qb; att::unit_of(u, b, hd, qb);
                    att::sb_unit((ATT_LAS char*)lds, (volatile ATT_LAS unsigned*)(LC + LC_SBDONE), (unsigned)(u + 1 + l * 4096), (const bf16*)(R0 + R_QS), (const bf16*)(R0 + R_KS), (const bf16*)(R0 + R_VS), (bf16*)(R0 + R_OS), b, hd, qb); }
                SEAM(PH(l, 2));
            }
        }
        if (SITE(4) && IN(PH(l, 3))) REP(11) {
            SITE_BEGIN();
            const long long wo = (l == 0) ? OFF_WO0 : (l == 1 ? OFF_WO1 : (l == 2 ? OFF_WO2 : OFF_WO3));
            pg8::Gemm g{(const bf16*)(R0 + (l < 2 ? R_O : R_OS)), (const bf16*)(wsl + wo), M, 1024, 1024}; pg8::StaticOrder S; S.init(M, 1024, Gs, cb);
            pg8::EpiRes E{HBP, DUMMY(11) ? (bf16*)(R0 + R_ACT) : HBP, DUMMY(11) ? SSA(2) : SSA(1), 1.0f, 0};
            pg8::gemm_phase<pg8::EpiRes, pg8::StaticOrder, true, true>(lds, g, S, E);
            SEAM(PH(l, 3));
        }
        const bool moe = (l & 1) != 0;
        if (SITE(11) && moe && IN(PH(l, 4))) REP(9) {
            SITE_BEGIN();
            int tid_ = threadIdx.x; asm volatile("" : "+v"(tid_));
            const int tid = tid_, lane = tid & 63, wave = __builtin_amdgcn_readfirstlane(tid >> 6);
            LAS int* lcnt = (LAS int*)lds; LAS int* gb = lcnt + 8; LAS int* le = lcnt + 16; LAS int* lp = le + 256; LAS float* lg = (LAS float*)(lp + 256);
            unsigned* cnt = (unsigned*)(wsl + WS_CTL) + CW_CNT + (l == 3 ? 64 : 0) + (DUMMY(9) ? 128 : 0);
            RInfo* rinfo = (RInfo*)(wsl + WS_RINFO);
#define RT_LOAD(dst, sdst, m_) do { const u32x2* hp_ = (const u32x2*)(HBP + (size_t)(m_) * D) + lane; dst[0] = hp_[0]; dst[1] = hp_[64]; dst[2] = hp_[128]; dst[3] = hp_[192]; sdst = sum16(SSA(1) + (size_t)(m_) * 16); } while (0)
            u32x2 hw[4][4], hn[4][4]; float ssc[4], ssn_[4];
#pragma unroll
            for (int r = 0; r < 4; ++r) {
#pragma unroll
                for (int j = 0; j < 4; ++j) { hw[r][j] = (u32x2){0u, 0u}; hn[r][j] = (u32x2){0u, 0u}; }
                ssc[r] = 0.f; ssn_[r] = 0.f; }
            bool pre = cb < M / 128;
            if (pre) {
#pragma unroll
                for (int r = 0; r < 4; ++r) RT_LOAD(hw[r], ssc[r], cb * 128 + r * 8 + wave); }
            LAS float* RT = (LAS float*)(lds + 8192); router_load(RT, INP(l == 1 ? 19 : 34), INP(l == 1 ? 20 : 35), tid);
            for (int chunk = cb; chunk < M / 128; chunk += Gs) {
                if (tid < NE) lcnt[tid] = 0;
                __syncthreads();
                if (!pre) {
#pragma unroll
                    for (int r = 0; r < 4; ++r) RT_LOAD(hw[r], ssc[r], chunk * 128 + r * 8 + wave); }
                pre = false;
                for (int it = 0; it < 4; ++it) {
                    if (it < 3) {
#pragma unroll
                        for (int r = 0; r < 4; ++r) RT_LOAD(hn[r], ssn_[r], chunk * 128 + (4 * (it + 1) + r) * 8 + wave); }
                    float acc4[4][NE]; route_dot4(RT, hw, lane, acc4);
#pragma unroll
                    for (int r = 0; r < 4; ++r) { const int rl = (4 * it + r) * 8 + wave; int i1, i2; float g1, g2;
                        route_row(acc4[r], rsqrtf(ssc[r] * (1.0f / D) + EPS), lane, i1, i2, g1, g2);
                        if (lane == 0) { le[2 * rl] = i1; le[2 * rl + 1] = i2; lg[2 * rl] = g1; lg[2 * rl + 1] = g2; lp[2 * rl] = __hip_atomic_fetch_add(lcnt + i1, 1, __ATOMIC_RELAXED, __HIP_MEMORY_SCOPE_WORKGROUP); lp[2 * rl + 1] = __hip_atomic_fetch_add(lcnt + i2, 1, __ATOMIC_RELAXED, __HIP_MEMORY_SCOPE_WORKGROUP); } }
#pragma unroll
                    for (int r = 0; r < 4; ++r) {
#pragma unroll
                        for (int j = 0; j < 4; ++j) hw[r][j] = hn[r][j];
                        ssc[r] = ssn_[r]; }
                }
#undef RT_LOAD
                __syncthreads();
                if (tid < NE) gb[tid] = (int)__hip_atomic_fetch_add(cnt + tid, (unsigned)lcnt[tid], RLX_AGENT);
                __syncthreads();
                if (tid < 128) { RInfo ri; ri.e1 = le[2 * tid]; ri.e2 = le[2 * tid + 1]; ri.p1 = gb[ri.e1] + lp[2 * tid]; ri.p2 = gb[ri.e2] + lp[2 * tid + 1]; ri.g1 = lg[2 * tid]; ri.g2 = lg[2 * tid + 1]; ri.s1 = 0; ri.s2 = 0; rinfo[chunk * 128 + tid] = ri; }
                __syncthreads();
            }
            SEAM(PH(l, 4));
        }
        if (SITE(12) && moe && IN(PH(l, 5))) REP(8) {
            SITE_BEGIN();
            int tid_ = threadIdx.x; asm volatile("" : "+v"(tid_));
            const int tid = tid_, lane = tid & 63, wave = __builtin_amdgcn_readfirstlane(tid >> 6);
            unsigned* cnt = (unsigned*)(wsl + WS_CTL) + CW_CNT + (l == 3 ? 64 : 0);
            int* base_out = (int*)(wsl + WS_CTL) + CW_BASE + (l == 3 ? 64 : 0);
            RInfo* rinfo = (RInfo*)(wsl + WS_RINFO);
            unsigned char* xg8 = R0 + R_XG; float* ssg = (float*)(wsl + WS_SLOT); float* sgate = ssg + TMAX;
            int cn[NE], base[NE + 1]; base[0] = 0;
            const unsigned cv_ = __hip_atomic_load(cnt + (lane & 7), RLX_AGENT);
#pragma unroll
            for (int e = 0; e < NE; ++e) { cn[e] = (int)__builtin_amdgcn_readlane(cv_, e); base[e + 1] = base[e] + ((cn[e] + 255) & ~255); }
            if (cb == 0 && tid <= NE) { int v = 0;
#pragma unroll
                for (int e = 0; e <= NE; ++e) if (tid == e) v = base[e];
                base_out[tid] = v; }
            const int gw = cb * NWAVES + wave, NGW = Gs * NWAVES;
            int2* tokslot = (int2*)(wsl + WS_TOKSLOT);
            for (int m0 = gw; m0 < M; m0 += 2 * NGW) {
                const int m1 = (m0 + NGW < M) ? m0 + NGW : m0;
                const RInfo ra = rinfo[m0], rb = rinfo[m1];
                const u32x4* sa = (const u32x4*)(HBP + (size_t)m0 * D) + 2 * lane; const u32x4* sb = (const u32x4*)(HBP + (size_t)m1 * D) + 2 * lane;
                const u32x4 a0 = sa[0], a1 = sa[1], c0 = sb[0], c1 = sb[1];
                float sva = 0.f, svb = 0.f; if (lane == 0) { sva = sum16(SSA(1) + (size_t)m0 * 16); svb = sum16(SSA(1) + (size_t)m1 * 16); }
                int ba1 = 0, ba2 = 0, bb1 = 0, bb2 = 0;
#pragma unroll
                for (int e = 0; e < NE; ++e) { if (ra.e1 == e) ba1 = base[e]; if (ra.e2 == e) ba2 = base[e]; if (rb.e1 == e) bb1 = base[e]; if (rb.e2 == e) bb2 = base[e]; }
                const int sa1 = ba1 + ra.p1, sa2 = ba2 + ra.p2, sb1 = bb1 + rb.p1, sb2 = bb2 + rb.p2;
                v4u oa, ob;
                oa.x = pg8::pk4_fp8(bf2f(a0.x), bf2f(a0.x >> 16), bf2f(a0.y), bf2f(a0.y >> 16)); oa.y = pg8::pk4_fp8(bf2f(a0.z), bf2f(a0.z >> 16), bf2f(a0.w), bf2f(a0.w >> 16));
                oa.z = pg8::pk4_fp8(bf2f(a1.x), bf2f(a1.x >> 16), bf2f(a1.y), bf2f(a1.y >> 16)); oa.w = pg8::pk4_fp8(bf2f(a1.z), bf2f(a1.z >> 16), bf2f(a1.w), bf2f(a1.w >> 16));
                ob.x = pg8::pk4_fp8(bf2f(c0.x), bf2f(c0.x >> 16), bf2f(c0.y), bf2f(c0.y >> 16)); ob.y = pg8::pk4_fp8(bf2f(c0.z), bf2f(c0.z >> 16), bf2f(c0.w), bf2f(c0.w >> 16));
                ob.z = pg8::pk4_fp8(bf2f(c1.x), bf2f(c1.x >> 16), bf2f(c1.y), bf2f(c1.y >> 16)); ob.w = pg8::pk4_fp8(bf2f(c1.z), bf2f(c1.z >> 16), bf2f(c1.w), bf2f(c1.w >> 16));
                *((v4u*)(xg8 + (size_t)sa1 * D) + lane) = oa; *((v4u*)(xg8 + (size_t)sa2 * D) + lane) = oa; *((v4u*)(xg8 + (size_t)sb1 * D) + lane) = ob; *((v4u*)(xg8 + (size_t)sb2 * D) + lane) = ob;
                if (lane == 0) { ssg[sa1] = sva; ssg[sa2] = sva; sgate[sa1] = ra.g1; sgate[sa2] = ra.g2; tokslot[m0] = make_int2(sa1, sa2);
                                 ssg[sb1] = svb; ssg[sb2] = svb; sgate[sb1] = rb.g1; sgate[sb2] = rb.g2; tokslot[m1] = make_int2(sb1, sb2); }
            }
            for (int e = cb; e < NE; e += Gs) {
                int plo = 0, phi = 0;
#pragma unroll
                for (int q = 0; q < NE; ++q) if (e == q) { plo = base[q] + cn[q]; phi = base[q + 1]; }
                for (int r = plo + wave; r < phi; r += NWAVES) { *((v4u*)(xg8 + (size_t)r * D) + lane) = (v4u){0u, 0u, 0u, 0u}; if (lane == 0) { ssg[r] = 1024.f; sgate[r] = 0.f; } }
            }
            SEAM(PH(l, 5));
        }
        if (SITE(5) && !moe && IN(PH(l, 6))) REP(4) {
            SITE_BEGIN();
            pg8::Gemm g{HBP, (const bf16*)(wsl + (l == 0 ? OFF_WGU0 : OFF_WGU2)), M, 5632, 1024}; pg8::StaticOrder S; S.init(M, 5632, Gs, cb);
            if (DENSE_DN_FP8) { pg8::EpiSwiglu8 E{SSA(1), R0 + R_ACT, 16, 1.0f};
                pg8::gemm_phase<pg8::EpiSwiglu8, pg8::StaticOrder, true, true>(lds, g, S, E); }
            else { pg8::EpiSwiglu E{SSA(1), (bf16*)(R0 + R_ACT), 16, 0};
                pg8::gemm_phase<pg8::EpiSwiglu, pg8::StaticOrder, true, true>(lds, g, S, E); }
            SEAM(PH(l, 6));
        }
        if (SITE(13) && moe && IN(PH(l, 6))) REP(5) {
            SITE_BEGIN();
            pg8::Gemm g{(const bf16*)(R0 + R_XG), (const bf16*)(wsl + OFF_MGU), TMAX, 5632, 512}; pg8::GroupedOrder S; S.initg((const int*)(wsl + WS_CTL) + CW_BASE + (l == 3 ? 64 : 0), 5632, Gs, cb, (size_t)MOE_GU_BYTES);
            pg8::EpiSwiglu8 E{(const float*)(wsl + WS_SLOT), R0 + R_ACTG, 1, 1.0f / 64.0f};
            pg8::gemm_phase<pg8::EpiSwiglu8, pg8::GroupedOrder, true, true, true>(lds, g, S, E);
            SEAM(PH(l, 6));
        }
        if (!moe) {
            if (SITE(6) && IN(PH(l, 7))) REP(12) {
                SITE_BEGIN();
                pg8::Gemm g{(const bf16*)(R0 + R_ACT), (const bf16*)(wsl + (l == 0 ? OFF_WDN0 : OFF_WDN2)), M, 1024, DENSE_DN_FP8 ? 1408 : 2816}; pg8::StaticOrder S; S.init(M, 1024, Gs, cb);
                pg8::EpiRes E{HBP, DUMMY(12) ? (bf16*)(R0 + R_QS) : HBP, DUMMY(12) ? SSA(2) : SSA(0), DENSE_DN_FP8 ? 1.0f / 512.0f : 1.0f, 0};
                if (DENSE_DN_FP8) pg8::gemm_phase<pg8::EpiRes, pg8::StaticOrder, true, true, true, true>(lds, g, S, E);
                else pg8::gemm_phase<pg8::EpiRes, pg8::StaticOrder, true, true, false, true>(lds, g, S, E);
                SEAM(PH(l, 7));
            }
        } else {
            if (SITE(7) && IN(PH(l, 7))) REP(6) {
                SITE_BEGIN();
                pg8::Gemm g{(const bf16*)(R0 + R_ACTG), (const bf16*)(wsl + OFF_MDN), TMAX, 1024, 1408}; pg8::GroupedOrder S;   S.initg((const int*)(wsl + WS_CTL) + CW_BASE + (l == 3 ? 64 : 0), 1024, Gs, cb, (size_t)MOE_DN_BYTES);
                pg8::MoeSplit sp; sp.init(S.nM, 4, Gs); S.nM = sp.nM_main; S.nwg = sp.nM_main * 4;
                pg8::EpiMdn E{(const float*)(wsl + WS_SLOT) + TMAX, (bf16*)(R0 + R_XG), 1.0f / 512.0f, 0};
                pg8::gemm_phase<pg8::EpiMdn, pg8::GroupedOrder, true, true, true, true>(lds, g, S, E);
                SEAM(PH(l, 7));
            }
            if (SITE(8) && IN(PH(l, 8))) REP(10) {
                SITE_BEGIN();
                int tid_ = threadIdx.x; asm volatile("" : "+v"(tid_));
                const int lane = tid_ & 63, wave = __builtin_amdgcn_readfirstlane(tid_ >> 6);
                pg8::MoeSplit sp; sp.init(__builtin_amdgcn_readfirstlane(((const int*)(wsl + WS_CTL) + CW_BASE + (l == 3 ? 64 : 0))[8]) / 256, 4, Gs);
                const int ntail = sp.ntail, thr = ntail ? sp.nM_main * 256 : 0x7fffffff;
                const bool tailcu = cb < ntail;
                const int gw = (cb - ntail) * NWAVES + wave, NGW = (Gs - ntail) * NWAVES;
                const int2* tokslot = (const int2*)(wsl + WS_TOKSLOT);
                const float* gf = (l == 3) ? INP(38) : nullptr;
                if (tailcu) {
                    pg8::Gemm g{(const bf16*)(R0 + R_ACTG), (const bf16*)(wsl + OFF_MDN), TMAX, 1024, 1408}; pg8::TailOrder S; S.initg((const int*)(wsl + WS_CTL) + CW_BASE + (l == 3 ? 64 : 0), 1024, Gs, cb, (size_t)MOE_DN_BYTES);
                    S.tpm = sp.nM_main + (cb >> 2); S.tpn = cb & 3;
                    pg8::EpiMdn E{(const float*)(wsl + WS_SLOT) + TMAX, (bf16*)(R0 + R_XG), 1.0f / 512.0f, 0};
                    pg8::gemm_phase<pg8::EpiMdn, pg8::TailOrder, true, true, true, true>(lds, g, S, E);
                }
                unsigned pend = 0u;
#pragma nounroll
                for (int pass = 0; pass < 2; ++pass) {
                    if (pass == 1) { if (ntail == 0) break; if (hi - lo > 1) xcd_barrier(bar); }
                    if (!tailcu) { int k = 0;
                        int2 ta = make_int2(0, 0), tb = make_int2(0, 0);
                        if (pass == 0 && gw < M) { ta = tokslot[gw]; tb = tokslot[(gw + NGW < M) ? gw + NGW : gw]; }
                        for (int m = gw; m < M; m += 2 * NGW, ++k) {
                            if (pass == 1) { if (k < 32 && !((pend >> k) & 1u)) continue; ta = tokslot[m]; tb = tokslot[(m + NGW < M) ? m + NGW : m]; }
                            int2 tna = ta, tnb = tb; const int mn = m + 2 * NGW;
                            if (pass == 0 && mn < M) { tna = tokslot[mn]; tnb = tokslot[(mn + NGW < M) ? mn + NGW : mn]; }
                            bool did;
                            if (l == 1) did = combine_rows2<false>(HBP, DUMMY(10) ? (bf16*)(R0 + R_ACTG) : HBP, nullptr, (const bf16*)(R0 + R_XG), tokslot, DUMMY(10) ? SSA(2) : SSA(0), nullptr, m, (m + NGW < M) ? m + NGW : m, lane, thr, pass, ta, tb);
                            else did = combine_rows2<true>(HBP, nullptr, DUMMY(10) ? (float*)(R0 + R_ACTG) : outl, (const bf16*)(R0 + R_XG), tokslot, nullptr, gf, m, (m + NGW < M) ? m + NGW : m, lane, thr, pass, ta, tb);
                            if (pass == 0 && !did && k < 32) pend |= 1u << k;
                            ta = tna; tb = tnb;
                        }
                    }
                }
                if (l == 1) conv_run(LC, lds, wsl, cb, Gs, tid_, 0, MOE_ITEMS, 36, 37, 34);
                SEAM(PH(l, 8));
            }
        }
    }

__global__ void __launch_bounds__(NWAVES * 64, 2) mega(Args args) {
    extern __shared__ __attribute__((aligned(16))) unsigned char lds_raw[];
    LAS unsigned char* lds = (LAS unsigned char*)lds_raw;
    volatile LAS unsigned* LC = (volatile LAS unsigned*)(lds + LDSCTL_OFF);
    for (int u = threadIdx.x; u < (LDS_BYTES - LDSCTL_OFF) / 4; u += NWAVES * 64) LC[u] = 0u;
    __syncthreads();
    if (threadIdx.x == 0) {
#pragma unroll
        for (int i = 0; i < 39; ++i) { const unsigned long long p = (unsigned long long)args.in[i]; LC[LC_PTR + 2 * i] = (unsigned)p; LC[LC_PTR + 2 * i + 1] = (unsigned)(p >> 32); }
    }
    __syncthreads();
#ifdef MK_PER_PHASE
    const int lo = args.ph_lo, hi = args.ph_hi;
#else
    constexpr int lo = 0, hi = PH_END;
#endif
    XcdBarrier bar; bar.bar = (unsigned*)(args.ws + WS_CTL) + CW_BAR; bar.x = 0; bar.st = nullptr;
    if (hi - lo > 1) bar = xcd_barrier_post((unsigned*)(args.ws + WS_CTL) + CW_BAR, LC + LC_BAR);
    if (SITE(0) && IN(PH_PRO)) REP(0) {
        SITE_BEGIN();
        int tid_ = threadIdx.x; asm volatile("" : "+v"(tid_));
        const int lane = tid_ & 63, wave = __builtin_amdgcn_readfirstlane(tid_ >> 6);
        const int gw = cb * NWAVES + wave, NGW = Gs * NWAVES;
        for (int l = 0; l < 2; ++l) { bf16* wd = (bf16*)(wsl + (l ? OFF_WD1 : OFF_WD0)) + (size_t)704 * 1024;
            for (int i = cb * 512 + tid_; i < 64 * 1024 / 8; i += Gs * 512) ((v4u*)wd)[i] = (v4u){0u, 0u, 0u, 0u}; }
        conv_run(LC, lds, wsl, cb, Gs, tid_, SMALL_ITEMS, SMALL_ITEMS + MOE_ITEMS, 21, 22, 19);
        for (int m = gw; m < M; m += 2 * NGW) prep_rows2(INP(0), (const int*)INP(1), HBP, SSA(0), (float2*)(wsl + WS_CS), m, (m + NGW < M) ? m + NGW : m, lane);
        SEAM(PH_PRO);
    }

    layer_phases<0>(args, lds, LC, bar, lo, hi);
    layer_phases<1>(args, lds, LC, bar, lo, hi);
    layer_phases<2>(args, lds, LC, bar, lo, hi);
    layer_phases<3>(args, lds, LC, bar, lo, hi);
#undef IN
#undef SEAM
#undef INP
#undef SSA
}


extern "C" void kernel_launch(void* const* d_in, const int* in_sizes, int n_in, void* d_out, int out_size, void* d_ws, size_t ws_size, hipStream_t stream) {
    if (n_in != 39 || out_size != M * D || ws_size < WS_END) { fprintf(stderr, "kernel_launch: unexpected shapes (n_in %d out %d ws %zu need %zu)\n", n_in, out_size, ws_size, (size_t)WS_END); return; }
    static int once = 0, grid = 256;
    if (!once) { once = 1;
        { int dev = 0, cus = 0; if (hipGetDevice(&dev) == hipSuccess && hipDeviceGetAttribute(&cus, hipDeviceAttributeMultiprocessorCount, dev) == hipSuccess && cus > 0) grid = cus; }
        (void)hipFuncSetAttribute((const void*)mega, hipFuncAttributeMaxDynamicSharedMemorySize, LDS_BYTES); }
    unsigned char* ws = (unsigned char*)d_ws;
    float* out = (float*)d_out;
    Args a{};
    for (int i = 0; i < 39; ++i) a.in[i] = d_in[i];
    a.out = out; a.ws = ws;
    auto phase = [&](int p) { a.ph_lo = p; a.ph_hi = p + 1; hipLaunchKernelGGL(mega, dim3(grid), dim3(NWAVES * 64), LDS_BYTES, stream, a); }; (void)phase;

    (void)hipMemsetAsync(ws + WS_CTL, 0, CTL_BYTES, stream);
#ifdef MK_PER_PHASE
    for (int p = 0; p < PH_END; ++p) phase(p);
#else
    a.ph_lo = 0; a.ph_hi = PH_END;
    hipLaunchKernelGGL(mega, dim3(grid), dim3(NWAVES * 64), LDS_BYTES, stream, a);
#endif
}
```
